# Optimizing an MI355X kernel written in HIP

```python
import math
import jax, jax.numpy as jnp
from jax import lax
import numpy as np

D_MODEL = 1024
BATCH = 2
SEQ = 8192
DEPTH = 2

N_EVEN = (DEPTH + 1) // 2
N_ODD = DEPTH // 2

A_HEADS = 8
A_HEAD_DIM = D_MODEL // 16
A_WIDTH = A_HEADS * A_HEAD_DIM
DILATED_CONFIGS = ((128, 1), (512, 4), (2048, 16))
ROT_DIM = A_HEAD_DIM // 4
ROPE_THETA = 500000.0

POOL_WINDOWS = (2, 4, 8, 16)
POOL_GROUPS = 4
POOL_GROUP_DIM = D_MODEL // 8
POOL_WIDTH = POOL_GROUPS * POOL_GROUP_DIM

EVEN_IN = 3 * A_WIDTH + POOL_WIDTH
EVEN_MIX = A_WIDTH + POOL_WIDTH

DN_HEADS = 8
DN_HEAD_DIM = D_MODEL // 8
DN_WIDTH = DN_HEADS * DN_HEAD_DIM
CONV_WIDTH = 4
CHUNK = 64
ODD_IN = 4 * DN_WIDTH + 2 * DN_HEADS

FFN_DIM = D_MODEL * 7 // 2
N_EXPERTS = 8
TOP_K = 2
EPS = 1e-6

kernel_name = 'hybrid_dilated_pool_deltanet_moe_block'


def _rmsnorm(x, g):
    xf = x.astype(jnp.float32)
    y = xf * lax.rsqrt(jnp.mean(xf * xf, axis=-1, keepdims=True) + EPS) * g
    return y.astype(x.dtype)


def _partial_rope(t, positions):
    half = ROT_DIM // 2
    inv_freq = ROPE_THETA ** (-jnp.arange(0, ROT_DIM, 2, dtype=jnp.float32) / ROT_DIM)
    ang = positions.astype(jnp.float32)[..., None] * inv_freq
    cos, sin = jnp.cos(ang)[:, :, None, :], jnp.sin(ang)[:, :, None, :]
    x1 = t[..., :half].astype(jnp.float32)
    x2 = t[..., half:ROT_DIM].astype(jnp.float32)
    rot = jnp.concatenate([x1 * cos - x2 * sin, x2 * cos + x1 * sin], axis=-1)
    return jnp.concatenate([rot.astype(t.dtype), t[..., ROT_DIM:]], axis=-1)


def _dilated_branch(q, k, v, window, dilation):
    bsz, nh, seq, hd = q.shape
    blk = window // dilation
    span = blk * dilation
    length = -(-seq // span) * span
    n_sub = length // dilation
    nb = n_sub // blk

    def to_blocks(t):
        t = jnp.pad(t, ((0, 0), (0, 0), (0, length - seq), (0, 0)))
        t = t.reshape(bsz, nh, n_sub, dilation, hd).transpose(0, 1, 3, 2, 4)
        return t.reshape(bsz, nh, dilation, nb, blk, hd)

    def with_prev(t):
        prev = jnp.pad(t, ((0, 0), (0, 0), (0, 0), (1, 0), (0, 0), (0, 0)))[:, :, :, :-1]
        return jnp.concatenate([prev, t], axis=4)

    qb = to_blocks(q)
    kk = with_prev(to_blocks(k))
    vv = with_prev(to_blocks(v))
    s = jnp.einsum('bhrnqd,bhrnkd->bhrnqk', qb, kk).astype(jnp.float32) * hd ** -0.5
    qi = jnp.arange(blk)[:, None] + blk
    kj = jnp.arange(2 * blk)[None, :]
    rel = qi - kj
    band = (rel >= 0) & (rel <= blk)
    has_prev = (jnp.arange(nb) > 0)[:, None, None] | (kj >= blk)[None]
    mask = band[None] & has_prev
    s = jnp.where(mask, s, -jnp.inf)
    m = jnp.max(s, axis=-1, keepdims=True)
    p = jnp.exp(s - m)
    den = jnp.sum(p, axis=-1)
    o = jnp.einsum('bhrnqk,bhrnkd->bhrnqd', p, vv.astype(jnp.float32)) / den[..., None]
    lse = m[..., 0] + jnp.log(den)
    o = o.reshape(bsz, nh, dilation, n_sub, hd).transpose(0, 1, 3, 2, 4)
    o = o.reshape(bsz, nh, length, hd)[:, :, :seq]
    lse = lse.reshape(bsz, nh, dilation, n_sub).transpose(0, 1, 3, 2)
    lse = lse.reshape(bsz, nh, length)[:, :, :seq]
    return o, lse


def _dilated_mixture(q, k, v):
    outs, lses = [], []
    for window, dilation in DILATED_CONFIGS:
        o, lse = _dilated_branch(q, k, v, window, dilation)
        outs.append(o)
        lses.append(lse)
    w = jax.nn.softmax(jnp.stack(lses), axis=0)
    return jnp.sum(w[..., None] * jnp.stack(outs), axis=0)


def _multiscale_pool(u, pool_w, pool_scale):
    bsz, seq, _ = u.shape
    ug = u.reshape(bsz, seq, POOL_GROUPS, POOL_GROUP_DIM).astype(jnp.float32)
    cs = jnp.pad(jnp.cumsum(ug, axis=1), ((0, 0), (1, 0), (0, 0), (0, 0)))
    win = jnp.array(POOL_WINDOWS, dtype=jnp.int32)
    t = jnp.arange(seq, dtype=jnp.int32)[:, None]
    lo = jnp.maximum(t + 1 - win[None, :], 0)
    cnt = jnp.minimum(t + 1, win[None, :]).astype(jnp.float32)
    lower = cs[:, lo, jnp.arange(POOL_GROUPS)[None, :], :]
    pooled = (cs[:, 1:] - lower) / cnt[None, :, :, None] - ug
    mixed = jnp.einsum('bsgc,gcd->bsgd', pooled, pool_w)
    mixed = mixed * pool_scale.reshape(POOL_GROUPS, POOL_GROUP_DIM)
    return mixed.reshape(bsz, seq, POOL_WIDTH).astype(u.dtype)


def _even_mixer(h, positions, w_in, pool_w, pool_scale, w_out):
    bsz, seq, _ = h.shape
    proj = h @ w_in
    q, k, v, u = jnp.split(proj, [A_WIDTH, 2 * A_WIDTH, 3 * A_WIDTH], axis=-1)
    q = _partial_rope(q.reshape(bsz, seq, A_HEADS, A_HEAD_DIM), positions)
    k = _partial_rope(k.reshape(bsz, seq, A_HEADS, A_HEAD_DIM), positions)
    v = v.reshape(bsz, seq, A_HEADS, A_HEAD_DIM)
    o_a = _dilated_mixture(q.transpose(0, 2, 1, 3), k.transpose(0, 2, 1, 3), v.transpose(0, 2, 1, 3))
    o_a = o_a.transpose(0, 2, 1, 3).reshape(bsz, seq, A_WIDTH).astype(h.dtype)
    o_b = _multiscale_pool(u, pool_w, pool_scale)
    return jnp.concatenate([o_a, o_b], axis=-1) @ w_out


def _causal_depthwise_conv(x, w):
    ch = x.shape[-1]
    return lax.conv_general_dilated(
        x, w[:, None, :], window_strides=(1,), padding=[(w.shape[0] - 1, 0)],
        dimension_numbers=('NWC', 'WIO', 'NWC'), feature_group_count=ch)


def _chunk_gated_delta(q, k, v, g, beta):
    bsz, nh, seq, dk = q.shape
    dv = v.shape[-1]
    n = seq // CHUNK
    q = q.reshape(bsz, nh, n, CHUNK, dk) * dk ** -0.5
    k = k.reshape(bsz, nh, n, CHUNK, dk)
    v = v.reshape(bsz, nh, n, CHUNK, dv)
    g = g.reshape(bsz, nh, n, CHUNK)
    beta = beta.reshape(bsz, nh, n, CHUNK)
    gc = jnp.cumsum(g, axis=-1)
    idx = jnp.arange(CHUNK)
    causal = idx[:, None] >= idx[None, :]
    strict = idx[:, None] > idx[None, :]
    decay = jnp.exp(jnp.where(causal, gc[..., :, None] - gc[..., None, :], -jnp.inf))
    kb = k * beta[..., None]
    lmat = jnp.where(strict, jnp.einsum('bhnid,bhnjd->bhnij', kb, k) * decay, 0.0)
    eye = jnp.eye(CHUNK, dtype=jnp.float32)
    rhs = jnp.concatenate([v * beta[..., None], kb * jnp.exp(gc)[..., None]], axis=-1)
    sol = lax.linalg.triangular_solve(lmat + eye, rhs, left_side=True, lower=True,
                                      unit_diagonal=True)
    u, w = sol[..., :dv], sol[..., dv:]
    attn = jnp.einsum('bhnid,bhnjd->bhnij', q, k) * decay
    q_g = q * jnp.exp(gc)[..., None]
    k_g = k * jnp.exp(gc[..., -1:] - gc)[..., None]
    chunk_decay = jnp.exp(gc[..., -1])

    def step(state, xs):
        q_c, k_c, u_c, w_c, a_c, d_c = xs
        v_new = u_c - jnp.einsum('bhck,bhkv->bhcv', w_c, state)
        o_c = jnp.einsum('bhck,bhkv->bhcv', q_c, state) + jnp.einsum('bhij,bhjv->bhiv', a_c, v_new)
        state = state * d_c[..., None, None] + jnp.einsum('bhck,bhcv->bhkv', k_c, v_new)
        return state, o_c

    front = lambda t: jnp.moveaxis(t, 2, 0)
    state0 = jnp.zeros((bsz, nh, dk, dv), jnp.float32)
    _, o = lax.scan(step, state0, (front(q_g), front(k_g), front(u), front(w), front(attn),
                                   front(chunk_decay)))
    return jnp.moveaxis(o, 0, 2).reshape(bsz, nh, seq, dv)


def _odd_mixer(h, w_in, conv_w, a_log, dt_bias, norm_g, w_out):
    bsz, seq, _ = h.shape
    proj = h @ w_in
    qkv, gate, beta_logit, a_logit = jnp.split(
        proj, [3 * DN_WIDTH, 4 * DN_WIDTH, 4 * DN_WIDTH + DN_HEADS], axis=-1)
    qkv = jax.nn.silu(_causal_depthwise_conv(qkv, conv_w))
    q, k, v = jnp.split(qkv, 3, axis=-1)
    heads = lambda t: t.reshape(bsz, seq, DN_HEADS, DN_HEAD_DIM).transpose(0, 2, 1, 3).astype(jnp.float32)
    q, k, v = heads(q), heads(k), heads(v)
    q = q * lax.rsqrt(jnp.sum(q * q, axis=-1, keepdims=True) + EPS)
    k = k * lax.rsqrt(jnp.sum(k * k, axis=-1, keepdims=True) + EPS)
    beta = jax.nn.sigmoid(beta_logit.astype(jnp.float32)).transpose(0, 2, 1)
    g = -(jnp.exp(a_log.astype(jnp.float32))
          * jax.nn.softplus(a_logit.astype(jnp.float32) + dt_bias)).transpose(0, 2, 1)
    o = _chunk_gated_delta(q, k, v, g, beta).transpose(0, 2, 1, 3)
    o = o * lax.rsqrt(jnp.mean(o * o, axis=-1, keepdims=True) + EPS) * norm_g
    o = o * jax.nn.silu(gate.astype(jnp.float32).reshape(bsz, seq, DN_HEADS, DN_HEAD_DIM))
    return o.reshape(bsz, seq, DN_WIDTH).astype(h.dtype) @ w_out


def _swiglu(h, w_gate, w_up, w_down):
    return (jax.nn.silu(h @ w_gate) * (h @ w_up)) @ w_down


def _moe(h, router_w, w_gate, w_up, w_down):
    bsz, seq, d = h.shape
    t = h.reshape(bsz * seq, d)
    logits = (t @ router_w).astype(jnp.float32)
    top_val, top_idx = lax.top_k(logits, TOP_K)
    top_w = jax.nn.softmax(top_val, axis=-1)
    combine = jnp.sum(jax.nn.one_hot(top_idx, N_EXPERTS, dtype=jnp.float32) * top_w[..., None], axis=1)
    out = jnp.zeros((bsz * seq, d), jnp.float32)
    for e in range(N_EXPERTS):
        out = out + combine[:, e:e + 1] * _swiglu(t, w_gate[e], w_up[e], w_down[e]).astype(jnp.float32)
    return out.reshape(bsz, seq, d).astype(h.dtype)


def setup_inputs(seed: int = 0) -> dict:
    key = jax.random.key(seed)
    ks = iter(jax.random.split(key, 40))
    nrm = lambda shape, scale: jax.random.normal(next(ks), shape, jnp.float32) * scale
    gain = lambda shape: 1.0 + 0.1 * jax.random.normal(next(ks), shape, jnp.float32)
    x = nrm((BATCH, SEQ, D_MODEL), 1.0)
    c = nrm((BATCH, D_MODEL), 1.0)
    offs = jax.random.randint(next(ks), (BATCH, 1), 0, 4096, dtype=jnp.int32)
    positions = offs + jnp.arange(SEQ, dtype=jnp.int32)[None, :]
    ada_w = nrm((DEPTH, D_MODEL, 6 * D_MODEL), 0.5 * D_MODEL ** -0.5)
    ada_b = nrm((DEPTH, 6 * D_MODEL), 0.02)
    mix_pre_g = gain((DEPTH, D_MODEL))
    mix_post_g = gain((DEPTH, D_MODEL))
    ffn_pre_g = gain((DEPTH, D_MODEL))
    ffn_post_g = gain((DEPTH, D_MODEL))
    even_w_in = nrm((N_EVEN, D_MODEL, EVEN_IN), D_MODEL ** -0.5)
    even_pool_w = nrm((N_EVEN, POOL_GROUPS, POOL_GROUP_DIM, POOL_GROUP_DIM), POOL_GROUP_DIM ** -0.5)
    even_pool_scale = 0.1 + 0.02 * jax.random.normal(next(ks), (N_EVEN, POOL_WIDTH), jnp.float32)
    even_w_out = nrm((N_EVEN, EVEN_MIX, D_MODEL), EVEN_MIX ** -0.5)
    even_ffn_w_gate = nrm((N_EVEN, D_MODEL, FFN_DIM), D_MODEL ** -0.5)
    even_ffn_w_up = nrm((N_EVEN, D_MODEL, FFN_DIM), D_MODEL ** -0.5)
    even_ffn_w_down = nrm((N_EVEN, FFN_DIM, D_MODEL), FFN_DIM ** -0.5)
    odd_w_in = nrm((N_ODD, D_MODEL, ODD_IN), D_MODEL ** -0.5)
    odd_conv_w = nrm((N_ODD, CONV_WIDTH, 3 * DN_WIDTH), CONV_WIDTH ** -0.5)
    odd_a_log = jnp.log(jax.random.uniform(next(ks), (N_ODD, DN_HEADS), jnp.float32, 1.0, 16.0))
    dt = jnp.exp(jax.random.uniform(next(ks), (N_ODD, DN_HEADS), jnp.float32,
                                    math.log(1e-3), math.log(1e-1)))
    odd_dt_bias = dt + jnp.log(-jnp.expm1(-dt))
    odd_norm_g = gain((N_ODD, DN_HEAD_DIM))
    odd_w_out = nrm((N_ODD, DN_WIDTH, D_MODEL), DN_WIDTH ** -0.5)
    odd_router_w = nrm((N_ODD, D_MODEL, N_EXPERTS), D_MODEL ** -0.5)
    odd_moe_w_gate = nrm((N_ODD, N_EXPERTS, D_MODEL, FFN_DIM), D_MODEL ** -0.5)
    odd_moe_w_up = nrm((N_ODD, N_EXPERTS, D_MODEL, FFN_DIM), D_MODEL ** -0.5)
    odd_moe_w_down = nrm((N_ODD, N_EXPERTS, FFN_DIM, D_MODEL), FFN_DIM ** -0.5)
    return {'x': x, 'c': c, 'positions': positions, 'ada_w': ada_w, 'ada_b': ada_b,
            'mix_pre_g': mix_pre_g, 'mix_post_g': mix_post_g,
            'ffn_pre_g': ffn_pre_g, 'ffn_post_g': ffn_post_g,
            'even_w_in': even_w_in, 'even_pool_w': even_pool_w,
            'even_pool_scale': even_pool_scale, 'even_w_out': even_w_out,
            'even_ffn_w_gate': even_ffn_w_gate, 'even_ffn_w_up': even_ffn_w_up,
            'even_ffn_w_down': even_ffn_w_down,
            'odd_w_in': odd_w_in, 'odd_conv_w': odd_conv_w, 'odd_a_log': odd_a_log,
            'odd_dt_bias': odd_dt_bias, 'odd_norm_g': odd_norm_g, 'odd_w_out': odd_w_out,
            'odd_router_w': odd_router_w, 'odd_moe_w_gate': odd_moe_w_gate,
            'odd_moe_w_up': odd_moe_w_up, 'odd_moe_w_down': odd_moe_w_down}


def reference(x, c, positions, ada_w, ada_b, mix_pre_g, mix_post_g, ffn_pre_g, ffn_post_g,
              even_w_in, even_pool_w, even_pool_scale, even_w_out,
              even_ffn_w_gate, even_ffn_w_up, even_ffn_w_down,
              odd_w_in, odd_conv_w, odd_a_log, odd_dt_bias, odd_norm_g, odd_w_out,
              odd_router_w, odd_moe_w_gate, odd_moe_w_up, odd_moe_w_down):
    c_act = jax.nn.silu(c)
    for layer in range(DEPTH):
        j = layer // 2
        mod = c_act @ ada_w[layer] + ada_b[layer]
        sh1, sc1, gt1, sh2, sc2, gt2 = jnp.split(mod, 6, axis=-1)
        h = _rmsnorm(x, mix_pre_g[layer]) * (1.0 + sc1[:, None, :]) + sh1[:, None, :]
        if layer % 2 == 0:
            y = _even_mixer(h, positions, even_w_in[j], even_pool_w[j], even_pool_scale[j], even_w_out[j])
        else:
            y = _odd_mixer(h, odd_w_in[j], odd_conv_w[j], odd_a_log[j], odd_dt_bias[j],
                           odd_norm_g[j], odd_w_out[j])
        x = x + gt1[:, None, :] * _rmsnorm(y, mix_post_g[layer])
        h = _rmsnorm(x, ffn_pre_g[layer]) * (1.0 + sc2[:, None, :]) + sh2[:, None, :]
        if layer % 2 == 0:
            y = _swiglu(h, even_ffn_w_gate[j], even_ffn_w_up[j], even_ffn_w_down[j])
        else:
            y = _moe(h, odd_router_w[j], odd_moe_w_gate[j], odd_moe_w_up[j], odd_moe_w_down[j])
        x = x + gt2[:, None, :] * _rmsnorm(y, ffn_post_g[layer])
    return x
```

```cpp
#include <hip/hip_runtime.h>
#include <cstdio>
#include <cstdint>

#ifndef CONV_IN_SCAN
#define CONV_IN_SCAN 1
#endif
#define GAS __attribute__((address_space(1)))
#define LAS __attribute__((address_space(3)))
typedef unsigned short bf16;
typedef float f32x4 __attribute__((ext_vector_type(4)));
typedef float f32x2 __attribute__((ext_vector_type(2)));
typedef short bf16x8 __attribute__((ext_vector_type(8)));
typedef short s16x4 __attribute__((ext_vector_type(4)));
typedef unsigned v4u __attribute__((ext_vector_type(4)));
typedef unsigned v2u __attribute__((ext_vector_type(2)));

constexpr int NB = 2, T = 8192, D = 1024, M = NB * T;
constexpr int AH = 8, AHD = 64, AW = 512;
constexpr int L0N = 2048;
constexpr int FF = 3584;
constexpr int DH = 8, DHD = 128;
constexpr int L1N = 4112;
constexpr int NE = 8;
constexpr int CH = 64, NCH = T / CH;
constexpr float EPS = 1e-6f;
constexpr int MAXTILES = 136;
constexpr int MAXROWS = MAXTILES * 256;

constexpr size_t MiB = 1u << 20;
constexpr size_t WS_CTL = 0, CTL_BYTES = 1 * MiB;
constexpr size_t WS_MOD = 1 * MiB;
constexpr size_t WS_ROPE = 2 * MiB;
constexpr size_t WS_BL = 3 * MiB;
constexpr size_t WS_ROUTE = 4 * MiB;
constexpr size_t WS_LSE = 5 * MiB;
constexpr size_t WS_POOLWT = 7 * MiB;
constexpr size_t WS_H = 8 * MiB;
constexpr size_t WS_WB_L1IN = 40 * MiB;
constexpr size_t WS_WB_L1OUT = 48 * MiB;
constexpr size_t WS_WB_L0IN = 50 * MiB;
constexpr size_t WS_WB_L0OUT = 54 * MiB;
constexpr size_t WS_WB_L0GU = 56 * MiB;
constexpr size_t WS_WB_L0DN = 70 * MiB;
constexpr size_t WS_Y = 78 * MiB;
constexpr size_t WS_MIX = 110 * MiB;
constexpr size_t WS_G0 = 142 * MiB;
constexpr size_t WS_PROJ0 = WS_G0;
constexpr size_t WS_ATTP = WS_G0 + 64 * MiB;
constexpr size_t WS_HID0 = WS_G0 + 112 * MiB;
constexpr size_t WS_QKV = WS_G0;
constexpr size_t WS_GATE = WS_G0 + 96 * MiB;
constexpr size_t WS_WF = WS_G0 + 128 * MiB;
constexpr size_t WS_QGF = WS_G0 + 160 * MiB;
constexpr size_t WS_KGF = WS_G0 + 192 * MiB;
constexpr size_t WS_ATF = WS_G0 + 224 * MiB;
constexpr size_t WS_UF = WS_G0 + 240 * MiB;
constexpr size_t WS_O = WS_G0 + 304 * MiB;
constexpr size_t WS_SBF = WS_G0 + 304 * MiB;
constexpr size_t WS_VBF = WS_H;
constexpr size_t WS_CDEC = 6 * MiB + 512 * 1024;
constexpr size_t WS_ASORT = 8 * MiB;
constexpr size_t WS_YS = 42 * MiB;
constexpr size_t WS_WB_GU = WS_G0;
constexpr size_t WS_WB_DN = WS_G0 + 56 * MiB;
constexpr size_t WS_H2 = WS_G0 + 84 * MiB;
constexpr size_t WS_HID = WS_G0 + 112 * MiB;
constexpr size_t WS_NEED = 512 * MiB;
constexpr int CW_BAR = 4096;
constexpr int CW_CNT = 120000;
constexpr int CW_TP = 130000;

__device__ __forceinline__ unsigned f2bf(float f) { unsigned u = __builtin_bit_cast(unsigned, f); return (u + 0x7fffu + ((u >> 16) & 1u)) >> 16; }
typedef __bf16 bf16x2_t __attribute__((ext_vector_type(2)));
__device__ __forceinline__ unsigned pk2(float lo, float hi) { const f32x2 v = {lo, hi}; return __builtin_bit_cast(unsigned, __builtin_convertvector(v, bf16x2_t)); }
__device__ __forceinline__ float bf2f(unsigned b) { return __builtin_bit_cast(float, (b & 0xffffu) << 16); }
__device__ __forceinline__ float bflo(unsigned w) { return __builtin_bit_cast(float, w << 16); }
__device__ __forceinline__ float bfhi(unsigned w) { return __builtin_bit_cast(float, w & 0xffff0000u); }
__device__ __forceinline__ unsigned pk4f8(float a, float b, float c, float d) {
    a = __builtin_amdgcn_fmed3f(a, -448.f, 448.f); b = __builtin_amdgcn_fmed3f(b, -448.f, 448.f); c = __builtin_amdgcn_fmed3f(c, -448.f, 448.f); d = __builtin_amdgcn_fmed3f(d, -448.f, 448.f);
    unsigned w = 0u; w = __builtin_amdgcn_cvt_pk_fp8_f32(a, b, w, false); w = __builtin_amdgcn_cvt_pk_fp8_f32(c, d, w, true); return w; }
#define DPP_ADD(v, ctrl) v += __builtin_bit_cast(float, __builtin_amdgcn_mov_dpp(__builtin_bit_cast(int, v), ctrl, 0xf, 0xf, true))
__device__ __forceinline__ float row16_sum(float v) { DPP_ADD(v, 0xB1); DPP_ADD(v, 0x4E); DPP_ADD(v, 0x141); DPP_ADD(v, 0x140); return v; }
__device__ __forceinline__ float row8_sum(float v) { DPP_ADD(v, 0xB1); DPP_ADD(v, 0x4E); DPP_ADD(v, 0x141); return v; }
__device__ __forceinline__ float wave_sum(float v) {
    const int r = __builtin_bit_cast(int, row16_sum(v));
    return (__builtin_bit_cast(float, __builtin_amdgcn_readlane(r, 0)) + __builtin_bit_cast(float, __builtin_amdgcn_readlane(r, 16))) + (__builtin_bit_cast(float, __builtin_amdgcn_readlane(r, 32)) + __builtin_bit_cast(float, __builtin_amdgcn_readlane(r, 48)));
}
__device__ __forceinline__ float silu_f(float x) { return x * __builtin_amdgcn_rcpf(1.f + __expf(-x)); }
__device__ __forceinline__ float sigmoid_f(float x) { return __builtin_amdgcn_rcpf(1.f + __expf(-x)); }
__device__ __forceinline__ float softplus_f(float x) { return fmaxf(x, 0.f) + log1pf(__expf(-fabsf(x))); }
#define XB_TMO      128
#define XB_XCNT(j)  (256  + 64 * (j))
#define XB_XSUB(j)  (1280 + 64 * (j))
#define XB_XGEN(j)  (2304 + 64 * (j))
#define XB_TOP      3328
#define XB_TOPGEN   3392
#define XCD_BAR_WORDS 3456
#define XB_SPIN_CAP (1u << 18)

__device__ __forceinline__ unsigned xb_ld(unsigned* p)              { return __hip_atomic_load(p, __ATOMIC_RELAXED, __HIP_MEMORY_SCOPE_AGENT); }
__device__ __forceinline__ unsigned xb_add(unsigned* p, unsigned v) { return __hip_atomic_fetch_add(p, v, __ATOMIC_RELAXED, __HIP_MEMORY_SCOPE_AGENT); }
__device__ __forceinline__ unsigned xb_xcc_id() { return (unsigned)__builtin_amdgcn_s_getreg((3 << 11) | 20) & 0xFu; }
#define XB_SPIN(cond, bar) do { unsigned _sp = 0; while (cond) { __builtin_amdgcn_s_sleep(1); \
    if ((++_sp & 255u) == 0u) { if (xb_ld(&(bar)[XB_TMO])) break; if (_sp > XB_SPIN_CAP) { atomicAdd(&(bar)[XB_TMO], 1u); break; } } } } while (0)

struct XcdBarrier {
    unsigned* bar; unsigned x;
    volatile LAS unsigned* st;
};

__device__ __forceinline__ XcdBarrier xcd_barrier_post(unsigned* bar, volatile LAS unsigned* st) {
    XcdBarrier b; b.bar = bar; b.x = xb_xcc_id(); b.st = st;
    if (threadIdx.x == 0) (void)xb_add(&bar[XB_XCNT(b.x)], 1u);
    return b;
}
__device__ __forceinline__ void xcd_barrier_complete(unsigned* bar, unsigned x, unsigned& nloc, unsigned& nx) {
    const unsigned G = gridDim.x * gridDim.y * gridDim.z;
    unsigned sum, cnt, mine, sp = 0u;
    for (;;) {
        sum = 0u; cnt = 0u; mine = 0u;
#pragma unroll
        for (unsigned j = 0; j < 16; ++j) { const unsigned c = xb_ld(&bar[XB_XCNT(j)]); sum += c; cnt += (c > 0u) ? 1u : 0u; mine = (j == x) ? c : mine; }
        if (sum == G) break;
        __builtin_amdgcn_s_sleep(1);
        if ((++sp & 255u) == 0u) { if (xb_ld(&bar[XB_TMO])) break; if (sp > XB_SPIN_CAP) { atomicAdd(&bar[XB_TMO], 1u); break; } }
    }
    nloc = mine > 0u ? mine : 1u; nx = cnt > 0u ? cnt : 1u;
}

__device__ __forceinline__ void xcd_barrier(const XcdBarrier& b) {
    asm volatile("s_waitcnt vmcnt(0)" ::: "memory");
    __syncthreads();
    if (threadIdx.x == 0) {
        unsigned* bar = b.bar;
        __builtin_amdgcn_s_waitcnt(0);
        unsigned nloc = b.st[0], nx = b.st[1];
        if (nloc == 0u) { xcd_barrier_complete(bar, b.x, nloc, nx); b.st[0] = nloc; b.st[1] = nx; }
        const unsigned old = xb_add(&bar[XB_XSUB(b.x)], 1u);
        const unsigned gen = old / nloc;
        if (old + 1u == (gen + 1u) * nloc) {
            __builtin_amdgcn_fence(__ATOMIC_RELEASE, "agent");
            asm volatile("s_waitcnt vmcnt(0)" ::: "memory");
            const unsigned og = xb_add(&bar[XB_TOP], 1u);
            const unsigned tg = og / nx;
            if (og + 1u == (tg + 1u) * nx) xb_add(&bar[XB_TOPGEN], 1u);
            else XB_SPIN(xb_ld(&bar[XB_TOPGEN]) == tg, bar);
            __builtin_amdgcn_fence(__ATOMIC_ACQUIRE, "agent");
            xb_add(&bar[XB_XGEN(b.x)], 1u);
            asm volatile("s_waitcnt vmcnt(0)" ::: "memory");
        } else {
            XB_SPIN(xb_ld(&bar[XB_XGEN(b.x)]) == gen, bar);
            __builtin_amdgcn_fence(__ATOMIC_ACQUIRE, "agent");
            asm volatile("s_waitcnt vmcnt(0)" ::: "memory");
        }
    }
    __syncthreads();
}

constexpr int NWAVES = 8, NTHR = 512;
constexpr int LDS_BYTES = 147456;
constexpr int RING_BYTES = 131072;
constexpr int MISC_OFF = LDS_BYTES - 256;
constexpr int GRID = 256;
constexpr int RPB = M / GRID;
static_assert(RPB == 64, "thin phases assume 64 rows per workgroup");

struct Args { const void* in[26]; float* out; unsigned char* ws; int ph_lo, ph_hi, li, pad; };
struct Frame {
    LAS unsigned char* lds;
    int tid, lane, wave, blk;
    const float *x, *c; const int* pos; const float *ada_w, *ada_b, *mix_pre_g, *mix_post_g, *ffn_pre_g, *ffn_post_g;
    const float *e_w_in, *e_pool_w, *e_pool_scale, *e_w_out, *e_wg, *e_wu, *e_wd;
    const float *o_w_in, *o_conv_w, *o_a_log, *o_dt_bias, *o_norm_g, *o_w_out, *o_router, *o_mg, *o_mu, *o_md;
    float* out; unsigned char* ws;
};
__device__ __forceinline__ void frame_init(Frame& F, const Args& a, LAS unsigned char* lds) {
    F.lds = lds; F.tid = threadIdx.x; F.lane = F.tid & 63; F.wave = __builtin_amdgcn_readfirstlane(F.tid >> 6); F.blk = blockIdx.x;
    F.x = (const float*)a.in[0]; F.c = (const float*)a.in[1]; F.pos = (const int*)a.in[2]; F.ada_w = (const float*)a.in[3]; F.ada_b = (const float*)a.in[4];
    F.mix_pre_g = (const float*)a.in[5]; F.mix_post_g = (const float*)a.in[6]; F.ffn_pre_g = (const float*)a.in[7]; F.ffn_post_g = (const float*)a.in[8];
    F.e_w_in = (const float*)a.in[9]; F.e_pool_w = (const float*)a.in[10]; F.e_pool_scale = (const float*)a.in[11]; F.e_w_out = (const float*)a.in[12];
    F.e_wg = (const float*)a.in[13]; F.e_wu = (const float*)a.in[14]; F.e_wd = (const float*)a.in[15];
    F.o_w_in = (const float*)a.in[16]; F.o_conv_w = (const float*)a.in[17]; F.o_a_log = (const float*)a.in[18]; F.o_dt_bias = (const float*)a.in[19];
    F.o_norm_g = (const float*)a.in[20]; F.o_w_out = (const float*)a.in[21]; F.o_router = (const float*)a.in[22];
    F.o_mg = (const float*)a.in[23]; F.o_mu = (const float*)a.in[24]; F.o_md = (const float*)a.in[25];
    F.out = a.out; F.ws = a.ws;
}
#define WSP(T_, off) ((T_*)(F.ws + (off)))

__device__ __forceinline__ void ld_row_f32(const float* p, int lane, f32x4 (&v)[4]) {
    const f32x4* q = (const f32x4*)p + lane;
#pragma unroll
    for (int j = 0; j < 4; ++j) v[j] = q[64 * j];
}
__device__ __forceinline__ void ld_row_bf16(const bf16* p, int lane, f32x4 (&v)[4]) {
    const v2u* q = (const v2u*)p + lane;
#pragma unroll
    for (int j = 0; j < 4; ++j) { const v2u w = q[64 * j]; v[j] = (f32x4){bflo(w.x), bfhi(w.x), bflo(w.y), bfhi(w.y)}; }
}
__device__ __forceinline__ void st_row_f32(float* p, int lane, const f32x4 (&v)[4]) {
    f32x4* q = (f32x4*)p + lane;
#pragma unroll
    for (int j = 0; j < 4; ++j) q[64 * j] = v[j];
}
__device__ __forceinline__ void st_row_bf16(bf16* p, int lane, const f32x4 (&v)[4]) {
    v2u* q = (v2u*)p + lane;
#pragma unroll
    for (int j = 0; j < 4; ++j) { v2u w; w.x = pk2(v[j].x, v[j].y); w.y = pk2(v[j].z, v[j].w); q[64 * j] = w; }
}
__device__ __forceinline__ float row_rinv(const f32x4 (&v)[4]) {
    float s = 0.f;
#pragma unroll
    for (int j = 0; j < 4; ++j) s += (v[j].x * v[j].x + v[j].y * v[j].y) + (v[j].z * v[j].z + v[j].w * v[j].w);
    return 1.0f / sqrtf(wave_sum(s) * (1.f / D) + EPS);
}
__device__ __forceinline__ void row_mod(const f32x4 (&v)[4], float r, const float* g, const float* sc, const float* sh, int lane, f32x4 (&h)[4]) {
    f32x4 gv[4], scv[4], shv[4]; ld_row_f32(g, lane, gv); ld_row_f32(sc, lane, scv); ld_row_f32(sh, lane, shv);
#pragma unroll
    for (int j = 0; j < 4; ++j) h[j] = v[j] * r * gv[j] * (scv[j] + 1.0f) + shv[j];
}
__device__ __forceinline__ void row_resid(const f32x4 (&xi)[4], const f32x4 (&y)[4], float ry, const float* pg, const float* gt, int lane, f32x4 (&xo)[4]) {
    f32x4 gv[4], gtv[4]; ld_row_f32(pg, lane, gv); ld_row_f32(gt, lane, gtv);
#pragma unroll
    for (int j = 0; j < 4; ++j) xo[j] = xi[j] + gtv[j] * (y[j] * ry * gv[j]);
}
__device__ __forceinline__ void row_mod_r(const f32x4 (&v)[4], float r, const f32x4 (&gv)[4], const f32x4 (&scv)[4], const f32x4 (&shv)[4], f32x4 (&h)[4]) {
#pragma unroll
    for (int j = 0; j < 4; ++j) h[j] = v[j] * r * gv[j] * (scv[j] + 1.0f) + shv[j];
}
__device__ __forceinline__ void row_resid_r(const f32x4 (&xi)[4], const f32x4 (&y)[4], float ry, const f32x4 (&gv)[4], const f32x4 (&gtv)[4], f32x4 (&xo)[4]) {
#pragma unroll
    for (int j = 0; j < 4; ++j) xo[j] = xi[j] + gtv[j] * (y[j] * ry * gv[j]);
}
__device__ __forceinline__ void ld_row_bf16_raw(const bf16* p, int lane, v2u (&w)[4]) {
    const v2u* q = (const v2u*)p + lane;
#pragma unroll
    for (int j = 0; j < 4; ++j) w[j] = q[64 * j];
}
__device__ __forceinline__ void cvt_row_bf16(const v2u (&w)[4], f32x4 (&v)[4]) {
#pragma unroll
    for (int j = 0; j < 4; ++j) v[j] = (f32x4){bflo(w[j].x), bfhi(w[j].x), bflo(w[j].y), bfhi(w[j].y)};
}
#define MODP(l, b, k) (WSP(const float, WS_MOD) + ((l) * 2 + (b)) * 6144 + (k) * 1024)

__device__ __forceinline__ void ph_mod_rope(Frame& F) {
    LAS float* red = (LAS float*)F.lds;
    LAS float* cact = red + 1024;
    for (int i = F.tid; i < 2 * D; i += NTHR) cact[i] = silu_f(F.c[i]);
    __syncthreads();
    for (int u = F.blk; u < 192; u += GRID) {
        const int l = u / 96, n = (u % 96) * 64 + F.lane;
        const float* W = F.ada_w + (size_t)l * D * 6144 + n;
        float a0 = 0.f, a1 = 0.f;
#pragma unroll 1
        for (int k0 = F.wave * 128; k0 < F.wave * 128 + 128; k0 += 16) {
            float wv[16];
#pragma unroll
            for (int q = 0; q < 16; ++q) wv[q] = __builtin_nontemporal_load(W + (size_t)(k0 + q) * 6144);
#pragma unroll
            for (int q = 0; q < 16; ++q) { a0 += cact[k0 + q] * wv[q]; a1 += cact[D + k0 + q] * wv[q]; }
        }
        red[(F.wave * 2 + 0) * 64 + F.lane] = a0; red[(F.wave * 2 + 1) * 64 + F.lane] = a1;
        __syncthreads();
        if (F.wave == 0) {
            float s0 = 0.f, s1 = 0.f;
#pragma unroll
            for (int w = 0; w < 8; ++w) { s0 += red[(w * 2 + 0) * 64 + F.lane]; s1 += red[(w * 2 + 1) * 64 + F.lane]; }
            const float bb = F.ada_b[l * 6144 + n];
            float* MOD = WSP(float, WS_MOD);
            MOD[(l * 2 + 0) * 6144 + n] = s0 + bb; MOD[(l * 2 + 1) * 6144 + n] = s1 + bb;
        }
        __syncthreads();
    }
    const float invf[8] = {1.0f, 0.1939227432012558f, 0.03760603070259094f, 0.007292664609849453f, 0.0014142135623842478f, 0.00027424818836152554f, 5.318296098266728e-05f, 1.0313386155758053e-05f};
    float* ROPE = WSP(float, WS_ROPE);
    for (int idx = F.blk * NTHR + F.tid; idx < M * 8; idx += GRID * NTHR) {
        const int m = idx >> 3, i = idx & 7;
        float fi = invf[0];
#pragma unroll
        for (int q = 1; q < 8; ++q) fi = (i == q) ? invf[q] : fi;
        const float ang = (float)F.pos[m] * fi;
        const double a = (double)ang, n2 = rint(a * 0.15915494309189535), r = a - n2 * 6.283185307179586;
        const float rf = (float)r;
        ROPE[m * 16 + i] = cosf(rf); ROPE[m * 16 + 8 + i] = sinf(rf);
    }
}

__device__ __forceinline__ void ph_norm_a(Frame& F) {
    bf16* H = WSP(bf16, WS_H);
    const int m0 = F.blk * RPB + F.wave * 8, b = m0 / T;
    f32x4 gv[4], scv[4], shv[4]; ld_row_f32(F.mix_pre_g, F.lane, gv); ld_row_f32(MODP(0, b, 1), F.lane, scv); ld_row_f32(MODP(0, b, 0), F.lane, shv);
    f32x4 vn[4]; ld_row_f32(F.x + (size_t)m0 * D, F.lane, vn);
#pragma unroll 1
    for (int i = 0; i < 8; ++i) {
        const int m = m0 + i;
        f32x4 v[4], h[4];
#pragma unroll
        for (int j = 0; j < 4; ++j) v[j] = vn[j];
        if (i < 7) ld_row_f32(F.x + (size_t)(m + 1) * D, F.lane, vn);
        const float r = row_rinv(v);
        row_mod_r(v, r, gv, scv, shv, h);
        st_row_bf16(H + (size_t)m * D, F.lane, h);
    }
}
template <int KIND> __device__ __forceinline__ void ph_norm_mid(Frame& F) {
    const bf16* Y = WSP(const bf16, WS_Y);
    bf16* H = WSP(bf16, WS_H);
    LAS float* WT = (LAS float*)F.lds;
    LAS int* selE = (LAS int*)(F.lds + 65536);
    LAS int* selR = (LAS int*)(F.lds + 65536 + 512);
    LAS int* cntE = (LAS int*)(F.lds + 65536 + 1024);
    if (KIND == 1) { for (int i = F.tid; i < 16 * D; i += NTHR) { const int k = i >> 4, j = i & 15; WT[j * D + k] = F.o_w_in[(size_t)k * L1N + 4096 + j]; } __syncthreads(); }
    if (KIND == 2) { for (int i = F.tid; i < 8 * D; i += NTHR) { const int k = i >> 3, j = i & 7; WT[j * D + k] = F.o_router[k * 8 + j]; } __syncthreads(); }
    const int mrow0 = F.blk * RPB + F.wave * 8, b = mrow0 / T;
    const bf16* xsb = (const bf16*)F.out; bf16* xdb = (KIND == 2) ? WSP(bf16, WS_MIX) : (bf16*)F.out;
    f32x4 pgv[4], gtv[4], g2v[4], scv[4], shv[4];
    if (KIND == 0) { ld_row_f32(F.mix_post_g, F.lane, pgv); ld_row_f32(MODP(0, b, 2), F.lane, gtv); ld_row_f32(F.ffn_pre_g, F.lane, g2v); ld_row_f32(MODP(0, b, 4), F.lane, scv); ld_row_f32(MODP(0, b, 3), F.lane, shv); }
    if (KIND == 1) { ld_row_f32(F.ffn_post_g, F.lane, pgv); ld_row_f32(MODP(0, b, 5), F.lane, gtv); ld_row_f32(F.mix_pre_g + D, F.lane, g2v); ld_row_f32(MODP(1, b, 1), F.lane, scv); ld_row_f32(MODP(1, b, 0), F.lane, shv); }
    if (KIND == 2) { ld_row_f32(F.mix_post_g + D, F.lane, pgv); ld_row_f32(MODP(1, b, 2), F.lane, gtv); ld_row_f32(F.ffn_pre_g + D, F.lane, g2v); ld_row_f32(MODP(1, b, 4), F.lane, scv); ld_row_f32(MODP(1, b, 3), F.lane, shv); }
    f32x4 xnx[4]; v2u xnb[4], ynx[4];
    if (KIND == 0) ld_row_f32(F.x + (size_t)mrow0 * D, F.lane, xnx); else ld_row_bf16_raw(xsb + (size_t)mrow0 * D, F.lane, xnb);
    ld_row_bf16_raw(Y + (size_t)mrow0 * D, F.lane, ynx);
    _Pragma("unroll 1") for (int i = 0; i < 8; ++i) {
        const int lt = F.wave * 8 + i, m = F.blk * RPB + lt;
        f32x4 xi[4], y[4], xo[4], h[4];
        if (KIND == 0) {
#pragma unroll
            for (int j = 0; j < 4; ++j) xi[j] = xnx[j];
        } else cvt_row_bf16(xnb, xi);
        cvt_row_bf16(ynx, y);
        if (i < 7) { if (KIND == 0) ld_row_f32(F.x + (size_t)(m + 1) * D, F.lane, xnx); else ld_row_bf16_raw(xsb + (size_t)(m + 1) * D, F.lane, xnb);
            ld_row_bf16_raw(Y + (size_t)(m + 1) * D, F.lane, ynx); }
        const float ry = row_rinv(y);
        row_resid_r(xi, y, ry, pgv, gtv, xo);
        st_row_bf16(xdb + (size_t)m * D, F.lane, xo);
        const float r = row_rinv(xo);
        row_mod_r(xo, r, g2v, scv, shv, h);
        if (KIND == 2) { unsigned* q = WSP(unsigned, WS_H2) + (size_t)m * (D / 4) + F.lane;
#pragma unroll
            for (int j = 0; j < 4; ++j) q[64 * j] = pk4f8(h[j].x, h[j].y, h[j].z, h[j].w); }
        else st_row_bf16(H + (size_t)m * D, F.lane, h);
        if (KIND == 1) {
            float* BL = WSP(float, WS_BL);
            float mine = 0.f;
#pragma unroll 1
            for (int j = 0; j < 16; ++j) {
                float a = 0.f;
#pragma unroll
                for (int jj = 0; jj < 4; ++jj) { const f32x4 w = *(const LAS f32x4*)(WT + j * D + 4 * F.lane + 256 * jj); a += (h[jj].x * w.x + h[jj].y * w.y) + (h[jj].z * w.z + h[jj].w * w.w); }
                a = wave_sum(a); mine = (F.lane == j) ? a : mine;
            }
            if (F.lane < 16) BL[(size_t)m * 16 + F.lane] = mine;
        }
        if (KIND == 2) {
            float lg[8];
#pragma unroll
            for (int j = 0; j < 8; ++j) {
                float a = 0.f;
#pragma unroll
                for (int jj = 0; jj < 4; ++jj) { const f32x4 w = *(const LAS f32x4*)(WT + j * D + 4 * F.lane + 256 * jj); a += (h[jj].x * w.x + h[jj].y * w.y) + (h[jj].z * w.z + h[jj].w * w.w); }
                lg[j] = wave_sum(a);
            }
            int e0 = 0; float v0 = lg[0];
#pragma unroll
            for (int j = 1; j < 8; ++j) if (lg[j] > v0) { v0 = lg[j]; e0 = j; }
            int e1 = -1; float v1 = -3.0e38f;
#pragma unroll
            for (int j = 0; j < 8; ++j) if (j != e0 && lg[j] > v1) { v1 = lg[j]; e1 = j; }
            const float w0 = 1.f / (1.f + __expf(v1 - v0)), w1 = 1.f - w0;
            if (F.lane == 0) {
                unsigned* R = WSP(unsigned, WS_ROUTE) + (size_t)m * 8;
                R[0] = (unsigned)e0; R[1] = (unsigned)e1; R[2] = __builtin_bit_cast(unsigned, w0); R[3] = __builtin_bit_cast(unsigned, w1);
                selE[lt * 2 + 0] = e0; selE[lt * 2 + 1] = e1;
            }
        }
    }
    if (KIND == 2) {
        __syncthreads();
        if (F.tid < 8) { int c = 0; for (int q = 0; q < 2 * RPB; ++q) { if (selE[q] == F.tid) { selR[q] = c; ++c; } } cntE[F.tid] = c; }
        __syncthreads();
        if (F.tid < 2 * RPB) { const int lt = F.tid >> 1, k = F.tid & 1; WSP(unsigned, WS_ROUTE)[(size_t)(F.blk * RPB + lt) * 8 + 4 + k] = (unsigned)selR[F.tid]; }
        if (F.tid < 8) WSP(int, WS_CTL)[CW_CNT + F.blk * 8 + F.tid] = cntE[F.tid];
    }
}
__device__ __forceinline__ void ph_gated_norm(Frame& F) {
    const float* O = WSP(const float, WS_O); const bf16* GT = WSP(const bf16, WS_GATE); bf16* MIX = WSP(bf16, WS_MIX);
    const f32x4 ng = *((const f32x4*)F.o_norm_g + (F.lane & 31));
    const int m0 = F.blk * RPB + F.wave * 8;
    f32x4 on[4]; v2u gn[4]; ld_row_f32(O + (size_t)m0 * D, F.lane, on); ld_row_bf16_raw(GT + (size_t)m0 * D, F.lane, gn);
    _Pragma("unroll 1") for (int i = 0; i < 8; ++i) {
        const int m = m0 + i;
        f32x4 o[4], g[4], r[4];
#pragma unroll
        for (int j = 0; j < 4; ++j) o[j] = on[j];
        cvt_row_bf16(gn, g);
        if (i < 7) { ld_row_f32(O + (size_t)(m + 1) * D, F.lane, on); ld_row_bf16_raw(GT + (size_t)(m + 1) * D, F.lane, gn); }
#pragma unroll
        for (int j = 0; j < 4; ++j) {
            float s = (o[j].x * o[j].x + o[j].y * o[j].y) + (o[j].z * o[j].z + o[j].w * o[j].w);
#pragma unroll
            for (int q = 1; q < 32; q <<= 1) s += __shfl_xor(s, q);
            const float rr = 1.0f / sqrtf(s * (1.f / DHD) + EPS);
            r[j].x = o[j].x * rr * ng.x * silu_f(g[j].x); r[j].y = o[j].y * rr * ng.y * silu_f(g[j].y);
            r[j].z = o[j].z * rr * ng.z * silu_f(g[j].z); r[j].w = o[j].w * rr * ng.w * silu_f(g[j].w);
        }
        st_row_bf16(MIX + (size_t)m * D, F.lane, r);
    }
}
__device__ __forceinline__ void ph_moe_gather(Frame& F) {
    LAS int* cnt = (LAS int*)F.lds;
    LAS int* tot = cnt + GRID * 8;
    LAS int* myo = tot + 8; LAS int* tp = myo + 8;
    const int* C = WSP(const int, WS_CTL) + CW_CNT;
    for (int i = F.tid; i < GRID * 8; i += NTHR) cnt[i] = C[i];
    __syncthreads();
    if (F.tid < 8) { int s = 0, mo = 0; for (int b = 0; b < GRID; ++b) { if (b == F.blk) mo = s; s += cnt[b * 8 + F.tid]; } tot[F.tid] = s; myo[F.tid] = mo; }
    __syncthreads();
    if (F.tid == 0) { int p = 0; for (int e = 0; e < 8; ++e) { tp[e] = p; p += (tot[e] + 255) >> 8; } tp[8] = p; }
    __syncthreads();
    if (F.blk == 0 && F.tid < 9) WSP(int, WS_CTL)[CW_TP + F.tid] = tp[F.tid];
    const unsigned char* H2 = F.ws + WS_H2; unsigned char* AS = F.ws + WS_ASORT;
    const int m0 = F.blk * RPB + F.wave * 8;
    v4u rw0[8], rw1[8], dat[8];
#pragma unroll
    for (int i = 0; i < 8; ++i) { const v4u* R = (const v4u*)(WSP(const unsigned, WS_ROUTE) + (size_t)(m0 + i) * 8); rw0[i] = R[0]; rw1[i] = R[1]; dat[i] = *((const v4u*)(H2 + (size_t)(m0 + i) * D) + F.lane); }
#pragma unroll
    for (int i = 0; i < 8; ++i) {
        const int m = m0 + i;
        const int e0 = (int)rw0[i].x, e1 = (int)rw0[i].y, r0 = (int)rw1[i].x, r1 = (int)rw1[i].y;
        const int d0 = tp[e0] * 256 + myo[e0] + r0, d1 = tp[e1] * 256 + myo[e1] + r1;
        if (F.lane == 0) { unsigned* R = WSP(unsigned, WS_ROUTE) + (size_t)m * 8; R[6] = (unsigned)d0; R[7] = (unsigned)d1; }
        *((v4u*)(AS + (size_t)d0 * D) + F.lane) = dat[i]; *((v4u*)(AS + (size_t)d1 * D) + F.lane) = dat[i];
    }
}
__device__ __forceinline__ void ph_final(Frame& F) {
    const bf16* YS = WSP(const bf16, WS_YS);
    const int m0 = F.blk * RPB + F.wave * 8, b = m0 / T;
    f32x4 pgv[4], gtv[4]; ld_row_f32(F.ffn_post_g + D, F.lane, pgv); ld_row_f32(MODP(1, b, 5), F.lane, gtv);
    const unsigned* R = WSP(const unsigned, WS_ROUTE) + (size_t)m0 * 8;
    const bf16* X3 = WSP(const bf16, WS_MIX);
    v2u xn[4], y0n[4], y1n[4]; float w0n, w1n;
    { w0n = __builtin_bit_cast(float, R[2]); w1n = __builtin_bit_cast(float, R[3]); const int d0 = (int)R[6], d1 = (int)R[7];
      ld_row_bf16_raw(X3 + (size_t)m0 * D, F.lane, xn); ld_row_bf16_raw(YS + (size_t)d0 * D, F.lane, y0n); ld_row_bf16_raw(YS + (size_t)d1 * D, F.lane, y1n); }
    _Pragma("unroll 1") for (int i = 0; i < 8; ++i) {
        const int m = m0 + i;
        f32x4 xi[4], y0[4], y1[4], y[4], xo[4]; const float w0 = w0n, w1 = w1n;
        cvt_row_bf16(xn, xi);
        cvt_row_bf16(y0n, y0); cvt_row_bf16(y1n, y1);
        if (i < 7) { const unsigned* Rn = R + (size_t)(i + 1) * 8; w0n = __builtin_bit_cast(float, Rn[2]); w1n = __builtin_bit_cast(float, Rn[3]); const int d0 = (int)Rn[6], d1 = (int)Rn[7];
            ld_row_bf16_raw(X3 + (size_t)(m + 1) * D, F.lane, xn); ld_row_bf16_raw(YS + (size_t)d0 * D, F.lane, y0n); ld_row_bf16_raw(YS + (size_t)d1 * D, F.lane, y1n); }
#pragma unroll
        for (int j = 0; j < 4; ++j) y[j] = y0[j] * w0 + y1[j] * w1;
        const float ry = row_rinv(y);
        row_resid_r(xi, y, ry, pgv, gtv, xo);
        st_row_f32(F.out + (size_t)m * D, F.lane, xo);
    }
}
namespace pg8 {
#define PG8_LAS __attribute__((address_space(3)))
typedef unsigned short bf16_t;
typedef unsigned u32x4 __attribute__((ext_vector_type(4)));
constexpr int BM = 256, BK = 64, HALF = 128, HTB = HALF * BK * 2  , STAGE_BYTES = 8 * HTB, NXCD = 8, WGM = 8;

__host__ __device__ __forceinline__ int lds_byte(int r, int c) { const int st = (r >> 4) * 2 + (c >> 5), rr = r & 15, cc = c & 31, ob = rr * 64 + cc * 2; return st * 1024 + (ob ^ (((ob >> 9) & 1) << 5)); }
__host__ __device__ __forceinline__ void stage_rc(int b, int& R, int& C) { const int st = b / 1024, sb = b % 1024, swz = sb ^ (((sb >> 9) & 1) << 5); R = (st >> 1) * 16 + swz / 64; C = (st & 1) * 32 + (swz % 64) / 2; }
__host__ __device__ __forceinline__ int perm32(int rho) { const int n = rho >> 4, i = rho & 15; return 8 * (i >> 2) + 4 * n + (i & 3); }

struct Unit { int pm, pn; };
struct Gemm { const void* A; const void* Bt; int M, N, K; };

struct StaticOrder {
    int nM, nN, nwg, G, c;
    __host__ __device__ void init(int M, int N, int G_, int c_) { nM = M / BM; nN = N / BM; nwg = nM * nN; G = G_; c = c_; }
    __host__ __device__ bool next(int i, Unit& u) const {
        const long L = (long)i * G + c; if (L >= nwg) return false;
        int wgid = (int)L; { const int q = nwg / NXCD, r = nwg % NXCD, xcd = wgid % NXCD, off = wgid / NXCD; wgid = (xcd < r ? xcd * (q + 1) : r * (q + 1) + (xcd - r) * q) + off; }
        const int nig = WGM * nN, gid = wgid / nig, fm = gid * WGM, gsz = (nM - fm) < WGM ? (nM - fm) : WGM;
        u.pm = fm + ((wgid % nig) % gsz); u.pn = (wgid % nig) / gsz; return true;
    }
    __device__ __forceinline__ void a_ready(const Unit&) const {}
    __device__ __forceinline__ void done(const Unit&) const {}
};

__device__ __forceinline__ unsigned cvt_pk_bf16(float lo, float hi) { unsigned r; asm volatile("v_cvt_pk_bf16_f32 %0, %1, %2" : "=v"(r) : "v"(lo), "v"(hi)); return r; }
typedef int i32x8 __attribute__((ext_vector_type(8)));
__device__ __forceinline__ i32x8 cat16(bf16x8 a, bf16x8 b) { const u32x4 x = __builtin_bit_cast(u32x4, a), y = __builtin_bit_cast(u32x4, b); return (i32x8){(int)x[0], (int)x[1], (int)x[2], (int)x[3], (int)y[0], (int)y[1], (int)y[2], (int)y[3]}; }
template <class Epi, class Sched, bool ALIGN_EPI = false, bool SP2 = false, bool F8 = false>
__device__ __forceinline__ void gemm_phase(PG8_LAS unsigned char* lds, const Gemm g, const Sched& S, const Epi& E) {
    const int tid = threadIdx.x, wid = __builtin_amdgcn_readfirstlane(tid >> 6), lane = tid & 63, wr = wid >> 2, wc = wid & 3, fr = lane & 15, fq = lane >> 4;
    const int K = g.K, RS = F8 ? K : 2 * K  , nt = RS / 128;
    unsigned voffA[2], voffB[2];
#pragma unroll
    for (int i = 0; i < 2; ++i) { int R, C; stage_rc(tid * 16 + i * 8192, R, C); const int Rb = Epi::PERM ? ((R & ~31) + perm32(R & 31)) : R;
        voffA[i] = (unsigned)(R * RS + C * 2); voffB[i] = (unsigned)(Rb * RS + C * 2); }
    const size_t kstep = (size_t)(BK * 2);
    const size_t hstep = (size_t)HALF * RS;
    const size_t tstep = 2 * hstep;
    const unsigned ldsw = (unsigned)wid * 1024u;
    const int aoff = lds_byte(wr * 64 + fr, fq * 8), boff = lds_byte(wc * 32 + fr, fq * 8);
#define PG8_SA(b, h) (((b) * 2 + (h)) * HTB)
#define PG8_SB(b, h) ((4 + (b) * 2 + (h)) * HTB)
#define PG8_STAGE(bufoff, gbase, voff) do { _Pragma("unroll") for (int _i = 0; _i < 2; ++_i) \
        __builtin_amdgcn_global_load_lds((const unsigned*)((const char*)(gbase) + (voff)[_i]), (PG8_LAS unsigned*)(lds + (bufoff) + ldsw + _i * 8192), 16, 0, 0); } while (0)
#define PG8_LD16(p) (*(const PG8_LAS bf16x8*)(p))
#define PG8_LDA(dst, b, h) do { _Pragma("unroll") for (int m = 0; m < 4; ++m) { if constexpr (F8) dst##8[m] = cat16(PG8_LD16(lds + PG8_SA(b, h) + aoff + m * 2048), PG8_LD16(lds + PG8_SA(b, h) + aoff + m * 2048 + 1024)); \
        else { _Pragma("unroll") for (int k = 0; k < 2; ++k) dst[m][k] = PG8_LD16(lds + PG8_SA(b, h) + aoff + m * 2048 + k * 1024); } } } while (0)
#define PG8_LDB(dst, b, h) do { _Pragma("unroll") for (int n = 0; n < 2; ++n) { if constexpr (F8) dst##8[n] = cat16(PG8_LD16(lds + PG8_SB(b, h) + boff + n * 2048), PG8_LD16(lds + PG8_SB(b, h) + boff + n * 2048 + 1024)); \
        else { _Pragma("unroll") for (int k = 0; k < 2; ++k) dst[n][k] = PG8_LD16(lds + PG8_SB(b, h) + boff + n * 2048 + k * 1024); } } } while (0)
#define PG8_MMA(ai, bj, At, Bt) do { __builtin_amdgcn_s_setprio(1); _Pragma("unroll") for (int m = 0; m < 4; ++m) _Pragma("unroll") for (int n = 0; n < 2; ++n) { \
        if constexpr (F8) asm volatile("v_mfma_f32_16x16x128_f8f6f4 %0, %1, %2, %0" : "+v"(acc[ai][bj][m][n]) : "v"(Bt##8[n]), "v"(At##8[m]));     \
        else { _Pragma("unroll") for (int k = 0; k < 2; ++k) acc[ai][bj][m][n] = __builtin_amdgcn_mfma_f32_16x16x32_bf16(Bt[n][k], At[m][k], acc[ai][bj][m][n], 0, 0, 0); } } __builtin_amdgcn_s_setprio(0); } while (0)
#define PG8_WAIT_V(n) asm volatile("s_waitcnt vmcnt(" #n ")" ::: "memory")
#define PG8_WAIT_L(n) asm volatile("s_waitcnt lgkmcnt(" #n ")" ::: "memory")
#define PG8_BAR __builtin_amdgcn_s_barrier()
#define PG8_SCHED __builtin_amdgcn_sched_barrier(0)
    Unit cur, nxt; int ui = 0;
    if (!S.next(0, cur)) return;
    f32x4 acc[2][2][4][2];
#pragma unroll
    for (int a = 0; a < 2; ++a)
#pragma unroll
        for (int b = 0; b < 2; ++b)
#pragma unroll
            for (int m = 0; m < 4; ++m)
#pragma unroll
                for (int n = 0; n < 2; ++n) acc[a][b][m][n] = (f32x4){0.f, 0.f, 0.f, 0.f};
    bf16x8 At[4][2], B0[2][2], B1[2][2]; i32x8 At8[4], B08[2], B18[2];
    const char* cA = (const char*)g.A + (size_t)cur.pm * tstep; const char* cB = (const char*)g.Bt + (size_t)cur.pn * tstep;
    S.a_ready(cur);
    if constexpr (SP2) {
        PG8_STAGE(PG8_SB(0, 0), cB, voffB); PG8_STAGE(PG8_SB(0, 1), cB + hstep, voffB); PG8_STAGE(PG8_SA(0, 0), cA, voffA); PG8_STAGE(PG8_SA(0, 1), cA + hstep, voffA);
        if (wr == 1) PG8_BAR;
        PG8_WAIT_V(2); PG8_BAR;
        PG8_STAGE(PG8_SB(1, 0), cB + kstep, voffB); PG8_STAGE(PG8_SA(1, 0), cA + kstep, voffA); PG8_STAGE(PG8_SB(1, 1), cB + hstep + kstep, voffB);
        PG8_WAIT_V(6); PG8_BAR;
    } else {
        PG8_STAGE(PG8_SB(0, 0), cB, voffB); PG8_STAGE(PG8_SA(0, 0), cA, voffA); PG8_STAGE(PG8_SB(0, 1), cB + hstep, voffB); PG8_STAGE(PG8_SA(0, 1), cA + hstep, voffA);
        if (wr == 1) PG8_BAR;
        PG8_WAIT_V(4); PG8_BAR;
        PG8_STAGE(PG8_SB(1, 0), cB + kstep, voffB); PG8_STAGE(PG8_SA(1, 0), cA + kstep, voffA); PG8_STAGE(PG8_SB(1, 1), cB + hstep + kstep, voffB);
        PG8_WAIT_V(6); PG8_BAR;
    }
    for (;;) {
        const bool has_next = S.next(ui + 1, nxt);
        const char* nA = has_next ? (const char*)g.A + (size_t)nxt.pm * tstep : cA; const char* nB = has_next ? (const char*)g.Bt + (size_t)nxt.pn * tstep : cB;
        for (int t = 0; t < nt; t += 2) {
            const bool last = (t == nt - 2);
            const char* a1 = cA + (size_t)(t + 1) * kstep;
            const char* a2 = last ? nA : cA + (size_t)(t + 2) * kstep; const char* b2 = last ? nB : cB + (size_t)(t + 2) * kstep;
            const char* a3 = a2 + kstep; const char* b3 = b2 + kstep;
            if (last && has_next) S.a_ready(nxt);
            if constexpr (SP2) {
            PG8_LDB(B0, 0, 0); PG8_LDB(B1, 0, 1); PG8_SCHED; PG8_LDA(At, 0, 0); PG8_STAGE(PG8_SA(1, 1), a1 + hstep, voffA);
            PG8_WAIT_V(8); PG8_WAIT_L(0); PG8_BAR; PG8_MMA(0, 0, At, B0); PG8_MMA(0, 1, At, B1); PG8_BAR; PG8_SCHED;
            PG8_LDA(At, 0, 1); PG8_STAGE(PG8_SB(0, 0), b2, voffB); PG8_STAGE(PG8_SB(0, 1), b2 + hstep, voffB); PG8_STAGE(PG8_SA(0, 0), a2, voffA);
            PG8_WAIT_V(8); PG8_WAIT_L(0); PG8_BAR; PG8_MMA(1, 0, At, B0); PG8_MMA(1, 1, At, B1); PG8_BAR; PG8_SCHED;
            PG8_LDB(B0, 1, 0); PG8_LDB(B1, 1, 1); PG8_SCHED; PG8_LDA(At, 1, 0); PG8_STAGE(PG8_SA(0, 1), a2 + hstep, voffA);
            PG8_WAIT_V(8); PG8_WAIT_L(0); PG8_BAR; PG8_MMA(0, 0, At, B0); PG8_MMA(0, 1, At, B1); PG8_BAR; PG8_SCHED;
            PG8_LDA(At, 1, 1); PG8_STAGE(PG8_SB(1, 0), b3, voffB); PG8_STAGE(PG8_SB(1, 1), b3 + hstep, voffB); PG8_STAGE(PG8_SA(1, 0), a3, voffA);
            PG8_WAIT_V(8); PG8_WAIT_L(0); PG8_BAR; PG8_MMA(1, 0, At, B0); PG8_MMA(1, 1, At, B1); PG8_BAR; PG8_SCHED;
            } else {
            PG8_LDB(B0, 0, 0); PG8_SCHED; PG8_LDA(At, 0, 0); PG8_STAGE(PG8_SA(1, 1), a1 + hstep, voffA);
            PG8_WAIT_L(8); PG8_BAR; PG8_WAIT_L(0); PG8_MMA(0, 0, At, B0); PG8_BAR; PG8_SCHED;
            PG8_LDB(B1, 0, 1); PG8_STAGE(PG8_SB(0, 0), b2, voffB);
            PG8_BAR; PG8_WAIT_L(0); PG8_MMA(0, 1, At, B1); PG8_BAR;
            PG8_LDA(At, 0, 1); PG8_STAGE(PG8_SA(0, 0), a2, voffA);
            PG8_BAR; PG8_WAIT_L(0); PG8_MMA(1, 0, At, B0); PG8_BAR; PG8_SCHED;
            PG8_STAGE(PG8_SB(0, 1), b2 + hstep, voffB);
            PG8_WAIT_V(6); PG8_BAR; PG8_MMA(1, 1, At, B1); PG8_BAR;
            PG8_LDB(B0, 1, 0); PG8_SCHED; PG8_LDA(At, 1, 0); PG8_STAGE(PG8_SA(0, 1), a2 + hstep, voffA);
            PG8_WAIT_L(8); PG8_BAR; PG8_WAIT_L(0); PG8_MMA(0, 0, At, B0); PG8_BAR; PG8_SCHED;
            PG8_LDB(B1, 1, 1); PG8_STAGE(PG8_SB(1, 0), b3, voffB);
            PG8_BAR; PG8_WAIT_L(0); PG8_MMA(0, 1, At, B1); PG8_BAR;
            PG8_LDA(At, 1, 1); PG8_STAGE(PG8_SA(1, 0), a3, voffA);
            PG8_BAR; PG8_WAIT_L(0); PG8_MMA(1, 0, At, B0); PG8_BAR; PG8_SCHED;
            PG8_STAGE(PG8_SB(1, 1), b3 + hstep, voffB);
            PG8_WAIT_V(6); PG8_BAR; PG8_MMA(1, 1, At, B1); PG8_BAR;
            }
        }
        if constexpr (F8) asm volatile("s_nop 15\n\ts_nop 15" ::: "memory");
        if constexpr (ALIGN_EPI) { if (wr == 0) PG8_BAR; }
        if constexpr (!Epi::AFTER_DRAIN) { int fr2 = fr, fq2 = fq; asm volatile("" : "+v"(fr2), "+v"(fq2));
            E(acc, cur, wr, wc, fr2, fq2);
            S.done(cur); }
        if (!has_next) break;
#pragma unroll
        for (int a = 0; a < 2; ++a)
#pragma unroll
            for (int b = 0; b < 2; ++b)
#pragma unroll
                for (int m = 0; m < 4; ++m)
#pragma unroll
                    for (int n = 0; n < 2; ++n) acc[a][b][m][n] = (f32x4){0.f, 0.f, 0.f, 0.f};
        cur = nxt; cA = nA; cB = nB; ++ui;
        if constexpr (ALIGN_EPI) { if (wr == 1) PG8_BAR; }
    }
    PG8_WAIT_V(0);
    if constexpr (!ALIGN_EPI) { if (wr == 0) PG8_BAR; }
    PG8_BAR;
    if constexpr (Epi::AFTER_DRAIN) { E.fused(acc, cur, wr, wc, fr, fq, lds, wid, lane); S.done(cur); }
#undef PG8_SA
#undef PG8_SB
#undef PG8_STAGE
#undef PG8_LD16
#undef PG8_LDA
#undef PG8_LDB
#undef PG8_MMA
#undef PG8_WAIT_V
#undef PG8_WAIT_L
#undef PG8_BAR
#undef PG8_SCHED
}
}
#define LDS_WAIT() asm volatile("s_waitcnt lgkmcnt(0)" ::: "memory")
constexpr int TR_STR = 68, TR_TILE = 64 * TR_STR * 4;
#define TR_PUT(V) do { _Pragma("unroll") for (int q_ = 0; q_ < 16; ++q_) *(LAS f32x4*)(scr + lane * TR_STR + 4 * q_) = (f32x4){V[4 * q_], V[4 * q_ + 1], V[4 * q_ + 2], V[4 * q_ + 3]}; } while (0)
template <bool F8> __device__ __forceinline__ void tr_emit(const LAS float* scr, unsigned char* dst, int K, float wscale, int lane) {
    const int c = lane & 7;
#pragma unroll
    for (int j = 0; j < 8; ++j) { const int n = (lane >> 3) + 8 * j; const LAS f32x4* sp = (const LAS f32x4*)(scr + n * TR_STR + 8 * c); const f32x4 a = sp[0] * wscale, b = sp[1] * wscale;
        if (F8) { v2u o; o.x = pk4f8(a[0], a[1], a[2], a[3]); o.y = pk4f8(b[0], b[1], b[2], b[3]); *(v2u*)(dst + (size_t)n * K + 8 * c) = o; }
        else { v4u o; o.x = pk2(a[0], a[1]); o.y = pk2(a[2], a[3]); o.z = pk2(b[0], b[1]); o.w = pk2(b[2], b[3]); *(v4u*)(dst + ((size_t)n * K + 8 * c) * 2) = o; } }
}
template <bool F8> __device__ __forceinline__ void tr_item(const float* W, int ldw, int K, unsigned char* WT, int k0, int n0, int drow0, LAS float* scr, int lane, float wscale) {
    const float* src = W + (size_t)k0 * ldw + n0 + lane;
    float v[64];
#pragma unroll
    for (int i = 0; i < 64; ++i) v[i] = __builtin_nontemporal_load(src + (size_t)i * ldw);
    TR_PUT(v);
    LDS_WAIT(); asm volatile("" ::: "memory");
    tr_emit<F8>(scr, WT + ((size_t)drow0 * K + k0) * (F8 ? 1 : 2), K, wscale, lane);
    LDS_WAIT(); asm volatile("" ::: "memory");
}
template <int KINDM, bool F8> __device__ __forceinline__ void tr_matrix(Frame& F, const float* W, int ldw, int K, int N, void* WT, float wscale, int& base, int gw, int ngw) {
    LAS float* scr = (LAS float*)(F.lds + F.wave * TR_TILE);
    const int nblk = N / 64, nitems = (K / 64) * nblk;
    int first = gw - (base % ngw); if (first < 0) first += ngw;
    for (int it = first; it < nitems; it += ngw) {
        const int kb = it / nblk, nb = it % nblk, n0 = nb * 64;
        const int drow0 = KINDM == 0 ? n0 : ((n0 >> 7) * 256 + (n0 & 127) + (KINDM == 2 ? 128 : 0));
        tr_item<F8>(W, ldw, K, (unsigned char*)WT, kb * 64, n0, drow0, scr, F.lane, wscale);
    }
    base += nitems;
}
__device__ __forceinline__ void ph_weights_dense(Frame& F) {
    const int gw = F.blk * NWAVES + F.wave, ngw = GRID * NWAVES; int base = 0;
    tr_matrix<0, false>(F, F.e_w_in, L0N, D, L0N, WSP(bf16, WS_WB_L0IN), 1.f, base, gw, ngw);
    tr_matrix<0, false>(F, F.e_w_out, D, D, D, WSP(bf16, WS_WB_L0OUT), 1.f, base, gw, ngw);
    tr_matrix<1, false>(F, F.e_wg, FF, D, FF, WSP(bf16, WS_WB_L0GU), 1.f, base, gw, ngw);
    tr_matrix<2, false>(F, F.e_wu, FF, D, FF, WSP(bf16, WS_WB_L0GU), 1.f, base, gw, ngw);
    tr_matrix<0, false>(F, F.e_wd, D, FF, D, WSP(bf16, WS_WB_L0DN), 1.f, base, gw, ngw);
    tr_matrix<0, false>(F, F.o_w_in, L1N, D, 4096, WSP(bf16, WS_WB_L1IN), 1.f, base, gw, ngw);
    tr_matrix<0, false>(F, F.o_w_out, D, D, D, WSP(bf16, WS_WB_L1OUT), 1.f, base, gw, ngw);
#pragma unroll 1
    for (int g = 0; g < 4; ++g) tr_matrix<0, false>(F, F.e_pool_w + g * 16384, 128, 128, 128, WSP(bf16, WS_POOLWT) + g * 16384, 1.f, base, gw, ngw);
}
constexpr int TRB_STR = 269;
struct TrB { const float* src; unsigned char* dst; int ldw, K, which; float sc; };
__device__ __forceinline__ TrB moe_item_b(Frame& F, int it) {
    const int e = it / 336, r = it % 336, which = r / 112, q = r % 112;
    TrB t; t.which = which;
    if (which < 2) { const int kb = q / 14, nb = q % 14; const float* W = (which == 0 ? F.o_mg : F.o_mu) + (size_t)e * D * FF;
        t.src = W + (size_t)(kb * 128) * FF + nb * 256; t.ldw = FF; t.K = D; t.sc = 32.0f;
        t.dst = F.ws + WS_WB_GU + ((size_t)e * 7168 + (nb * 2) * 256 + which * 128) * D + kb * 128; }
    else { const int kb = q / 4, nb = q % 4; const float* W = F.o_md + (size_t)e * FF * D;
        t.src = W + (size_t)(kb * 128) * D + nb * 256; t.ldw = D; t.K = FF; t.sc = 64.0f;
        t.dst = F.ws + WS_WB_DN + ((size_t)e * D + nb * 256) * FF + kb * 128; }
    return t;
}
#define TRB_LOAD(V, T_) do { _Pragma("unroll") for (int i_ = 0; i_ < 16; ++i_) V[i_] = __builtin_nontemporal_load((const f32x4*)((T_).src + (size_t)(r0 + 8 * i_) * (T_).ldw) + col4); } while (0)
#define TRB_STEP(V, CUR, NXT_IT) do { \
        _Pragma("unroll") for (int i_ = 0; i_ < 16; ++i_) { const int k_ = r0 + 8 * i_; LAS float* d_ = scr + k_ * TRB_STR + 4 * col4 + 4 * (k_ >> 5); d_[0] = V[i_][0]; d_[1] = V[i_][1]; d_[2] = V[i_][2]; d_[3] = V[i_][3]; } \
        const TrB cur_ = CUR; CUR = moe_item_b(F, (NXT_IT) < NIT ? (NXT_IT) : cb); TRB_LOAD(V, CUR); \
        asm volatile("s_waitcnt lgkmcnt(0)" ::: "memory"); __builtin_amdgcn_s_barrier(); asm volatile("" ::: "memory"); \
        _Pragma("unroll") for (int j_ = 0; j_ < 8; ++j_) { const int n_ = nl + 32 * j_; const LAS float* sp_ = scr + (8 * c) * TRB_STR + n_ + 4 * (c >> 2); const float ws_ = cur_.sc; \
            v2u o_; o_.x = pk4f8(sp_[0 * TRB_STR] * ws_, sp_[1 * TRB_STR] * ws_, sp_[2 * TRB_STR] * ws_, sp_[3 * TRB_STR] * ws_); o_.y = pk4f8(sp_[4 * TRB_STR] * ws_, sp_[5 * TRB_STR] * ws_, sp_[6 * TRB_STR] * ws_, sp_[7 * TRB_STR] * ws_); \
            const size_t orow_ = cur_.which < 2 ? (size_t)((n_ >> 7) * 256 + (n_ & 127)) : (size_t)n_; \
            __builtin_nontemporal_store(o_, (v2u*)(cur_.dst + orow_ * cur_.K + 8 * c)); } \
        asm volatile("s_waitcnt lgkmcnt(0)" ::: "memory"); __builtin_amdgcn_s_barrier(); asm volatile("" ::: "memory"); } while (0)
__device__ __forceinline__ void ph_weights_moe_blk(Frame& F, int cb, int ncb) {
    constexpr int NIT = NE * 336;
    LAS float* scr = (LAS float*)F.lds;
    const int tid = F.tid, col4 = tid & 63, r0 = tid >> 6, c = tid & 15, nl = tid >> 4;
    int it = cb; if (it >= NIT) return;
    TrB tA = moe_item_b(F, it), tB = moe_item_b(F, it + ncb < NIT ? it + ncb : cb);
    f32x4 vA[16], vB[16];
    TRB_LOAD(vA, tA); TRB_LOAD(vB, tB);
#pragma unroll 1
    for (;;) {
        TRB_STEP(vA, tA, it + 2 * ncb);
        if (it + ncb >= NIT) break;
        TRB_STEP(vB, tB, it + 3 * ncb);
        it += 2 * ncb; if (it >= NIT) break;
    }
}
#undef TRB_LOAD
#undef TRB_STEP

namespace pg8 {
struct EpiPlain {
    static constexpr bool PERM = true, AFTER_DRAIN = false;
    bf16_t* O; int ldc; bf16_t* O2; int ldc2; int split; int nper; float oscale;
    __device__ __forceinline__ void operator()(const f32x4 (&acc)[2][2][4][2], const Unit& u, int wr, int wc, int fr, int fq) const {
        int pn = u.pn % nper; bf16_t* base = O; int ld = ldc;
        if (pn >= split) { pn -= split; base = O2; ld = ldc2; }
        const int row0 = u.pm * BM + wr * 64 + fr, col0 = pn * BM + wc * 32 + 8 * fq;
#pragma unroll
        for (int ai = 0; ai < 2; ++ai)
#pragma unroll
            for (int m = 0; m < 4; ++m) { bf16_t* rowp = base + (size_t)(row0 + ai * HALF + m * 16) * ld + col0;
#pragma unroll
                for (int bj = 0; bj < 2; ++bj) { const f32x4 v0 = acc[ai][bj][m][0] * oscale, v1 = acc[ai][bj][m][1] * oscale;
                    u32x4 w; w.x = cvt_pk_bf16(v0[0], v0[1]); w.y = cvt_pk_bf16(v0[2], v0[3]); w.z = cvt_pk_bf16(v1[0], v1[1]); w.w = cvt_pk_bf16(v1[2], v1[3]);
                    *(u32x4*)(rowp + bj * HALF) = w; } }
    }
};
struct EpiSwiglu {
    static constexpr bool PERM = true, AFTER_DRAIN = false;
    bf16_t* O; int ldc; int nper;
    __device__ __forceinline__ void operator()(const f32x4 (&acc)[2][2][4][2], const Unit& u, int wr, int wc, int fr, int fq) const {
        const int pn = u.pn % nper;
        const int row0 = u.pm * BM + wr * 64 + fr, col0 = pn * HALF + wc * 32 + 8 * fq;
#pragma unroll
        for (int ai = 0; ai < 2; ++ai)
#pragma unroll
            for (int m = 0; m < 4; ++m) { bf16_t* rowp = O + (size_t)(row0 + ai * HALF + m * 16) * ldc + col0;
                float o[8];
#pragma unroll
                for (int n = 0; n < 2; ++n)
#pragma unroll
                    for (int i = 0; i < 4; ++i) { const float g = acc[ai][0][m][n][i], uu = acc[ai][1][m][n][i]; o[4 * n + i] = g * __builtin_amdgcn_rcpf(1.0f + __expf(-g)) * uu; }
                u32x4 w; w.x = cvt_pk_bf16(o[0], o[1]); w.y = cvt_pk_bf16(o[2], o[3]); w.z = cvt_pk_bf16(o[4], o[5]); w.w = cvt_pk_bf16(o[6], o[7]);
                *(u32x4*)rowp = w; }
    }
};
struct EpiSwigluF8 {
    static constexpr bool PERM = true, AFTER_DRAIN = false;
    unsigned char* O; int ldc; int nper; float iscale, hscale;
    __device__ __forceinline__ void operator()(const f32x4 (&acc)[2][2][4][2], const Unit& u, int wr, int wc, int fr, int fq) const {
        const int pn = u.pn % nper;
        const int row0 = u.pm * BM + wr * 64 + fr, col0 = pn * HALF + wc * 32 + 8 * fq;
#pragma unroll
        for (int ai = 0; ai < 2; ++ai)
#pragma unroll
            for (int m = 0; m < 4; ++m) { unsigned char* rowp = O + (size_t)(row0 + ai * HALF + m * 16) * ldc + col0;
                float o[8];
#pragma unroll
                for (int n = 0; n < 2; ++n)
#pragma unroll
                    for (int i = 0; i < 4; ++i) { const float g = acc[ai][0][m][n][i] * iscale, uu = acc[ai][1][m][n][i] * (iscale * hscale); o[4 * n + i] = g * __builtin_amdgcn_rcpf(1.0f + __expf(-g)) * uu; }
                v2u w; w.x = pk4f8(o[0], o[1], o[2], o[3]); w.y = pk4f8(o[4], o[5], o[6], o[7]);
                *(v2u*)rowp = w; asm volatile("" ::: "memory"); }
    }
};
struct EpiL0In {
    static constexpr bool PERM = true, AFTER_DRAIN = false;
    bf16_t* O; const float* rope;
    __device__ __forceinline__ void operator()(const f32x4 (&acc)[2][2][4][2], const Unit& u, int wr, int wc, int fr, int fq) const {
        const int row0 = u.pm * BM + wr * 64 + fr, col0 = u.pn * BM + wc * 32 + 8 * fq;
        const bool qk = u.pn < 4, rot = qk && ((wc & 1) == 0) && (fq < 2);
        const float sc = u.pn < 2 ? 0.125f : 1.0f;
#pragma unroll
        for (int ai = 0; ai < 2; ++ai)
#pragma unroll
            for (int m = 0; m < 4; ++m) { const int r = row0 + ai * HALF + m * 16; bf16_t* rowp = O + (size_t)r * L0N + col0;
                f32x4 cs0 = {1.f, 1.f, 1.f, 1.f}, cs1 = cs0, sn0 = {0.f, 0.f, 0.f, 0.f}, sn1 = sn0;
                if (rot) { const f32x4* t = (const f32x4*)(rope + (size_t)r * 16); cs0 = t[0]; cs1 = t[1]; sn0 = t[2]; sn1 = t[3]; if (fq == 0) { sn0 = -sn0; sn1 = -sn1; } }
#pragma unroll
                for (int bj = 0; bj < 2; ++bj) { f32x4 v0 = acc[ai][bj][m][0], v1 = acc[ai][bj][m][1];
                    if (qk) {
                        f32x4 p0, p1;
#pragma unroll
                        for (int i = 0; i < 4; ++i) { p0[i] = __shfl_xor(v0[i], 16); p1[i] = __shfl_xor(v1[i], 16); }
                        v0 = v0 * cs0 + p0 * sn0; v1 = v1 * cs1 + p1 * sn1;
                    }
                    v0 = v0 * sc; v1 = v1 * sc;
                    u32x4 w; w.x = cvt_pk_bf16(v0[0], v0[1]); w.y = cvt_pk_bf16(v0[2], v0[3]); w.z = cvt_pk_bf16(v1[0], v1[1]); w.w = cvt_pk_bf16(v1[2], v1[3]);
                    *(u32x4*)(rowp + bj * HALF) = w; } }
    }
};
struct MoeOrder {
    int nM, nN, nwg, G, c; int t1, t2, t3, t4, t5, t6, t7;
#define RFL(x) __builtin_amdgcn_readfirstlane(x)
    __device__ void init(const int* tp, int nN_, int G_, int c_) { nM = RFL(tp[8]); nN = nN_; nwg = nM * nN; G = G_; c = c_; t1 = RFL(tp[1]); t2 = RFL(tp[2]); t3 = RFL(tp[3]); t4 = RFL(tp[4]); t5 = RFL(tp[5]); t6 = RFL(tp[6]); t7 = RFL(tp[7]); }
#undef RFL
    __device__ bool next(int i, Unit& u) const {
        const long L = (long)i * G + c; if (L >= nwg) return false;
        int wgid = (int)L; { const int q = nwg / NXCD, r = nwg % NXCD, xcd = wgid % NXCD, off = wgid / NXCD; wgid = (xcd < r ? xcd * (q + 1) : r * (q + 1) + (xcd - r) * q) + off; }
        const int nig = WGM * nN, gid = wgid / nig, fm = gid * WGM, gsz = (nM - fm) < WGM ? (nM - fm) : WGM;
        const int pm = fm + ((wgid % nig) % gsz), pn = (wgid % nig) / gsz;
        const int e = (pm >= t1) + (pm >= t2) + (pm >= t3) + (pm >= t4) + (pm >= t5) + (pm >= t6) + (pm >= t7);
        u.pm = pm; u.pn = e * nN + pn; return true;
    }
    __device__ __forceinline__ void a_ready(const Unit&) const {}
    __device__ __forceinline__ void done(const Unit&) const {}
};
}
#define MFMA16(a, b, c) __builtin_amdgcn_mfma_f32_16x16x32_bf16((a), (b), (c), 0, 0, 0)
__device__ __forceinline__ s16x4 tr16(LAS unsigned char* p) { return __builtin_amdgcn_ds_read_tr16_b64_v4i16((LAS s16x4*)p); }
__device__ __forceinline__ bf16x8 cat4(s16x4 a, s16x4 b) { return (bf16x8){a[0], a[1], a[2], a[3], b[0], b[1], b[2], b[3]}; }
#ifndef PROBE_POOL2
#define PROBE_POOL2 0
#endif
#ifndef PROBE_ATT2
#define PROBE_ATT2 0
#endif
constexpr int KV_STRIDE = 144;
constexpr int ATT_UNITS = NB * AH * 3 * 64;
struct AttUnit { int b, h, br, d, r, nb; };
__device__ __forceinline__ AttUnit att_decode(int u) {
    AttUnit a; a.br = u >> 10; const int rem = u & 1023; a.b = rem >> 9; a.h = (rem >> 6) & 7; const int rb = rem & 63;
    a.d = a.br == 0 ? 1 : (a.br == 1 ? 4 : 16); const int nblk = 64 / a.d; a.r = rb / nblk; a.nb = rb % nblk; return a;
}
__device__ __forceinline__ void att_issue(const bf16* P0, const AttUnit& a, int tid, int wave, int lane, v4u (&kr)[4], v4u (&vr)[4], v4u (&qr)[2]) {
    const int c = tid & 7, row0 = tid >> 3;
#pragma unroll
    for (int i = 0; i < 4; ++i) {
        int n = 128 * (a.nb - 1) + row0 + 64 * i; if (n < 0) n += 128;
        const bf16* p = P0 + (size_t)(a.b * T + n * a.d + a.r) * L0N + 64 * a.h + 8 * c;
        kr[i] = *(const v4u*)(p + 512); vr[i] = *(const v4u*)(p + 1024);
    }
    const int tq = a.b * T + (128 * a.nb + 16 * wave + (lane & 15)) * a.d + a.r;
    const bf16* q = P0 + (size_t)tq * L0N + 64 * a.h + 8 * (lane >> 4);
    qr[0] = *(const v4u*)q; qr[1] = *(const v4u*)(q + 32);
}
__device__ __forceinline__ void pool_unit(const bf16* P0, const bf16* PW, const float* pscale, bf16* MIX, int m, int t, int gg, int li, int g) {
    const int Wn = 2 << gg, cnt = (t + 1 < Wn) ? t + 1 : Wn; const float rc = 1.0f / (float)cnt;
    f32x4 acc[8];
#pragma unroll
    for (int nt = 0; nt < 8; ++nt) acc[nt] = (f32x4){0.f, 0.f, 0.f, 0.f};
#pragma unroll 1
    for (int ks = 0; ks < 4; ++ks) {
        const bf16* up = P0 + (size_t)m * L0N + 1536 + 128 * gg + 32 * ks + 8 * g;
        const v4u self = *(const v4u*)up;
        float sm[8];
#pragma unroll
        for (int q = 0; q < 8; ++q) sm[q] = 0.f;
        { v4u x[16];
#pragma unroll
          for (int j = 0; j < 16; ++j) { const int jj = j < cnt ? j : 0; x[j] = *(const v4u*)(up - (size_t)jj * L0N); }
#pragma unroll
          for (int j = 0; j < 16; ++j) { const float mk = j < cnt ? 1.0f : 0.0f;
              sm[0] += mk * bflo(x[j].x); sm[1] += mk * bfhi(x[j].x); sm[2] += mk * bflo(x[j].y); sm[3] += mk * bfhi(x[j].y); sm[4] += mk * bflo(x[j].z); sm[5] += mk * bfhi(x[j].z); sm[6] += mk * bflo(x[j].w); sm[7] += mk * bfhi(x[j].w); } }
        v4u bw; bw.x = pk2(sm[0] * rc - bflo(self.x), sm[1] * rc - bfhi(self.x)); bw.y = pk2(sm[2] * rc - bflo(self.y), sm[3] * rc - bfhi(self.y));
        bw.z = pk2(sm[4] * rc - bflo(self.z), sm[5] * rc - bfhi(self.z)); bw.w = pk2(sm[6] * rc - bflo(self.w), sm[7] * rc - bfhi(self.w));
        const bf16x8 bfrag = __builtin_bit_cast(bf16x8, bw);
        asm volatile("" ::: "memory");
        bf16x8 af[8];
#pragma unroll
        for (int nt = 0; nt < 8; ++nt) af[nt] = *(const bf16x8*)(PW + (size_t)gg * 16384 + (16 * nt + li) * 128 + 32 * ks + 8 * g);
#pragma unroll
        for (int nt = 0; nt < 8; ++nt) acc[nt] = MFMA16(af[nt], bfrag, acc[nt]);
    }
    bf16* op = MIX + (size_t)m * D + 512 + 128 * gg + 4 * g;
#pragma unroll
    for (int nt = 0; nt < 8; ++nt) {
        const f32x4 sc = *(const f32x4*)(pscale + 128 * gg + 16 * nt + 4 * g);
        v2u wv; wv.x = pk2(acc[nt][0] * sc[0], acc[nt][1] * sc[1]); wv.y = pk2(acc[nt][2] * sc[2], acc[nt][3] * sc[3]); *(v2u*)(op + 16 * nt) = wv;
    }
}
__device__ __forceinline__ void att_compute(const AttUnit& a, LAS unsigned char* Ks, LAS unsigned char* Vs, bf16x8 q0, bf16x8 q1, int w, int li, int g, bf16* AP, float* LSE) {
        f32x4 s[9];
#pragma unroll
        for (int kt = 0; kt < 9; ++kt) {
            const LAS unsigned char* kp = Ks + (16 * (w + kt) + li) * KV_STRIDE + 16 * g;
            const bf16x8 a0 = *(const LAS bf16x8*)kp, a1 = *(const LAS bf16x8*)(kp + 64);
            f32x4 z = {0.f, 0.f, 0.f, 0.f};
            z = MFMA16(a0, q0, z); s[kt] = MFMA16(a1, q1, z);
        }
        float mx = -3.0e38f;
        const int d0 = 4 * g - li;
#pragma unroll
        for (int kt = 0; kt < 9; ++kt) {
            const bool tile_ok = (a.nb > 0) || (w + kt >= 8);
#pragma unroll
            for (int i = 0; i < 4; ++i) {
                bool ok = tile_ok;
                if (kt == 0) ok = ok && (d0 + i >= 0);
                if (kt == 8) ok = ok && (d0 + i <= 0);
                s[kt][i] = ok ? s[kt][i] : -3.0e38f; mx = fmaxf(mx, s[kt][i]);
            }
        }
        mx = fmaxf(mx, __shfl_xor(mx, 16)); mx = fmaxf(mx, __shfl_xor(mx, 32));
        float l = 0.f; unsigned pk[10][2];
#pragma unroll
        for (int kt = 0; kt < 9; ++kt) {
            float p[4];
#pragma unroll
            for (int i = 0; i < 4; ++i) { p[i] = __expf(s[kt][i] - mx); l += p[i]; }
            pk[kt][0] = pk2(p[0], p[1]); pk[kt][1] = pk2(p[2], p[3]);
        }
        pk[9][0] = 0u; pk[9][1] = 0u;
        l += __shfl_xor(l, 16); l += __shfl_xor(l, 32);
        f32x4 o[4];
#pragma unroll
        for (int mt = 0; mt < 4; ++mt) o[mt] = (f32x4){0.f, 0.f, 0.f, 0.f};
#pragma unroll
        for (int sI = 0; sI < 5; ++sI) {
            const v4u bw = {pk[2 * sI][0], pk[2 * sI][1], pk[2 * sI + 1][0], pk[2 * sI + 1][1]};
            const bf16x8 bfrag = __builtin_bit_cast(bf16x8, bw);
            const int t0 = w + 2 * sI, t1 = (w + 2 * sI + 1) > 15 ? 15 : (w + 2 * sI + 1);
            LAS unsigned char* v0 = Vs + (16 * t0 + 4 * g + (li >> 2)) * KV_STRIDE + 8 * (li & 3);
            LAS unsigned char* v1 = Vs + (16 * t1 + 4 * g + (li >> 2)) * KV_STRIDE + 8 * (li & 3);
#pragma unroll
            for (int mt = 0; mt < 4; ++mt) { const bf16x8 af = cat4(tr16(v0 + 32 * mt), tr16(v1 + 32 * mt)); o[mt] = MFMA16(af, bfrag, o[mt]); }
        }
        const float rl = __builtin_amdgcn_rcpf(l);
        const int tq = a.b * T + (128 * a.nb + 16 * w + li) * a.d + a.r;
        bf16* op = AP + ((size_t)a.br * M + tq) * AW + 64 * a.h + 4 * g;
#pragma unroll
        for (int mt = 0; mt < 4; ++mt) { v2u wv; wv.x = pk2(o[mt][0] * rl, o[mt][1] * rl); wv.y = pk2(o[mt][2] * rl, o[mt][3] * rl); *(v2u*)(op + 16 * mt) = wv; }
        if (g == 0) LSE[((size_t)a.br * M + tq) * 8 + a.h] = mx + __logf(l);
}
__device__ __forceinline__ void ph_attn_pool(Frame& F) {
    const bf16* P0 = WSP(const bf16, WS_PROJ0); bf16* AP = WSP(bf16, WS_ATTP); float* LSE = WSP(float, WS_LSE);
    LAS unsigned char* Ks = F.lds; LAS unsigned char* Vs = F.lds + 256 * KV_STRIDE;
    const int lane = F.lane, w = F.wave, li = lane & 15, g = lane >> 4, tid = F.tid;
    v4u krA[4], vrA[4], qrA[2], krB[4], vrB[4], qrB[2];
    const int c8 = tid & 7, row0 = tid >> 3;
    int u = F.blk;
    { const AttUnit a = att_decode(u < ATT_UNITS ? u : 0); att_issue(P0, a, tid, w, lane, krA, vrA, qrA); }
    { const AttUnit a = att_decode(u + GRID < ATT_UNITS ? u + GRID : 0); att_issue(P0, a, tid, w, lane, krB, vrB, qrB); }
#define ATT_BAR() do { asm volatile("s_waitcnt lgkmcnt(0)" ::: "memory"); __builtin_amdgcn_s_barrier(); asm volatile("" ::: "memory"); } while (0)
#define ATT_STEP(KR, VR, QR, UU) do { \
        const AttUnit a_ = att_decode(UU); \
        _Pragma("unroll") for (int i_ = 0; i_ < 4; ++i_) { *(LAS v4u*)(Ks + (row0 + 64 * i_) * KV_STRIDE + c8 * 16) = KR[i_]; *(LAS v4u*)(Vs + (row0 + 64 * i_) * KV_STRIDE + c8 * 16) = VR[i_]; } \
        const bf16x8 q0_ = __builtin_bit_cast(bf16x8, QR[0]), q1_ = __builtin_bit_cast(bf16x8, QR[1]); \
        ATT_BAR(); \
        { const int un_ = (UU) + 2 * GRID; const AttUnit an_ = att_decode(un_ < ATT_UNITS ? un_ : 0); att_issue(P0, an_, tid, w, lane, KR, VR, QR); } \
        att_compute(a_, Ks, Vs, q0_, q1_, w, li, g, AP, LSE); \
        if (PROBE_ATT2) { asm volatile("" ::: "memory"); att_compute(a_, Ks, Vs, q0_, q1_, w, li, g, AP, LSE); } \
        ATT_BAR(); } while (0)
#pragma unroll 1
    for (; u < ATT_UNITS; u += 2 * GRID) {
        ATT_STEP(krA, vrA, qrA, u);
        if (u + GRID < ATT_UNITS) ATT_STEP(krB, vrB, qrB, u + GRID);
    }
#undef ATT_STEP
#undef ATT_BAR
    asm volatile("s_waitcnt vmcnt(0)" ::: "memory"); __syncthreads();
    {
        const bf16* PW = WSP(const bf16, WS_POOLWT); bf16* MIX = WSP(bf16, WS_MIX);
        constexpr int PSTR = 272;
        LAS unsigned char* Ut = F.lds; LAS unsigned char* Wt = F.lds + 143 * PSTR + 16;
        v4u ur[5], wr[4];
#define POOL_ISSUE(PU) do { const int tile_ = (PU) & 127, gg_ = (PU) >> 7; const int m0_ = tile_ * 128, lo_ = (m0_ / T) * T; \
            _Pragma("unroll") for (int i_ = 0; i_ < 5; ++i_) { int p_ = tid + 512 * i_; p_ = p_ < 143 * 16 ? p_ : 143 * 16 - 1; int mr_ = m0_ - 15 + (p_ >> 4); mr_ = mr_ < lo_ ? lo_ : mr_; \
                ur[i_] = *(const v4u*)(P0 + (size_t)mr_ * L0N + 1536 + 128 * gg_ + (p_ & 15) * 8); } \
            _Pragma("unroll") for (int i_ = 0; i_ < 4; ++i_) { const int p_ = tid + 512 * i_; wr[i_] = *(const v4u*)(PW + (size_t)gg_ * 16384 + (p_ >> 4) * 128 + (p_ & 15) * 8); } } while (0)
        int pu = F.blk;
        POOL_ISSUE(pu);
#pragma unroll 1
        for (; pu < 512; pu += GRID) {
            const int tile = pu & 127, gg = pu >> 7;
#pragma unroll
            for (int i = 0; i < 5; ++i) { const int p = tid + 512 * i; if (p < 143 * 16) *(LAS v4u*)(Ut + (p >> 4) * PSTR + (p & 15) * 16) = ur[i]; }
#pragma unroll
            for (int i = 0; i < 4; ++i) { const int p = tid + 512 * i; *(LAS v4u*)(Wt + (p >> 4) * PSTR + (p & 15) * 16) = wr[i]; }
            __syncthreads();
            if (pu + GRID < 512) POOL_ISSUE(pu + GRID);
            const int m = tile * 128 + 16 * w + li, t = m % T, Wn = 2 << gg, cnt = (t + 1 < Wn) ? t + 1 : Wn; const float rc = 1.0f / (float)cnt;
            const LAS unsigned char* urow = Ut + (16 * w + li + 15) * PSTR + 16 * g;
            f32x4 acc[8];
#pragma unroll
            for (int nt = 0; nt < 8; ++nt) acc[nt] = (f32x4){0.f, 0.f, 0.f, 0.f};
#pragma unroll 1
            for (int ks = 0; ks < 4; ++ks) {
                float sm[8];
#pragma unroll
                for (int q = 0; q < 8; ++q) sm[q] = 0.f;
                const v4u self = *(const LAS v4u*)(urow + 64 * ks);
#pragma unroll
                for (int j = 0; j < 16; ++j) { const v4u x = *(const LAS v4u*)(urow + 64 * ks - j * PSTR); const float mk = j < cnt ? 1.0f : 0.0f;
                    sm[0] += mk * bflo(x.x); sm[1] += mk * bfhi(x.x); sm[2] += mk * bflo(x.y); sm[3] += mk * bfhi(x.y); sm[4] += mk * bflo(x.z); sm[5] += mk * bfhi(x.z); sm[6] += mk * bflo(x.w); sm[7] += mk * bfhi(x.w); }
                v4u bw; bw.x = pk2(sm[0] * rc - bflo(self.x), sm[1] * rc - bfhi(self.x)); bw.y = pk2(sm[2] * rc - bflo(self.y), sm[3] * rc - bfhi(self.y));
                bw.z = pk2(sm[4] * rc - bflo(self.z), sm[5] * rc - bfhi(self.z)); bw.w = pk2(sm[6] * rc - bflo(self.w), sm[7] * rc - bfhi(self.w));
                const bf16x8 bfrag = __builtin_bit_cast(bf16x8, bw);
#pragma unroll
                for (int nt = 0; nt < 8; ++nt) acc[nt] = MFMA16(*(const LAS bf16x8*)(Wt + (16 * nt + li) * PSTR + 64 * ks + 16 * g), bfrag, acc[nt]);
            }
            bf16* op = MIX + (size_t)m * D + 512 + 128 * gg + 4 * g;
#pragma unroll
            for (int nt = 0; nt < 8; ++nt) {
                const f32x4 sc = *(const f32x4*)(F.e_pool_scale + 128 * gg + 16 * nt + 4 * g);
                v2u wv; wv.x = pk2(acc[nt][0] * sc[0], acc[nt][1] * sc[1]); wv.y = pk2(acc[nt][2] * sc[2], acc[nt][3] * sc[3]); *(v2u*)(op + 16 * nt) = wv;
            }
            __syncthreads();
        }
#undef POOL_ISSUE
    }
}
__device__ __forceinline__ void ph_attn_combine(Frame& F) {
    const bf16* AP = WSP(const bf16, WS_ATTP); const float* LSE = WSP(const float, WS_LSE); bf16* MIX = WSP(bf16, WS_MIX);
    const int m0 = F.blk * RPB + F.wave * 8, h = F.lane >> 3;
    v4u an, bn, cn; float l0n, l1n, l2n;
#define CMB_LOAD(M_) do { l0n = LSE[((size_t)0 * M + (M_)) * 8 + h]; l1n = LSE[((size_t)1 * M + (M_)) * 8 + h]; l2n = LSE[((size_t)2 * M + (M_)) * 8 + h]; \
        an = *((const v4u*)(AP + ((size_t)0 * M + (M_)) * AW) + F.lane); bn = *((const v4u*)(AP + ((size_t)1 * M + (M_)) * AW) + F.lane); cn = *((const v4u*)(AP + ((size_t)2 * M + (M_)) * AW) + F.lane); } while (0)
    CMB_LOAD(m0);
#pragma unroll 1
    for (int i = 0; i < 8; ++i) {
        const int m = m0 + i;
        const v4u a = an, b = bn, c = cn; const float l0 = l0n, l1 = l1n, l2 = l2n;
        if (i < 7) CMB_LOAD(m + 1);
        const float mx = fmaxf(l0, fmaxf(l1, l2)), e0 = __expf(l0 - mx), e1 = __expf(l1 - mx), e2 = __expf(l2 - mx), rs = __builtin_amdgcn_rcpf(e0 + e1 + e2);
        const float w0 = e0 * rs, w1 = e1 * rs, w2 = e2 * rs;
        v4u o;
        o.x = pk2(w0 * bflo(a.x) + w1 * bflo(b.x) + w2 * bflo(c.x), w0 * bfhi(a.x) + w1 * bfhi(b.x) + w2 * bfhi(c.x));
        o.y = pk2(w0 * bflo(a.y) + w1 * bflo(b.y) + w2 * bflo(c.y), w0 * bfhi(a.y) + w1 * bfhi(b.y) + w2 * bfhi(c.y));
        o.z = pk2(w0 * bflo(a.z) + w1 * bflo(b.z) + w2 * bflo(c.z), w0 * bfhi(a.z) + w1 * bfhi(b.z) + w2 * bfhi(c.z));
        o.w = pk2(w0 * bflo(a.w) + w1 * bflo(b.w) + w2 * bflo(c.w), w0 * bfhi(a.w) + w1 * bfhi(b.w) + w2 * bfhi(c.w));
        *((v4u*)(MIX + (size_t)m * D) + F.lane) = o;
    }
#undef CMB_LOAD
}
#ifndef PROBE_CP
#define PROBE_CP 0
#endif
constexpr int CP_STR = 272, CP_IMG = 64 * CP_STR;
constexpr int IMG_KB = 0, IMG_K = CP_IMG, IMG_Q = 2 * CP_IMG, IMG_VB = 3 * CP_IMG, IMG_KBG = 4 * CP_IMG, IMG_KG = 5 * CP_IMG, CP_GATES = 6 * CP_IMG;
constexpr int NM_STR = 144, NM_IMG = 64 * NM_STR;
__device__ __forceinline__ bf16x8 ldsb128(const LAS unsigned char* p) { return *(const LAS bf16x8*)p; }
__device__ __forceinline__ bf16x8 tr_pair(LAS unsigned char* p, int step) { return cat4(tr16(p), tr16(p + step)); }
__device__ __forceinline__ v2u pk4(f32x4 v) { v2u r; r.x = pk2(v[0], v[1]); r.y = pk2(v[2], v[3]); return r; }

struct CpIn { v4u x[3][4][2]; v4u wv; float bl, al; };
__device__ __forceinline__ void cp_issue(Frame& F, int un, int tid, CpIn& I) {
    const bf16* QKV = WSP(const bf16, WS_QKV); const float* BL = WSP(const float, WS_BL);
    const int b = un >> 10, h = (un >> 7) & 7, c = un & 127, row = tid >> 3, cg = tid & 7, t = c * CH + row;
#pragma unroll
    for (int mat = 0; mat < 3; ++mat)
#pragma unroll
        for (int j = 0; j < 4; ++j) {
            int tt = t - 3 + j; tt = tt < 0 ? 0 : tt;
            const v4u* p = (const v4u*)(QKV + ((size_t)b * T + tt) * 3072 + mat * 1024 + 128 * h + 16 * cg);
            I.x[mat][j][0] = p[0]; I.x[mat][j][1] = p[1];
        }
    { const int idx = tid < 384 ? tid : 383, j = idx / 96, r = idx % 96, mat = r >> 5, c4 = r & 31;
      I.wv = *(const v4u*)(F.o_conv_w + j * 3072 + mat * 1024 + 128 * h + 4 * c4); }
    const size_t mrow = (size_t)b * T + (size_t)c * CH + (tid & 63);
    I.bl = BL[mrow * 16 + h]; I.al = BL[mrow * 16 + 8 + h];
}
__device__ __forceinline__ void ph_chunk_prep(Frame& F) {
    unsigned char* WFp = F.ws + WS_WF; unsigned char* QGp = F.ws + WS_QGF; unsigned char* KGp = F.ws + WS_KGF; unsigned char* ATp = F.ws + WS_ATF; unsigned char* UFp = F.ws + WS_UF;
    float* CDEC = WSP(float, WS_CDEC);
    LAS unsigned char* L = F.lds; LAS float* gcs = (LAS float*)(L + CP_GATES); LAS float* betas = gcs + 64;
    LAS float* wcv = (LAS float*)(L + CP_GATES + 2048);
    const int w = F.wave;
#pragma unroll 1
    for (int un = F.blk; un < NB * DH * NCH; un += GRID) {
        int tid = F.tid; asm volatile("" : "+v"(tid));
        const int lane = tid & 63, li = lane & 15, g = lane >> 4;
        const int h = (un >> 7) & 7, c = un & 127;
        CpIn I; cp_issue(F, un, tid, I);
        if (w == 0) {
            float gl = -__expf(F.o_a_log[h]) * softplus_f(I.al + F.o_dt_bias[h]);
            DPP_ADD(gl, 0x111); DPP_ADD(gl, 0x112); DPP_ADD(gl, 0x114); DPP_ADD(gl, 0x118);
            { const int gi = __builtin_bit_cast(int, gl);
              const float t0 = __builtin_bit_cast(float, __builtin_amdgcn_readlane(gi, 15)), t1 = __builtin_bit_cast(float, __builtin_amdgcn_readlane(gi, 31)), t2 = __builtin_bit_cast(float, __builtin_amdgcn_readlane(gi, 47));
              const int rr = lane >> 4; gl += (rr >= 1 ? t0 : 0.f) + (rr >= 2 ? t1 : 0.f) + (rr >= 3 ? t2 : 0.f); }
            gcs[lane] = gl; betas[lane] = sigmoid_f(I.bl);
            if (lane == 63) CDEC[un] = __expf(gl);
        }
        if (tid < 384) *(LAS v4u*)(wcv + 4 * tid) = I.wv;
        __syncthreads();
        for (int rp_ = 0; rp_ < (PROBE_CP == 1 ? 2 : 1); ++rp_) {
        {
            const int row = tid >> 3, cg = tid & 7, t = c * CH + row;
            const float gcr = gcs[row], beta = betas[row], eg = __expf(gcr), ekl = __expf(gcs[63] - gcr);
            const int off = row * CP_STR + cg * 32;
#define ST_IMG(IMG, P) do { *(LAS v4u*)(L + (IMG) + off) = (v4u){P[0], P[1], P[2], P[3]}; *(LAS v4u*)(L + (IMG) + off + 16) = (v4u){P[4], P[5], P[6], P[7]}; } while (0)
#pragma unroll
            for (int mat = 0; mat < 3; ++mat) {
                float acc[16];
#pragma unroll
                for (int e = 0; e < 16; ++e) acc[e] = 0.f;
                f32x4 wq[4][4];
#pragma unroll
                for (int j = 0; j < 4; ++j) { const LAS f32x4* wp = (const LAS f32x4*)(wcv + (j * 3 + mat) * 128 + 16 * cg); wq[j][0] = wp[0]; wq[j][1] = wp[1]; wq[j][2] = wp[2]; wq[j][3] = wp[3]; }
                __builtin_amdgcn_sched_barrier(0);
#pragma unroll
                for (int j = 0; j < 4; ++j) {
                    const bool okr = (t - 3 + j) >= 0;
                    const v4u z = {0u, 0u, 0u, 0u}; const v4u x0 = okr ? I.x[mat][j][0] : z, x1 = okr ? I.x[mat][j][1] : z;
                    const f32x4 w0 = wq[j][0], w1 = wq[j][1], w2 = wq[j][2], w3 = wq[j][3];
                    acc[0] += w0[0] * bflo(x0.x); acc[1] += w0[1] * bfhi(x0.x); acc[2] += w0[2] * bflo(x0.y); acc[3] += w0[3] * bfhi(x0.y);
                    acc[4] += w1[0] * bflo(x0.z); acc[5] += w1[1] * bfhi(x0.z); acc[6] += w1[2] * bflo(x0.w); acc[7] += w1[3] * bfhi(x0.w);
                    acc[8] += w2[0] * bflo(x1.x); acc[9] += w2[1] * bfhi(x1.x); acc[10] += w2[2] * bflo(x1.y); acc[11] += w2[3] * bfhi(x1.y);
                    acc[12] += w3[0] * bflo(x1.z); acc[13] += w3[1] * bfhi(x1.z); acc[14] += w3[2] * bflo(x1.w); acc[15] += w3[3] * bfhi(x1.w);
                }
                float ss = 0.f;
#pragma unroll
                for (int e = 0; e < 16; ++e) { acc[e] = silu_f(acc[e]); ss += acc[e] * acc[e]; }
                ss = row8_sum(ss);
                const float rn = 1.0f / sqrtf(ss + EPS);
                if (mat == 0) {
                    const float rq = rn * 0.08838834764831845f;
                    unsigned pq[8], pqg[8];
#pragma unroll
                    for (int e = 0; e < 8; ++e) { const float q0 = acc[2 * e] * rq, q1 = acc[2 * e + 1] * rq; pq[e] = pk2(q0, q1); pqg[e] = pk2(q0 * eg, q1 * eg); }
                    ST_IMG(IMG_Q, pq);
                    unsigned char* qgb = QGp + (size_t)un * 16384 + (((row >> 4) * 4 + (cg >> 1)) * 64 + (row & 15)) * 16 + (cg & 1) * 8;
#pragma unroll
                    for (int gp = 0; gp < 4; ++gp) *(v2u*)(qgb + gp * 16 * 16) = (v2u){pqg[2 * gp], pqg[2 * gp + 1]};
                } else if (mat == 1) {
                    unsigned pk_[8], pkb[8], pkbg[8], pkg[8];
#pragma unroll
                    for (int e = 0; e < 8; ++e) { const float k0 = acc[2 * e] * rn, k1 = acc[2 * e + 1] * rn; pk_[e] = pk2(k0, k1); pkb[e] = pk2(k0 * beta, k1 * beta);
                        pkbg[e] = pk2(k0 * beta * eg, k1 * beta * eg); pkg[e] = pk2(k0 * ekl, k1 * ekl); }
                    ST_IMG(IMG_K, pk_); ST_IMG(IMG_KB, pkb); ST_IMG(IMG_KBG, pkbg); ST_IMG(IMG_KG, pkg);
                } else {
                    unsigned pvb[8];
#pragma unroll
                    for (int e = 0; e < 8; ++e) pvb[e] = pk2(acc[2 * e] * beta, acc[2 * e + 1] * beta);
                    ST_IMG(IMG_VB, pvb);
                }
                asm volatile("" ::: "memory");
            }
#undef ST_IMG
        }
        }
        __syncthreads();
        f32x4 m1[4];
        if (w < 4) {
            const int it = w;
            bf16x8 fa[4], fb[4][4];
#pragma unroll
            for (int ks = 0; ks < 4; ++ks) fa[ks] = ldsb128(L + IMG_KB + (16 * it + li) * CP_STR + (32 * ks + 8 * g) * 2);
#pragma unroll
            for (int nt = 0; nt < 4; ++nt)
#pragma unroll
                for (int ks = 0; ks < 4; ++ks) fb[nt][ks] = ldsb128(L + IMG_K + (16 * nt + li) * CP_STR + (32 * ks + 8 * g) * 2);
            __builtin_amdgcn_sched_barrier(0);
#pragma unroll
            for (int nt = 0; nt < 4; ++nt) {
                f32x4 acc = {0.f, 0.f, 0.f, 0.f};
#pragma unroll
                for (int ks = 0; ks < 4; ++ks) acc = MFMA16(fa[ks], fb[nt][ks], acc);
                const int j = 16 * nt + li; const float gj = gcs[j]; const f32x4 giv = *(const LAS f32x4*)(gcs + 16 * it + 4 * g);
#pragma unroll
                for (int i2 = 0; i2 < 4; ++i2) { const int i = 16 * it + 4 * g + i2; const float e = __expf(fminf(giv[i2] - gj, 0.f)); m1[nt][i2] = (i > j) ? -acc[i2] * e : 0.f; }
            }
        } else {
            const int it = w - 4, i = 16 * it + li; const float gi = gcs[i];
            v2u fr[4];
            bf16x8 fq[4], fk[4][4];
#pragma unroll
            for (int ks = 0; ks < 4; ++ks) fq[ks] = ldsb128(L + IMG_Q + (16 * it + li) * CP_STR + (32 * ks + 8 * g) * 2);
#pragma unroll
            for (int jt = 0; jt < 4; ++jt)
#pragma unroll
                for (int ks = 0; ks < 4; ++ks) fk[jt][ks] = ldsb128(L + IMG_K + (16 * jt + li) * CP_STR + (32 * ks + 8 * g) * 2);
            __builtin_amdgcn_sched_barrier(0);
#pragma unroll
            for (int jt = 0; jt < 4; ++jt) {
                f32x4 acc = {0.f, 0.f, 0.f, 0.f};
#pragma unroll
                for (int ks = 0; ks < 4; ++ks) acc = MFMA16(fk[jt][ks], fq[ks], acc);
                const f32x4 gjv = *(const LAS f32x4*)(gcs + 16 * jt + 4 * g);
#pragma unroll
                for (int i2 = 0; i2 < 4; ++i2) { const int j = 16 * jt + 4 * g + i2; const float e = __expf(fminf(gi - gjv[i2], 0.f)); acc[i2] = (j <= i) ? acc[i2] * e : 0.f; }
                fr[jt] = pk4(acc);
            }
            unsigned char* ab = ATp + (size_t)un * 8192 + ((it * 2) * 64 + lane) * 16;
            *(v4u*)ab = (v4u){fr[0].x, fr[0].y, fr[1].x, fr[1].y}; *(v4u*)(ab + 1024) = (v4u){fr[2].x, fr[2].y, fr[3].x, fr[3].y};
        }
        __syncthreads();
        LAS float* Md = (LAS float*)(L + CP_GATES + 1024);
        LAS unsigned char* Tt = L + 3 * NM_IMG;
        if (w < 4) {
#pragma unroll
            for (int nt = 0; nt < 4; ++nt) { const int o = (16 * nt + li) * NM_STR + (16 * w + 4 * g) * 2; *(LAS v2u*)(L + o) = pk4(m1[nt]); if (nt > w) *(LAS v2u*)(Tt + o) = (v2u){0u, 0u}; }
#pragma unroll
            for (int nt = 0; nt < 4; ++nt) if (nt == w) {
#pragma unroll
                for (int i2 = 0; i2 < 4; ++i2) Md[w * 256 + (4 * g + i2) * 16 + li] = m1[nt][i2]; }
        } else {
#pragma unroll
            for (int q = 0; q < 4; ++q) {
                const int f = (w - 4) * 4 + q, dkt = f >> 1, ks2 = f & 1;
                LAS unsigned char* p = L + IMG_KG + (32 * ks2 + 4 * g + (li >> 2)) * CP_STR + (16 * dkt + 4 * (li & 3)) * 2;
                const bf16x8 fr = tr_pair(p, 16 * CP_STR);
                *(bf16x8*)(KGp + (size_t)un * 16384 + ((dkt * 2 + ks2) * 64 + lane) * 16) = fr;
            }
        }
        __syncthreads();
        if (w == 0) {
            float xv[16];
#pragma unroll
            for (int i = 0; i < 16; ++i) {
                float a = (i == li) ? 1.0f : 0.0f;
#pragma unroll
                for (int k4 = 0; k4 < (i + 3) / 4; ++k4) {
                    const f32x4 mv = *(const LAS f32x4*)(Md + g * 256 + i * 16 + 4 * k4);
#pragma unroll
                    for (int e = 0; e < 4; ++e) if (4 * k4 + e < i) a += mv[e] * xv[4 * k4 + e];
                }
                xv[i] = a;
            }
            v4u lo, hi;
            lo.x = pk2(xv[0], xv[1]); lo.y = pk2(xv[2], xv[3]); lo.z = pk2(xv[4], xv[5]); lo.w = pk2(xv[6], xv[7]);
            hi.x = pk2(xv[8], xv[9]); hi.y = pk2(xv[10], xv[11]); hi.z = pk2(xv[12], xv[13]); hi.w = pk2(xv[14], xv[15]);
            LAS unsigned char* d = Tt + (16 * g + li) * NM_STR + (16 * g) * 2;
            *(LAS v4u*)d = lo; *(LAS v4u*)(d + 16) = hi;
        }
        __syncthreads();
        const bf16x8 zf = {0, 0, 0, 0, 0, 0, 0, 0};
        if (w < 2) {
            const int p = w;
            bf16x8 af = tr_pair(L + (32 * p + 8 * g + (li >> 2)) * NM_STR + (32 * p + 16 + 4 * (li & 3)) * 2, 4 * NM_STR);
            bf16x8 bfr = ldsb128(Tt + (32 * p + li) * NM_STR + (32 * p + 8 * g) * 2);
            if (g >= 2) { af = zf; bfr = zf; }
            f32x4 a = {0.f, 0.f, 0.f, 0.f}; a = MFMA16(af, bfr, a);
            *(LAS v2u*)(L + 1 * NM_IMG + (16 * p + li) * NM_STR + (4 * g) * 2) = pk4(a);
        }
        __syncthreads();
        if (w < 2) {
            const int p = w;
            bf16x8 af = tr_pair(Tt + (32 * p + 16 + 8 * g + (li >> 2)) * NM_STR + (32 * p + 16 + 4 * (li & 3)) * 2, 4 * NM_STR);
            bf16x8 bfr = ldsb128(L + 1 * NM_IMG + (16 * p + li) * NM_STR + (8 * g) * 2);
            if (g >= 2) { af = zf; bfr = zf; }
            f32x4 a = {0.f, 0.f, 0.f, 0.f}; a = MFMA16(af, bfr, a);
            *(LAS v2u*)(Tt + (32 * p + li) * NM_STR + (32 * p + 16 + 4 * g) * 2) = pk4(a);
        }
        __syncthreads();
        if (w < 4) {
            const int ti = w >> 1, tn = w & 1;
            const bf16x8 af = tr_pair(L + (8 * g + (li >> 2)) * NM_STR + (32 + 16 * ti + 4 * (li & 3)) * 2, 4 * NM_STR);
            const bf16x8 bfr = ldsb128(Tt + (16 * tn + li) * NM_STR + (8 * g) * 2);
            f32x4 a = {0.f, 0.f, 0.f, 0.f}; a = MFMA16(af, bfr, a);
            *(LAS v2u*)(L + 2 * NM_IMG + (16 * tn + li) * NM_STR + (16 * ti + 4 * g) * 2) = pk4(a);
        }
        __syncthreads();
        if (w < 4) {
            const int ti = w >> 1, tn = w & 1;
            const bf16x8 af = tr_pair(Tt + (32 + 8 * g + (li >> 2)) * NM_STR + (32 + 16 * ti + 4 * (li & 3)) * 2, 4 * NM_STR);
            const bf16x8 bfr = ldsb128(L + 2 * NM_IMG + (16 * tn + li) * NM_STR + (8 * g) * 2);
            f32x4 a = {0.f, 0.f, 0.f, 0.f}; a = MFMA16(af, bfr, a);
            *(LAS v2u*)(Tt + (16 * tn + li) * NM_STR + (32 + 16 * ti + 4 * g) * 2) = pk4(a);
        }
        __syncthreads();
        for (int rp_ = 0; rp_ < (PROBE_CP == 3 ? 2 : 1); ++rp_) {
        {
            bf16x8 tf[4][2];
#pragma unroll
            for (int it = 0; it < 4; ++it)
#pragma unroll
                for (int ks = 0; ks < 2; ++ks) tf[it][ks] = tr_pair(Tt + (32 * ks + 8 * g + (li >> 2)) * NM_STR + (16 * it + 4 * (li & 3)) * 2, 4 * NM_STR);
            bf16x8 vbf[2], kbf[2];
#pragma unroll
            for (int ks = 0; ks < 2; ++ks) {
                const int o = (32 * ks + 8 * g + (li >> 2)) * CP_STR + (16 * w + 4 * (li & 3)) * 2;
                vbf[ks] = tr_pair(L + IMG_VB + o, 4 * CP_STR); kbf[ks] = tr_pair(L + IMG_KBG + o, 4 * CP_STR);
            }
#pragma unroll
            for (int it = 0; it < 4; ++it) {
                f32x4 a = {0.f, 0.f, 0.f, 0.f}; a = MFMA16(tf[it][0], vbf[0], a); a = MFMA16(tf[it][1], vbf[1], a);
                *(f32x4*)(UFp + (size_t)un * 32768 + ((w * 4 + it) * 64 + lane) * 16) = a;
                f32x4 d = {0.f, 0.f, 0.f, 0.f}; d = MFMA16(kbf[0], tf[it][0], d); d = MFMA16(kbf[1], tf[it][1], d);
                *(v2u*)(WFp + (size_t)un * 16384 + ((it * 4 + (w >> 1)) * 64 + lane) * 16 + (w & 1) * 8) = pk4(-d);
            }
        }
        }
        __syncthreads();
    }
}

constexpr int SC_SLOT = 43008;
#define SB_() __builtin_amdgcn_sched_barrier(0)
__device__ __forceinline__ void scan_compute(const LAS unsigned char* B, f32x4 (&S)[8], float dc, unsigned char* sbp, unsigned char* vbp, int lane) {
    const LAS unsigned char* Bl = B + lane * 16;
    bf16x8 h0[8], h1[8];
    f32x4 vn[4];
#pragma unroll
    for (int mt = 0; mt < 4; ++mt) { h0[2 * mt] = ldsb128(Bl + (mt * 4 + 0) * 1024); h0[2 * mt + 1] = ldsb128(Bl + (mt * 4 + 1) * 1024); }
#pragma unroll
    for (int mt = 0; mt < 4; ++mt) vn[mt] = *(const LAS f32x4*)(Bl + 32768 + mt * 1024);
#pragma unroll
    for (int mt = 0; mt < 4; ++mt) { h1[2 * mt] = ldsb128(Bl + (mt * 4 + 2) * 1024); h1[2 * mt + 1] = ldsb128(Bl + (mt * 4 + 3) * 1024); }
    bf16x8 Sb[4];
#pragma unroll
    for (int ks = 0; ks < 4; ++ks) { const v2u lo = pk4(S[2 * ks]), hi = pk4(S[2 * ks + 1]); Sb[ks] = __builtin_bit_cast(bf16x8, (v4u){lo.x, lo.y, hi.x, hi.y}); __builtin_nontemporal_store(Sb[ks], (bf16x8*)(sbp + ks * 1024)); }
    SB_();
#pragma unroll
    for (int k2 = 0; k2 < 2; ++k2)
#pragma unroll
        for (int mt = 0; mt < 4; ++mt) vn[mt] = MFMA16(h0[2 * mt + k2], Sb[k2], vn[mt]);
    SB_();
#pragma unroll
    for (int d = 0; d < 4; ++d) { h0[2 * d] = ldsb128(Bl + 16384 + (d * 2) * 1024); h0[2 * d + 1] = ldsb128(Bl + 16384 + (d * 2 + 1) * 1024); }
    SB_();
#pragma unroll
    for (int k2 = 0; k2 < 2; ++k2)
#pragma unroll
        for (int mt = 0; mt < 4; ++mt) vn[mt] = MFMA16(h1[2 * mt + k2], Sb[2 + k2], vn[mt]);
    SB_();
#pragma unroll
    for (int d = 0; d < 4; ++d) { h1[2 * d] = ldsb128(Bl + 16384 + ((d + 4) * 2) * 1024); h1[2 * d + 1] = ldsb128(Bl + 16384 + ((d + 4) * 2 + 1) * 1024); }
    bf16x8 vb[2];
#pragma unroll
    for (int ks = 0; ks < 2; ++ks) { const v2u lo = pk4(vn[2 * ks]), hi = pk4(vn[2 * ks + 1]); vb[ks] = __builtin_bit_cast(bf16x8, (v4u){lo.x, lo.y, hi.x, hi.y}); __builtin_nontemporal_store(vb[ks], (bf16x8*)(vbp + ks * 1024)); }
#pragma unroll
    for (int d = 0; d < 8; ++d) S[d] = S[d] * dc;
    SB_();
#pragma unroll
    for (int ks = 0; ks < 2; ++ks)
#pragma unroll
        for (int d = 0; d < 4; ++d) S[d] = MFMA16(h0[2 * d + ks], vb[ks], S[d]);
#pragma unroll
    for (int ks = 0; ks < 2; ++ks)
#pragma unroll
        for (int d = 0; d < 4; ++d) S[4 + d] = MFMA16(h1[2 * d + ks], vb[ks], S[4 + d]);
    SB_();
}
#undef SB_
#define SCAN_STRIDE(i_) ((i_) == 4 ? st4 : ((i_) == 5 ? 32768u : 16384u))
#define SCAN_LOAD(R, CHK) do { const size_t un_ = (size_t)(bh * 128 + ((CHK) < NCH ? (CHK) : NCH - 1)); _Pragma("unroll") for (int i_ = 0; i_ < 6; ++i_) R[i_] = *(const v4u*)(F.ws + bo[i_] + un_ * SCAN_STRIDE(i_)); } while (0)
#define SCAN_STORE(R, SLOT) do { LAS unsigned char* Bn_ = L + (SLOT) * SC_SLOT + lt * 16; _Pragma("unroll") for (int i_ = 0; i_ < 6; ++i_) *(LAS v4u*)(Bn_ + i_ * 448 * 16) = R[i_]; } while (0)
#define SCAN_BAR() do { asm volatile("s_waitcnt lgkmcnt(0)" ::: "memory"); __builtin_amdgcn_s_barrier(); asm volatile("" ::: "memory"); } while (0)
__device__ __forceinline__ void ph_scan(Frame& F) {
    if (F.blk < 128) {
        const int x = F.blk & 7, qq = F.blk >> 3, bh = x + 8 * (qq >> 3), s = qq & 7;
        const int lane = F.lane, w = F.wave;
        LAS unsigned char* L = F.lds;
        const float* CDEC = WSP(const float, WS_CDEC);
        if (w == 0) {
            unsigned char* sbp = F.ws + WS_SBF + ((size_t)(bh * 128) * 8 + s) * 4096 + lane * 16;
            unsigned char* vbp = F.ws + WS_VBF + ((size_t)(bh * 128) * 8 + s) * 2048 + lane * 16;
            f32x4 S[8];
#pragma unroll
            for (int d = 0; d < 8; ++d) S[d] = (f32x4){0.f, 0.f, 0.f, 0.f};
            float dnext = CDEC[bh * 128];
            SCAN_BAR();
#pragma unroll 1
            for (int c = 0; c < NCH; c += 2) {
                { const float dc = dnext; dnext = CDEC[bh * 128 + c + 1]; scan_compute(L, S, dc, sbp + (size_t)c * 32768, vbp + (size_t)c * 16384, lane); }
                SCAN_BAR();
                { const float dc = dnext; dnext = CDEC[bh * 128 + (c + 2 < NCH ? c + 2 : NCH - 1)]; scan_compute(L + SC_SLOT, S, dc, sbp + (size_t)(c + 1) * 32768, vbp + (size_t)(c + 1) * 16384, lane); }
                SCAN_BAR();
            }
        } else {
            const int lt = (w - 1) * 64 + lane;
            unsigned bo[6]; unsigned st4 = 16384u;
#pragma unroll
            for (int i = 0; i < 6; ++i) {
                int j = lt + 448 * i; j = j < 2304 ? j : 2303;
                unsigned o = (unsigned)WS_WF + (unsigned)j * 16u;
                if (j >= 1024) o = (unsigned)WS_KGF + (unsigned)(j - 1024) * 16u;
                if (j >= 2048) { o = (unsigned)WS_UF + (unsigned)s * 4096u + (unsigned)(j - 2048) * 16u; if (i == 4) st4 = 32768u; }
                bo[i] = o;
            }
            v4u rA[6], rB[6], rC[6], rD[6];
            SCAN_LOAD(rA, 0); SCAN_STORE(rA, 0); SCAN_LOAD(rA, 1); SCAN_LOAD(rB, 2); SCAN_LOAD(rC, 3); SCAN_LOAD(rD, 4);
            SCAN_BAR();
#pragma unroll 1
            for (int c = 0; c < NCH; c += 4) {
                SCAN_STORE(rA, 1); SCAN_LOAD(rA, c + 5); SCAN_BAR();
                SCAN_STORE(rB, 0); SCAN_LOAD(rB, c + 6); SCAN_BAR();
                SCAN_STORE(rC, 1); SCAN_LOAD(rC, c + 7); SCAN_BAR();
                SCAN_STORE(rD, 0); SCAN_LOAD(rD, c + 8); SCAN_BAR();
            }
        }
    } else {
#if CONV_IN_SCAN
        ph_weights_moe_blk(F, F.blk - 128, 128);
#endif
    }
}
#undef SCAN_LOAD
#undef SCAN_STRIDE
#undef SCAN_STORE
#undef SCAN_BAR
#define OP_BAR() do { asm volatile("s_waitcnt lgkmcnt(0)" ::: "memory"); __builtin_amdgcn_s_barrier(); asm volatile("" ::: "memory"); } while (0)
struct OpSmall { bf16x8 sf[4], vf[2]; unsigned short gt[16]; };
__device__ __forceinline__ void op_issue(Frame& F, int un, int w, int lane, LAS unsigned char* tile, OpSmall& R) {
#pragma unroll
    for (int q = 0; q < 3; ++q) { const int f = w * 3 + q;
        const unsigned char* src = (f < 16 ? F.ws + WS_QGF + (size_t)un * 16384 + f * 1024 : F.ws + WS_ATF + (size_t)un * 8192 + (f - 16) * 1024) + lane * 16;
        __builtin_amdgcn_global_load_lds((const unsigned*)src, (LAS unsigned*)(tile + f * 1024), 16, 0, 0); }
    const unsigned char* sb = F.ws + WS_SBF + ((size_t)un * 8 + w) * 4096 + lane * 16;
    const unsigned char* vb = F.ws + WS_VBF + ((size_t)un * 8 + w) * 2048 + lane * 16;
#pragma unroll
    for (int i = 0; i < 4; ++i) R.sf[i] = *(const bf16x8*)(sb + i * 1024);
#pragma unroll
    for (int i = 0; i < 2; ++i) R.vf[i] = *(const bf16x8*)(vb + i * 1024);
    const int b = un >> 10, h = (un >> 7) & 7, c = un & 127, li = lane & 15, g = lane >> 4;
    const bf16* gp = WSP(const bf16, WS_GATE) + ((size_t)b * T + (size_t)c * CH + 4 * g) * D + 128 * h + 16 * w + li;
#pragma unroll
    for (int mt = 0; mt < 4; ++mt)
#pragma unroll
        for (int i = 0; i < 4; ++i) R.gt[mt * 4 + i] = gp[(size_t)(16 * mt + i) * D];
}
__device__ __forceinline__ void ph_ophase(Frame& F) {
    bf16* MIX = WSP(bf16, WS_MIX);
    LAS float* part = (LAS float*)F.lds;
    LAS float* rinv = part + 512;
    LAS unsigned char* tiles = F.lds + 4096;
    const int w = F.wave;
    constexpr int NU = NB * DH * NCH;
    OpSmall R;
    if (F.blk < NU) op_issue(F, F.blk, w, F.lane, tiles, R);
    int par = 0;
#pragma unroll 1
    for (int un = F.blk; un < NU; un += GRID, par ^= 1) {
        int tid = F.tid; asm volatile("" : "+v"(tid));
        const int lane = tid & 63, li = lane & 15, g = lane >> 4;
        const int b = un >> 10, h = (un >> 7) & 7, c = un & 127;
        OpSmall C = R;
        asm volatile("s_waitcnt vmcnt(0)" ::: "memory");
        OP_BAR();
        if (un + GRID < NU) op_issue(F, un + GRID, w, lane, tiles + (par ^ 1) * 24576, R);
        const LAS unsigned char* tl = tiles + par * 24576 + lane * 16;
        f32x4 oa[4];
#pragma unroll
        for (int mt = 0; mt < 4; ++mt) { oa[mt] = (f32x4){0.f, 0.f, 0.f, 0.f};
#pragma unroll
            for (int ks = 0; ks < 4; ++ks) oa[mt] = MFMA16(ldsb128(tl + (mt * 4 + ks) * 1024), C.sf[ks], oa[mt]);
#pragma unroll
            for (int ks = 0; ks < 2; ++ks) oa[mt] = MFMA16(ldsb128(tl + 16384 + (mt * 2 + ks) * 1024), C.vf[ks], oa[mt]); }
#pragma unroll
        for (int mt = 0; mt < 4; ++mt)
#pragma unroll
            for (int i = 0; i < 4; ++i) { const float q = row16_sum(oa[mt][i] * oa[mt][i]); if (li == 0) part[w * 64 + 16 * mt + 4 * g + i] = q; }
        OP_BAR();
        if (tid < 64) { float sacc = 0.f;
#pragma unroll
            for (int q = 0; q < 8; ++q) sacc += part[q * 64 + tid];
            rinv[tid] = 1.0f / sqrtf(sacc * (1.f / DHD) + EPS); }
        OP_BAR();
        const float ng = F.o_norm_g[16 * w + li];
        LAS unsigned char* ot = F.lds + 4096 + 2 * 24576;
#pragma unroll
        for (int mt = 0; mt < 4; ++mt) { const f32x4 rv = *(const LAS f32x4*)(rinv + 16 * mt + 4 * g);
#pragma unroll
            for (int i = 0; i < 4; ++i) { const float gv = bf2f(C.gt[mt * 4 + i]); *(LAS unsigned short*)(ot + (16 * mt + 4 * g + i) * 272 + (16 * w + li) * 2) = (unsigned short)f2bf(oa[mt][i] * rv[i] * ng * silu_f(gv)); } }
        OP_BAR();
        { bf16* mp = MIX + ((size_t)b * T + (size_t)c * CH) * D + 128 * h;
#pragma unroll
          for (int q = 0; q < 2; ++q) { const int p = tid + 512 * q, row = p >> 4, ch = p & 15; *(v4u*)(mp + (size_t)row * D + ch * 8) = *(const LAS v4u*)(ot + row * 272 + ch * 16); } }
    }
    asm volatile("s_waitcnt vmcnt(0)" ::: "memory"); __syncthreads();
}
#undef OP_BAR
constexpr int NPHASE = 20;
__global__ void __launch_bounds__(NTHR, 2) mega(Args args) {
    extern __shared__ __attribute__((aligned(16))) unsigned char lds_raw[];
    Frame F; frame_init(F, args, (LAS unsigned char*)lds_raw);
    volatile LAS unsigned* MISC = (volatile LAS unsigned*)(F.lds + MISC_OFF);
    for (int u = F.tid; u < (LDS_BYTES - MISC_OFF) / 4; u += NTHR) ((LAS unsigned*)(F.lds + MISC_OFF))[u] = 0u;
    __syncthreads();
    const int lo = args.ph_lo, hi = args.ph_hi;
    XcdBarrier bar; bar.bar = WSP(unsigned, WS_CTL) + CW_BAR + args.li * XCD_BAR_WORDS; bar.x = 0; bar.st = nullptr;
    if (hi - lo > 1) bar = xcd_barrier_post(WSP(unsigned, WS_CTL) + CW_BAR + args.li * XCD_BAR_WORDS, MISC + 8);
#define IN(k) (lo <= (k) && (k) < hi)
#define SEAM(k) do { if (IN(k) && IN((k) + 1)) xcd_barrier(bar); } while (0)
    if (IN(0)) { ph_mod_rope(F); __syncthreads(); ph_weights_dense(F); SEAM(0); }
    if (IN(1)) { ph_norm_a(F); SEAM(1); }
    if (IN(2)) {
        pg8::Gemm g{WSP(const bf16, WS_H), WSP(const bf16, WS_WB_L0IN), M, L0N, D}; pg8::StaticOrder S; S.init(M, L0N, GRID, F.blk);
        pg8::EpiL0In E{WSP(bf16, WS_PROJ0), WSP(const float, WS_ROPE)};
        pg8::gemm_phase<pg8::EpiL0In, pg8::StaticOrder, true, true>(F.lds, g, S, E);
        SEAM(2);
    }
    if (IN(3)) { ph_attn_pool(F); SEAM(3); }
    if (IN(4)) { ph_attn_combine(F); SEAM(4); }
    if (IN(5)) {
        pg8::Gemm g{WSP(const bf16, WS_MIX), WSP(const bf16, WS_WB_L0OUT), M, D, D}; pg8::StaticOrder S; S.init(M, D, GRID, F.blk);
        pg8::EpiPlain E{WSP(bf16, WS_Y), D, nullptr, 0, 1 << 30, 1 << 30, 1.0f};
        pg8::gemm_phase<pg8::EpiPlain, pg8::StaticOrder, true, true>(F.lds, g, S, E);
        SEAM(5);
    }
    if (IN(6)) { ph_norm_mid<0>(F); SEAM(6); }
    if (IN(7)) {
        pg8::Gemm g{WSP(const bf16, WS_H), WSP(const bf16, WS_WB_L0GU), M, 2 * FF, D}; pg8::StaticOrder S; S.init(M, 2 * FF, GRID, F.blk);
        pg8::EpiSwiglu E{WSP(bf16, WS_HID0), FF, 1 << 30};
        pg8::gemm_phase<pg8::EpiSwiglu, pg8::StaticOrder, true, true>(F.lds, g, S, E);
        SEAM(7);
    }
    if (IN(8)) {
        pg8::Gemm g{WSP(const bf16, WS_HID0), WSP(const bf16, WS_WB_L0DN), M, D, FF}; pg8::StaticOrder S; S.init(M, D, GRID, F.blk);
        pg8::EpiPlain E{WSP(bf16, WS_Y), D, nullptr, 0, 1 << 30, 1 << 30, 1.0f};
        pg8::gemm_phase<pg8::EpiPlain, pg8::StaticOrder, true, true>(F.lds, g, S, E);
        SEAM(8);
    }
    if (IN(9)) { ph_norm_mid<1>(F); SEAM(9); }
    if (IN(10)) {
        pg8::Gemm g{WSP(const bf16, WS_H), WSP(const bf16, WS_WB_L1IN), M, 4096, D}; pg8::StaticOrder S; S.init(M, 4096, GRID, F.blk);
        pg8::EpiPlain E{WSP(bf16, WS_QKV), 3072, WSP(bf16, WS_GATE), D, 12, 1 << 30, 1.0f};
        pg8::gemm_phase<pg8::EpiPlain, pg8::StaticOrder, true, true>(F.lds, g, S, E);
        SEAM(10);
    }
    if (IN(11)) { ph_chunk_prep(F); SEAM(11); }
    if (IN(12)) { ph_scan(F); SEAM(12); }
    if (IN(13)) { ph_ophase(F); SEAM(13); }
    if (IN(14)) {
        pg8::Gemm g{WSP(const bf16, WS_MIX), WSP(const bf16, WS_WB_L1OUT), M, D, D}; pg8::StaticOrder S; S.init(M, D, GRID, F.blk);
        pg8::EpiPlain E{WSP(bf16, WS_Y), D, nullptr, 0, 1 << 30, 1 << 30, 1.0f};
        pg8::gemm_phase<pg8::EpiPlain, pg8::StaticOrder, true, true>(F.lds, g, S, E);
        SEAM(14);
    }
    if (IN(15)) { ph_norm_mid<2>(F); SEAM(15); }
    if (IN(16)) { ph_moe_gather(F);
        SEAM(16); }
    if (IN(17)) {
        pg8::Gemm g{F.ws + WS_ASORT, F.ws + WS_WB_GU, MAXROWS, NE * 2 * FF, D}; pg8::MoeOrder S; S.init(WSP(const int, WS_CTL) + CW_TP, 28, GRID, F.blk);
        pg8::EpiSwigluF8 E{F.ws + WS_HID, FF, 28, 0.03125f, 4.0f};
        pg8::gemm_phase<pg8::EpiSwigluF8, pg8::MoeOrder, true, true, true>(F.lds, g, S, E);
        SEAM(17);
    }
    if (IN(18)) {
        pg8::Gemm g{F.ws + WS_HID, F.ws + WS_WB_DN, MAXROWS, NE * D, FF}; pg8::MoeOrder S; S.init(WSP(const int, WS_CTL) + CW_TP, 4, GRID, F.blk);
        pg8::EpiPlain E{WSP(bf16, WS_YS), D, nullptr, 0, 1 << 30, 4, 0.00390625f};
        pg8::gemm_phase<pg8::EpiPlain, pg8::MoeOrder, true, true, true>(F.lds, g, S, E);
        SEAM(18);
    }
    if (IN(19)) { ph_final(F); }
#undef IN
#undef SEAM
}

extern "C" void kernel_launch(void* const* d_in, const int* in_sizes, int n_in, void* d_out, int out_size, void* d_ws, size_t ws_size, hipStream_t stream) {
    static int ok = 0;
    if (ok == 0) {
        if (n_in != 26 || in_sizes[0] != M * D || out_size != M * D || ws_size < WS_NEED) { fprintf(stderr, "kernel_launch: unexpected shapes (n_in %d, in0 %d, out %d, ws %zu)\n", n_in, n_in > 0 ? in_sizes[0] : -1, out_size, ws_size); ok = -1; return; }
        if (hipFuncSetAttribute((const void*)mega, hipFuncAttributeMaxDynamicSharedMemorySize, LDS_BYTES) != hipSuccess) { fprintf(stderr, "kernel_launch: hipFuncSetAttribute failed\n"); ok = -1; return; }
        int per_cu = 0; (void)hipOccupancyMaxActiveBlocksPerMultiprocessor(&per_cu, (const void*)mega, NTHR, LDS_BYTES); (void)hipGetLastError();
        if (per_cu < 1) fprintf(stderr, "kernel_launch: occupancy query says %d\n", per_cu);
        ok = 1;
    }
    if (ok < 0) return;
    (void)hipMemsetAsync((char*)d_ws + WS_CTL, 0, CTL_BYTES, stream);
    Args a{}; for (int i = 0; i < 26; ++i) a.in[i] = d_in[i]; a.out = (float*)d_out; a.ws = (unsigned char*)d_ws;
    a.ph_lo = 0; a.ph_hi = NPHASE; a.li = 0;
    hipLaunchKernelGGL(mega, dim3(GRID), dim3(NTHR), LDS_BYTES, stream, a);
}
```

```cpp
#include <hip/hip_runtime.h>
#include <cstdio>
#include <cstdint>

#ifndef CONV_IN_SCAN
#define CONV_IN_SCAN 1
#endif
#define GAS __attribute__((address_space(1)))
#define LAS __attribute__((address_space(3)))
typedef unsigned short bf16;
typedef float f32x4 __attribute__((ext_vector_type(4)));
typedef float f32x2 __attribute__((ext_vector_type(2)));
typedef short bf16x8 __attribute__((ext_vector_type(8)));
typedef short s16x4 __attribute__((ext_vector_type(4)));
typedef unsigned v4u __attribute__((ext_vector_type(4)));
typedef unsigned v2u __attribute__((ext_vector_type(2)));

constexpr int NB = 2, T = 8192, D = 1024, M = NB * T;
constexpr int AH = 8, AHD = 64, AW = 512;
constexpr int L0N = 2048;
constexpr int FF = 3584;
constexpr int DH = 8, DHD = 128;
constexpr int L1N = 4112;
constexpr int NE = 8;
constexpr int CH = 64, NCH = T / CH;
constexpr float EPS = 1e-6f;
constexpr int MAXTILES = 136;
constexpr int MAXROWS = MAXTILES * 256;

constexpr size_t MiB = 1u << 20;
constexpr size_t WS_CTL = 0, CTL_BYTES = 1 * MiB;
constexpr size_t WS_MOD = 1 * MiB;
constexpr size_t WS_ROPE = 2 * MiB;
constexpr size_t WS_BL = 3 * MiB;
constexpr size_t WS_ROUTE = 4 * MiB;
constexpr size_t WS_LSE = 5 * MiB;
constexpr size_t WS_POOLWT = 7 * MiB;
constexpr size_t WS_H = 8 * MiB;
constexpr size_t WS_WB_L1IN = 40 * MiB;
constexpr size_t WS_WB_L1OUT = 48 * MiB;
constexpr size_t WS_WB_L0IN = 50 * MiB;
constexpr size_t WS_WB_L0OUT = 54 * MiB;
constexpr size_t WS_WB_L0GU = 56 * MiB;
constexpr size_t WS_WB_L0DN = 70 * MiB;
constexpr size_t WS_Y = 78 * MiB;
constexpr size_t WS_MIX = 110 * MiB;
constexpr size_t WS_G0 = 142 * MiB;
constexpr size_t WS_PROJ0 = WS_G0;
constexpr size_t WS_ATTP = WS_G0 + 64 * MiB;
constexpr size_t WS_HID0 = WS_G0 + 112 * MiB;
constexpr size_t WS_QKV = WS_G0;
constexpr size_t WS_GATE = WS_G0 + 96 * MiB;
constexpr size_t WS_WF = WS_G0 + 128 * MiB;
constexpr size_t WS_QGF = WS_G0 + 160 * MiB;
constexpr size_t WS_KGF = WS_G0 + 192 * MiB;
constexpr size_t WS_ATF = WS_G0 + 224 * MiB;
constexpr size_t WS_UF = WS_G0 + 240 * MiB;
constexpr size_t WS_O = WS_G0 + 304 * MiB;
constexpr size_t WS_SBF = WS_G0 + 304 * MiB;
constexpr size_t WS_VBF = WS_H;
constexpr size_t WS_CDEC = 6 * MiB + 512 * 1024;
constexpr size_t WS_ASORT = 8 * MiB;
constexpr size_t WS_YS = 42 * MiB;
constexpr size_t WS_WB_GU = WS_G0;
constexpr size_t WS_WB_DN = WS_G0 + 56 * MiB;
constexpr size_t WS_H2 = WS_G0 + 84 * MiB;
constexpr size_t WS_HID = WS_G0 + 112 * MiB;
constexpr size_t WS_NEED = 512 * MiB;
constexpr int CW_BAR = 4096;
constexpr int CW_CNT = 120000;
constexpr int CW_TP = 130000;

__device__ __forceinline__ unsigned f2bf(float f) { unsigned u = __builtin_bit_cast(unsigned, f); return (u + 0x7fffu + ((u >> 16) & 1u)) >> 16; }
typedef __bf16 bf16x2_t __attribute__((ext_vector_type(2)));
__device__ __forceinline__ unsigned pk2(float lo, float hi) { const f32x2 v = {lo, hi}; return __builtin_bit_cast(unsigned, __builtin_convertvector(v, bf16x2_t)); }
__device__ __forceinline__ float bf2f(unsigned b) { return __builtin_bit_cast(float, (b & 0xffffu) << 16); }
__device__ __forceinline__ float bflo(unsigned w) { return __builtin_bit_cast(float, w << 16); }
__device__ __forceinline__ float bfhi(unsigned w) { return __builtin_bit_cast(float, w & 0xffff0000u); }
__device__ __forceinline__ unsigned pk4f8(float a, float b, float c, float d) {
    a = __builtin_amdgcn_fmed3f(a, -448.f, 448.f); b = __builtin_amdgcn_fmed3f(b, -448.f, 448.f); c = __builtin_amdgcn_fmed3f(c, -448.f, 448.f); d = __builtin_amdgcn_fmed3f(d, -448.f, 448.f);
    unsigned w = 0u; w = __builtin_amdgcn_cvt_pk_fp8_f32(a, b, w, false); w = __builtin_amdgcn_cvt_pk_fp8_f32(c, d, w, true); return w; }
#define DPP_ADD(v, ctrl) v += __builtin_bit_cast(float, __builtin_amdgcn_mov_dpp(__builtin_bit_cast(int, v), ctrl, 0xf, 0xf, true))
__device__ __forceinline__ float row16_sum(float v) { DPP_ADD(v, 0xB1); DPP_ADD(v, 0x4E); DPP_ADD(v, 0x141); DPP_ADD(v, 0x140); return v; }
__device__ __forceinline__ float row8_sum(float v) { DPP_ADD(v, 0xB1); DPP_ADD(v, 0x4E); DPP_ADD(v, 0x141); return v; }
__device__ __forceinline__ float wave_sum(float v) {
    const int r = __builtin_bit_cast(int, row16_sum(v));
    return (__builtin_bit_cast(float, __builtin_amdgcn_readlane(r, 0)) + __builtin_bit_cast(float, __builtin_amdgcn_readlane(r, 16))) + (__builtin_bit_cast(float, __builtin_amdgcn_readlane(r, 32)) + __builtin_bit_cast(float, __builtin_amdgcn_readlane(r, 48)));
}
__device__ __forceinline__ float silu_f(float x) { return x * __builtin_amdgcn_rcpf(1.f + __expf(-x)); }
__device__ __forceinline__ float sigmoid_f(float x) { return __builtin_amdgcn_rcpf(1.f + __expf(-x)); }
__device__ __forceinline__ float softplus_f(float x) { return fmaxf(x, 0.f) + log1pf(__expf(-fabsf(x))); }
#define XB_TMO      128
#define XB_XCNT(j)  (256  + 64 * (j))
#define XB_XSUB(j)  (1280 + 64 * (j))
#define XB_XGEN(j)  (2304 + 64 * (j))
#define XB_TOP      3328
#define XB_TOPGEN   3392
#define XCD_BAR_WORDS 3456
#define XB_SPIN_CAP (1u << 18)

__device__ __forceinline__ unsigned xb_ld(unsigned* p)              { return __hip_atomic_load(p, __ATOMIC_RELAXED, __HIP_MEMORY_SCOPE_AGENT); }
__device__ __forceinline__ unsigned xb_add(unsigned* p, unsigned v) { return __hip_atomic_fetch_add(p, v, __ATOMIC_RELAXED, __HIP_MEMORY_SCOPE_AGENT); }
__device__ __forceinline__ unsigned xb_xcc_id() { return (unsigned)__builtin_amdgcn_s_getreg((3 << 11) | 20) & 0xFu; }
#define XB_SPIN(cond, bar) do { unsigned _sp = 0; while (cond) { __builtin_amdgcn_s_sleep(1); \
    if ((++_sp & 255u) == 0u) { if (xb_ld(&(bar)[XB_TMO])) break; if (_sp > XB_SPIN_CAP) { atomicAdd(&(bar)[XB_TMO], 1u); break; } } } } while (0)

struct XcdBarrier {
    unsigned* bar; unsigned x;
    volatile LAS unsigned* st;
};

__device__ __forceinline__ XcdBarrier xcd_barrier_post(unsigned* bar, volatile LAS unsigned* st) {
    XcdBarrier b; b.bar = bar; b.x = xb_xcc_id(); b.st = st;
    if (threadIdx.x == 0) (void)xb_add(&bar[XB_XCNT(b.x)], 1u);
    return b;
}
__device__ __forceinline__ void xcd_barrier_complete(unsigned* bar, unsigned x, unsigned& nloc, unsigned& nx) {
    const unsigned G = gridDim.x * gridDim.y * gridDim.z;
    unsigned sum, cnt, mine, sp = 0u;
    for (;;) {
        sum = 0u; cnt = 0u; mine = 0u;
#pragma unroll
        for (unsigned j = 0; j < 16; ++j) { const unsigned c = xb_ld(&bar[XB_XCNT(j)]); sum += c; cnt += (c > 0u) ? 1u : 0u; mine = (j == x) ? c : mine; }
        if (sum == G) break;
        __builtin_amdgcn_s_sleep(1);
        if ((++sp & 255u) == 0u) { if (xb_ld(&bar[XB_TMO])) break; if (sp > XB_SPIN_CAP) { atomicAdd(&bar[XB_TMO], 1u); break; } }
    }
    nloc = mine > 0u ? mine : 1u; nx = cnt > 0u ? cnt : 1u;
}

__device__ __forceinline__ void xcd_barrier(const XcdBarrier& b) {
    asm volatile("s_waitcnt vmcnt(0)" ::: "memory");
    __syncthreads();
    if (threadIdx.x == 0) {
        unsigned* bar = b.bar;
        __builtin_amdgcn_s_waitcnt(0);
        unsigned nloc = b.st[0], nx = b.st[1];
        if (nloc == 0u) { xcd_barrier_complete(bar, b.x, nloc, nx); b.st[0] = nloc; b.st[1] = nx; }
        const unsigned old = xb_add(&bar[XB_XSUB(b.x)], 1u);
        const unsigned gen = old / nloc;
        if (old + 1u == (gen + 1u) * nloc) {
            __builtin_amdgcn_fence(__ATOMIC_RELEASE, "agent");
            asm volatile("s_waitcnt vmcnt(0)" ::: "memory");
            const unsigned og = xb_add(&bar[XB_TOP], 1u);
            const unsigned tg = og / nx;
            if (og + 1u == (tg + 1u) * nx) xb_add(&bar[XB_TOPGEN], 1u);
            else XB_SPIN(xb_ld(&bar[XB_TOPGEN]) == tg, bar);
            __builtin_amdgcn_fence(__ATOMIC_ACQUIRE, "agent");
            xb_add(&bar[XB_XGEN(b.x)], 1u);
            asm volatile("s_waitcnt vmcnt(0)" ::: "memory");
        } else {
            XB_SPIN(xb_ld(&bar[XB_XGEN(b.x)]) == gen, bar);
            __builtin_amdgcn_fence(__ATOMIC_ACQUIRE, "agent");
            asm volatile("s_waitcnt vmcnt(0)" ::: "memory");
        }
    }
    __syncthreads();
}

__global__ void placement_pad(int* p) {
    asm volatile("s_nop 0\n\ts_nop 0\n\ts_nop 0\n\ts_nop 0\n\ts_nop 0\n\ts_nop 0\n\ts_nop 0\n\ts_nop 0\n\ts_nop 0\n\ts_nop 0\n\ts_nop 0\n\ts_nop 0\n\ts_nop 0\n\ts_nop 0\n\ts_nop 0\n\ts_nop 0\n\ts_nop 0\n\ts_nop 0\n\ts_nop 0\n\ts_nop 0\n\ts_nop 0\n\ts_nop 0\n\ts_nop 0\n\ts_nop 0\n\ts_nop 0\n\ts_nop 0\n\ts_nop 0\n\ts_nop 0\n\ts_nop 0\n\ts_nop 0\n\ts_nop 0\n\ts_nop 0\n\ts_nop 0\n\ts_nop 0\n\ts_nop 0\n\ts_nop 0\n\ts_nop 0\n\ts_nop 0\n\ts_nop 0\n\ts_nop 0\n\ts_nop 0\n\ts_nop 0\n\ts_nop 0\n\ts_nop 0\n\ts_nop 0\n\ts_nop 0\n\ts_nop 0\n\ts_nop 0\n\ts_nop 0\n\ts_nop 0\n\ts_nop 0\n\ts_nop 0\n\ts_nop 0\n\ts_nop 0\n\ts_nop 0\n\ts_nop 0\n\ts_nop 0\n\ts_nop 0\n\ts_nop 0\n\ts_nop 0\n\ts_nop 0\n\ts_nop 0\n\ts_nop 0\n\ts_nop 0\n\ts_nop 0\n\ts_nop 0\n\ts_nop 0\n\ts_nop 0\n\ts_nop 0\n\ts_nop 0\n\ts_nop 0\n\ts_nop 0\n\ts_nop 0\n\ts_nop 0\n\ts_nop 0\n\ts_nop 0\n\ts_nop 0\n\ts_nop 0\n\ts_nop 0\n\ts_nop 0\n\ts_nop 0\n\ts_nop 0\n\ts_nop 0\n\ts_nop 0\n\ts_nop 0\n\ts_nop 0\n\ts_nop 0\n\ts_nop 0\n\ts_nop 0\n\ts_nop 0\n\ts_nop 0\n\ts_nop 0\n\ts_nop 0\n\ts_nop 0\n\ts_nop 0\n\ts_nop 0\n\ts_nop 0\n\ts_nop 0\n\ts_nop 0\n\ts_nop 0\n\ts_nop 0\n\ts_nop 0\n\ts_nop 0\n\ts_nop 0\n\ts_nop 0\n\ts_nop 0\n\ts_nop 0\n\ts_nop 0\n\ts_nop 0\n\ts_nop 0\n\ts_nop 0\n\ts_nop 0\n\ts_nop 0\n\ts_nop 0\n\ts_nop 0\n\ts_nop 0\n\ts_nop 0\n\ts_nop 0\n\ts_nop 0\n\ts_nop 0\n\ts_nop 0\n\ts_nop 0\n\ts_nop 0\n\ts_nop 0\n\ts_nop 0\n\ts_nop 0\n\ts_nop 0\n\ts_nop 0\n\ts_nop 0" ::: "memory");
    if (p) *p = 0;
}
constexpr int NWAVES = 8, NTHR = 512;
constexpr int LDS_BYTES = 147456;
constexpr int RING_BYTES = 131072;
constexpr int MISC_OFF = LDS_BYTES - 256;
constexpr int GRID = 256;
constexpr int RPB = M / GRID;
static_assert(RPB == 64, "thin phases assume 64 rows per workgroup");

struct Args { const void* in[26]; float* out; unsigned char* ws; int ph_lo, ph_hi, li, pad; };
struct Frame {
    LAS unsigned char* lds;
    int tid, lane, wave, blk;
    const float *x, *c; const int* pos; const float *ada_w, *ada_b, *mix_pre_g, *mix_post_g, *ffn_pre_g, *ffn_post_g;
    const float *e_w_in, *e_pool_w, *e_pool_scale, *e_w_out, *e_wg, *e_wu, *e_wd;
    const float *o_w_in, *o_conv_w, *o_a_log, *o_dt_bias, *o_norm_g, *o_w_out, *o_router, *o_mg, *o_mu, *o_md;
    float* out; unsigned char* ws;
};
__device__ __forceinline__ void frame_init(Frame& F, const Args& a, LAS unsigned char* lds) {
    F.lds = lds; F.tid = threadIdx.x; F.lane = F.tid & 63; F.wave = __builtin_amdgcn_readfirstlane(F.tid >> 6); F.blk = blockIdx.x;
    F.x = (const float*)a.in[0]; F.c = (const float*)a.in[1]; F.pos = (const int*)a.in[2]; F.ada_w = (const float*)a.in[3]; F.ada_b = (const float*)a.in[4];
    F.mix_pre_g = (const float*)a.in[5]; F.mix_post_g = (const float*)a.in[6]; F.ffn_pre_g = (const float*)a.in[7]; F.ffn_post_g = (const float*)a.in[8];
    F.e_w_in = (const float*)a.in[9]; F.e_pool_w = (const float*)a.in[10]; F.e_pool_scale = (const float*)a.in[11]; F.e_w_out = (const float*)a.in[12];
    F.e_wg = (const float*)a.in[13]; F.e_wu = (const float*)a.in[14]; F.e_wd = (const float*)a.in[15];
    F.o_w_in = (const float*)a.in[16]; F.o_conv_w = (const float*)a.in[17]; F.o_a_log = (const float*)a.in[18]; F.o_dt_bias = (const float*)a.in[19];
    F.o_norm_g = (const float*)a.in[20]; F.o_w_out = (const float*)a.in[21]; F.o_router = (const float*)a.in[22];
    F.o_mg = (const float*)a.in[23]; F.o_mu = (const float*)a.in[24]; F.o_md = (const float*)a.in[25];
    F.out = a.out; F.ws = a.ws;
}
#define WSP(T_, off) ((T_*)(F.ws + (off)))

__device__ __forceinline__ void ld_row_f32(const float* p, int lane, f32x4 (&v)[4]) {
    const f32x4* q = (const f32x4*)p + lane;
#pragma unroll
    for (int j = 0; j < 4; ++j) v[j] = q[64 * j];
}
__device__ __forceinline__ void ld_row_bf16(const bf16* p, int lane, f32x4 (&v)[4]) {
    const v2u* q = (const v2u*)p + lane;
#pragma unroll
    for (int j = 0; j < 4; ++j) { const v2u w = q[64 * j]; v[j] = (f32x4){bflo(w.x), bfhi(w.x), bflo(w.y), bfhi(w.y)}; }
}
__device__ __forceinline__ void st_row_f32(float* p, int lane, const f32x4 (&v)[4]) {
    f32x4* q = (f32x4*)p + lane;
#pragma unroll
    for (int j = 0; j < 4; ++j) q[64 * j] = v[j];
}
__device__ __forceinline__ void st_row_bf16(bf16* p, int lane, const f32x4 (&v)[4]) {
    v2u* q = (v2u*)p + lane;
#pragma unroll
    for (int j = 0; j < 4; ++j) { v2u w; w.x = pk2(v[j].x, v[j].y); w.y = pk2(v[j].z, v[j].w); q[64 * j] = w; }
}
__device__ __forceinline__ float row_rinv(const f32x4 (&v)[4]) {
    float s = 0.f;
#pragma unroll
    for (int j = 0; j < 4; ++j) s += (v[j].x * v[j].x + v[j].y * v[j].y) + (v[j].z * v[j].z + v[j].w * v[j].w);
    return 1.0f / sqrtf(wave_sum(s) * (1.f / D) + EPS);
}
__device__ __forceinline__ void row_mod(const f32x4 (&v)[4], float r, const float* g, const float* sc, const float* sh, int lane, f32x4 (&h)[4]) {
    f32x4 gv[4], scv[4], shv[4]; ld_row_f32(g, lane, gv); ld_row_f32(sc, lane, scv); ld_row_f32(sh, lane, shv);
#pragma unroll
    for (int j = 0; j < 4; ++j) h[j] = v[j] * r * gv[j] * (scv[j] + 1.0f) + shv[j];
}
__device__ __forceinline__ void row_resid(const f32x4 (&xi)[4], const f32x4 (&y)[4], float ry, const float* pg, const float* gt, int lane, f32x4 (&xo)[4]) {
    f32x4 gv[4], gtv[4]; ld_row_f32(pg, lane, gv); ld_row_f32(gt, lane, gtv);
#pragma unroll
    for (int j = 0; j < 4; ++j) xo[j] = xi[j] + gtv[j] * (y[j] * ry * gv[j]);
}
__device__ __forceinline__ void row_mod_r(const f32x4 (&v)[4], float r, const f32x4 (&gv)[4], const f32x4 (&scv)[4], const f32x4 (&shv)[4], f32x4 (&h)[4]) {
#pragma unroll
    for (int j = 0; j < 4; ++j) h[j] = v[j] * r * gv[j] * (scv[j] + 1.0f) + shv[j];
}
__device__ __forceinline__ void row_resid_r(const f32x4 (&xi)[4], const f32x4 (&y)[4], float ry, const f32x4 (&gv)[4], const f32x4 (&gtv)[4], f32x4 (&xo)[4]) {
#pragma unroll
    for (int j = 0; j < 4; ++j) xo[j] = xi[j] + gtv[j] * (y[j] * ry * gv[j]);
}
__device__ __forceinline__ void ld_row_bf16_raw(const bf16* p, int lane, v2u (&w)[4]) {
    const v2u* q = (const v2u*)p + lane;
#pragma unroll
    for (int j = 0; j < 4; ++j) w[j] = q[64 * j];
}
__device__ __forceinline__ void cvt_row_bf16(const v2u (&w)[4], f32x4 (&v)[4]) {
#pragma unroll
    for (int j = 0; j < 4; ++j) v[j] = (f32x4){bflo(w[j].x), bfhi(w[j].x), bflo(w[j].y), bfhi(w[j].y)};
}
#define MODP(l, b, k) (WSP(const float, WS_MOD) + ((l) * 2 + (b)) * 6144 + (k) * 1024)

__device__ __forceinline__ void ph_mod_rope(Frame& F) {
    LAS float* red = (LAS float*)F.lds;
    LAS float* cact = red + 1024;
    for (int i = F.tid; i < 2 * D; i += NTHR) cact[i] = silu_f(F.c[i]);
    __syncthreads();
    for (int u = F.blk; u < 192; u += GRID) {
        const int l = u / 96, n = (u % 96) * 64 + F.lane;
        const float* W = F.ada_w + (size_t)l * D * 6144 + n;
        float a0 = 0.f, a1 = 0.f;
#pragma unroll 1
        for (int k0 = F.wave * 128; k0 < F.wave * 128 + 128; k0 += 16) {
            float wv[16];
#pragma unroll
            for (int q = 0; q < 16; ++q) wv[q] = __builtin_nontemporal_load(W + (size_t)(k0 + q) * 6144);
#pragma unroll
            for (int q = 0; q < 16; ++q) { a0 += cact[k0 + q] * wv[q]; a1 += cact[D + k0 + q] * wv[q]; }
        }
        red[(F.wave * 2 + 0) * 64 + F.lane] = a0; red[(F.wave * 2 + 1) * 64 + F.lane] = a1;
        __syncthreads();
        if (F.wave == 0) {
            float s0 = 0.f, s1 = 0.f;
#pragma unroll
            for (int w = 0; w < 8; ++w) { s0 += red[(w * 2 + 0) * 64 + F.lane]; s1 += red[(w * 2 + 1) * 64 + F.lane]; }
            const float bb = F.ada_b[l * 6144 + n];
            float* MOD = WSP(float, WS_MOD);
            MOD[(l * 2 + 0) * 6144 + n] = s0 + bb; MOD[(l * 2 + 1) * 6144 + n] = s1 + bb;
        }
        __syncthreads();
    }
    const float invf[8] = {1.0f, 0.1939227432012558f, 0.03760603070259094f, 0.007292664609849453f, 0.0014142135623842478f, 0.00027424818836152554f, 5.318296098266728e-05f, 1.0313386155758053e-05f};
    float* ROPE = WSP(float, WS_ROPE);
    for (int idx = F.blk * NTHR + F.tid; idx < M * 8; idx += GRID * NTHR) {
        const int m = idx >> 3, i = idx & 7;
        float fi = invf[0];
#pragma unroll
        for (int q = 1; q < 8; ++q) fi = (i == q) ? invf[q] : fi;
        const float ang = (float)F.pos[m] * fi;
        const double a = (double)ang, n2 = rint(a * 0.15915494309189535), r = a - n2 * 6.283185307179586;
        const float rf = (float)r;
        ROPE[m * 16 + i] = cosf(rf); ROPE[m * 16 + 8 + i] = sinf(rf);
    }
}

__device__ __forceinline__ void ph_norm_a(Frame& F) {
    bf16* H = WSP(bf16, WS_H);
    const int m0 = F.blk * RPB + F.wave * 8, b = m0 / T;
    f32x4 gv[4], scv[4], shv[4]; ld_row_f32(F.mix_pre_g, F.lane, gv); ld_row_f32(MODP(0, b, 1), F.lane, scv); ld_row_f32(MODP(0, b, 0), F.lane, shv);
    f32x4 vn[4]; ld_row_f32(F.x + (size_t)m0 * D, F.lane, vn);
#pragma unroll 1
    for (int i = 0; i < 8; ++i) {
        const int m = m0 + i;
        f32x4 v[4], h[4];
#pragma unroll
        for (int j = 0; j < 4; ++j) v[j] = vn[j];
        if (i < 7) ld_row_f32(F.x + (size_t)(m + 1) * D, F.lane, vn);
        const float r = row_rinv(v);
        row_mod_r(v, r, gv, scv, shv, h);
        st_row_bf16(H + (size_t)m * D, F.lane, h);
    }
}
template <int KIND> __device__ __forceinline__ void ph_norm_mid(Frame& F) {
    const bf16* Y = WSP(const bf16, WS_Y);
    bf16* H = WSP(bf16, WS_H);
    LAS float* WT = (LAS float*)F.lds;
    LAS int* selE = (LAS int*)(F.lds + 65536);
    LAS int* selR = (LAS int*)(F.lds + 65536 + 512);
    LAS int* cntE = (LAS int*)(F.lds + 65536 + 1024);
    if (KIND == 1) { for (int i = F.tid; i < 16 * D; i += NTHR) { const int k = i >> 4, j = i & 15; WT[j * D + k] = F.o_w_in[(size_t)k * L1N + 4096 + j]; } __syncthreads(); }
    if (KIND == 2) { for (int i = F.tid; i < 8 * D; i += NTHR) { const int k = i >> 3, j = i & 7; WT[j * D + k] = F.o_router[k * 8 + j]; } __syncthreads(); }
    const int mrow0 = F.blk * RPB + F.wave * 8, b = mrow0 / T;
    const bf16* xsb = (const bf16*)F.out; bf16* xdb = (KIND == 2) ? WSP(bf16, WS_MIX) : (bf16*)F.out;
    f32x4 pgv[4], gtv[4], g2v[4], scv[4], shv[4];
    if (KIND == 0) { ld_row_f32(F.mix_post_g, F.lane, pgv); ld_row_f32(MODP(0, b, 2), F.lane, gtv); ld_row_f32(F.ffn_pre_g, F.lane, g2v); ld_row_f32(MODP(0, b, 4), F.lane, scv); ld_row_f32(MODP(0, b, 3), F.lane, shv); }
    if (KIND == 1) { ld_row_f32(F.ffn_post_g, F.lane, pgv); ld_row_f32(MODP(0, b, 5), F.lane, gtv); ld_row_f32(F.mix_pre_g + D, F.lane, g2v); ld_row_f32(MODP(1, b, 1), F.lane, scv); ld_row_f32(MODP(1, b, 0), F.lane, shv); }
    if (KIND == 2) { ld_row_f32(F.mix_post_g + D, F.lane, pgv); ld_row_f32(MODP(1, b, 2), F.lane, gtv); ld_row_f32(F.ffn_pre_g + D, F.lane, g2v); ld_row_f32(MODP(1, b, 4), F.lane, scv); ld_row_f32(MODP(1, b, 3), F.lane, shv); }
    f32x4 xnx[4]; v2u xnb[4], ynx[4];
    if (KIND == 0) ld_row_f32(F.x + (size_t)mrow0 * D, F.lane, xnx); else ld_row_bf16_raw(xsb + (size_t)mrow0 * D, F.lane, xnb);
    ld_row_bf16_raw(Y + (size_t)mrow0 * D, F.lane, ynx);
    _Pragma("unroll 1") for (int i = 0; i < 8; ++i) {
        const int lt = F.wave * 8 + i, m = F.blk * RPB + lt;
        f32x4 xi[4], y[4], xo[4], h[4];
        if (KIND == 0) {
#pragma unroll
            for (int j = 0; j < 4; ++j) xi[j] = xnx[j];
        } else cvt_row_bf16(xnb, xi);
        cvt_row_bf16(ynx, y);
        if (i < 7) { if (KIND == 0) ld_row_f32(F.x + (size_t)(m + 1) * D, F.lane, xnx); else ld_row_bf16_raw(xsb + (size_t)(m + 1) * D, F.lane, xnb);
            ld_row_bf16_raw(Y + (size_t)(m + 1) * D, F.lane, ynx); }
        const float ry = row_rinv(y);
        row_resid_r(xi, y, ry, pgv, gtv, xo);
        st_row_bf16(xdb + (size_t)m * D, F.lane, xo);
        const float r = row_rinv(xo);
        row_mod_r(xo, r, g2v, scv, shv, h);
        if (KIND == 2) { unsigned* q = WSP(unsigned, WS_H2) + (size_t)m * (D / 4) + F.lane;
#pragma unroll
            for (int j = 0; j < 4; ++j) q[64 * j] = pk4f8(h[j].x, h[j].y, h[j].z, h[j].w); }
        else st_row_bf16(H + (size_t)m * D, F.lane, h);
        if (KIND == 1) {
            float* BL = WSP(float, WS_BL);
            float mine = 0.f;
#pragma unroll 1
            for (int j = 0; j < 16; ++j) {
                float a = 0.f;
#pragma unroll
                for (int jj = 0; jj < 4; ++jj) { const f32x4 w = *(const LAS f32x4*)(WT + j * D + 4 * F.lane + 256 * jj); a += (h[jj].x * w.x + h[jj].y * w.y) + (h[jj].z * w.z + h[jj].w * w.w); }
                a = wave_sum(a); mine = (F.lane == j) ? a : mine;
            }
            if (F.lane < 16) BL[(size_t)m * 16 + F.lane] = mine;
        }
        if (KIND == 2) {
            float lg[8];
#pragma unroll
            for (int j = 0; j < 8; ++j) {
                float a = 0.f;
#pragma unroll
                for (int jj = 0; jj < 4; ++jj) { const f32x4 w = *(const LAS f32x4*)(WT + j * D + 4 * F.lane + 256 * jj); a += (h[jj].x * w.x + h[jj].y * w.y) + (h[jj].z * w.z + h[jj].w * w.w); }
                lg[j] = wave_sum(a);
            }
            int e0 = 0; float v0 = lg[0];
#pragma unroll
            for (int j = 1; j < 8; ++j) if (lg[j] > v0) { v0 = lg[j]; e0 = j; }
            int e1 = -1; float v1 = -3.0e38f;
#pragma unroll
            for (int j = 0; j < 8; ++j) if (j != e0 && lg[j] > v1) { v1 = lg[j]; e1 = j; }
            const float w0 = 1.f / (1.f + __expf(v1 - v0)), w1 = 1.f - w0;
            if (F.lane == 0) {
                unsigned* R = WSP(unsigned, WS_ROUTE) + (size_t)m * 8;
                R[0] = (unsigned)e0; R[1] = (unsigned)e1; R[2] = __builtin_bit_cast(unsigned, w0); R[3] = __builtin_bit_cast(unsigned, w1);
                selE[lt * 2 + 0] = e0; selE[lt * 2 + 1] = e1;
            }
        }
    }
    if (KIND == 2) {
        __syncthreads();
        if (F.tid < 8) { int c = 0; for (int q = 0; q < 2 * RPB; ++q) { if (selE[q] == F.tid) { selR[q] = c; ++c; } } cntE[F.tid] = c; }
        __syncthreads();
        if (F.tid < 2 * RPB) { const int lt = F.tid >> 1, k = F.tid & 1; WSP(unsigned, WS_ROUTE)[(size_t)(F.blk * RPB + lt) * 8 + 4 + k] = (unsigned)selR[F.tid]; }
        if (F.tid < 8) WSP(int, WS_CTL)[CW_CNT + F.blk * 8 + F.tid] = cntE[F.tid];
    }
}
__device__ __forceinline__ void ph_gated_norm(Frame& F) {
    const float* O = WSP(const float, WS_O); const bf16* GT = WSP(const bf16, WS_GATE); bf16* MIX = WSP(bf16, WS_MIX);
    const f32x4 ng = *((const f32x4*)F.o_norm_g + (F.lane & 31));
    const int m0 = F.blk * RPB + F.wave * 8;
    f32x4 on[4]; v2u gn[4]; ld_row_f32(O + (size_t)m0 * D, F.lane, on); ld_row_bf16_raw(GT + (size_t)m0 * D, F.lane, gn);
    _Pragma("unroll 1") for (int i = 0; i < 8; ++i) {
        const int m = m0 + i;
        f32x4 o[4], g[4], r[4];
#pragma unroll
        for (int j = 0; j < 4; ++j) o[j] = on[j];
        cvt_row_bf16(gn, g);
        if (i < 7) { ld_row_f32(O + (size_t)(m + 1) * D, F.lane, on); ld_row_bf16_raw(GT + (size_t)(m + 1) * D, F.lane, gn); }
#pragma unroll
        for (int j = 0; j < 4; ++j) {
            float s = (o[j].x * o[j].x + o[j].y * o[j].y) + (o[j].z * o[j].z + o[j].w * o[j].w);
#pragma unroll
            for (int q = 1; q < 32; q <<= 1) s += __shfl_xor(s, q);
            const float rr = 1.0f / sqrtf(s * (1.f / DHD) + EPS);
            r[j].x = o[j].x * rr * ng.x * silu_f(g[j].x); r[j].y = o[j].y * rr * ng.y * silu_f(g[j].y);
            r[j].z = o[j].z * rr * ng.z * silu_f(g[j].z); r[j].w = o[j].w * rr * ng.w * silu_f(g[j].w);
        }
        st_row_bf16(MIX + (size_t)m * D, F.lane, r);
    }
}
__device__ __forceinline__ void ph_moe_gather(Frame& F) {
    LAS int* cnt = (LAS int*)F.lds;
    LAS int* tot = cnt + GRID * 8;
    LAS int* myo = tot + 8; LAS int* tp = myo + 8;
    const int* C = WSP(const int, WS_CTL) + CW_CNT;
    for (int i = F.tid; i < GRID * 8; i += NTHR) cnt[i] = C[i];
    __syncthreads();
    if (F.tid < 8) { int s = 0, mo = 0; for (int b = 0; b < GRID; ++b) { if (b == F.blk) mo = s; s += cnt[b * 8 + F.tid]; } tot[F.tid] = s; myo[F.tid] = mo; }
    __syncthreads();
    if (F.tid == 0) { int p = 0; for (int e = 0; e < 8; ++e) { tp[e] = p; p += (tot[e] + 255) >> 8; } tp[8] = p; }
    __syncthreads();
    if (F.blk == 0 && F.tid < 9) WSP(int, WS_CTL)[CW_TP + F.tid] = tp[F.tid];
    const unsigned char* H2 = F.ws + WS_H2; unsigned char* AS = F.ws + WS_ASORT;
    const int m0 = F.blk * RPB + F.wave * 8;
    v4u rw0[8], rw1[8], dat[8];
#pragma unroll
    for (int i = 0; i < 8; ++i) { const v4u* R = (const v4u*)(WSP(const unsigned, WS_ROUTE) + (size_t)(m0 + i) * 8); rw0[i] = R[0]; rw1[i] = R[1]; dat[i] = *((const v4u*)(H2 + (size_t)(m0 + i) * D) + F.lane); }
#pragma unroll
    for (int i = 0; i < 8; ++i) {
        const int m = m0 + i;
        const int e0 = (int)rw0[i].x, e1 = (int)rw0[i].y, r0 = (int)rw1[i].x, r1 = (int)rw1[i].y;
        const int d0 = tp[e0] * 256 + myo[e0] + r0, d1 = tp[e1] * 256 + myo[e1] + r1;
        if (F.lane == 0) { unsigned* R = WSP(unsigned, WS_ROUTE) + (size_t)m * 8; R[6] = (unsigned)d0; R[7] = (unsigned)d1; }
        *((v4u*)(AS + (size_t)d0 * D) + F.lane) = dat[i]; *((v4u*)(AS + (size_t)d1 * D) + F.lane) = dat[i];
    }
}
__device__ __forceinline__ void ph_final(Frame& F) {
    const bf16* YS = WSP(const bf16, WS_YS);
    const int m0 = F.blk * RPB + F.wave * 8, b = m0 / T;
    f32x4 pgv[4], gtv[4]; ld_row_f32(F.ffn_post_g + D, F.lane, pgv); ld_row_f32(MODP(1, b, 5), F.lane, gtv);
    const unsigned* R = WSP(const unsigned, WS_ROUTE) + (size_t)m0 * 8;
    const bf16* X3 = WSP(const bf16, WS_MIX);
    v2u xn[4], y0n[4], y1n[4]; float w0n, w1n;
    { w0n = __builtin_bit_cast(float, R[2]); w1n = __builtin_bit_cast(float, R[3]); const int d0 = (int)R[6], d1 = (int)R[7];
      ld_row_bf16_raw(X3 + (size_t)m0 * D, F.lane, xn); ld_row_bf16_raw(YS + (size_t)d0 * D, F.lane, y0n); ld_row_bf16_raw(YS + (size_t)d1 * D, F.lane, y1n); }
    _Pragma("unroll 1") for (int i = 0; i < 8; ++i) {
        const int m = m0 + i;
        f32x4 xi[4], y0[4], y1[4], y[4], xo[4]; const float w0 = w0n, w1 = w1n;
        cvt_row_bf16(xn, xi);
        cvt_row_bf16(y0n, y0); cvt_row_bf16(y1n, y1);
        if (i < 7) { const unsigned* Rn = R + (size_t)(i + 1) * 8; w0n = __builtin_bit_cast(float, Rn[2]); w1n = __builtin_bit_cast(float, Rn[3]); const int d0 = (int)Rn[6], d1 = (int)Rn[7];
            ld_row_bf16_raw(X3 + (size_t)(m + 1) * D, F.lane, xn); ld_row_bf16_raw(YS + (size_t)d0 * D, F.lane, y0n); ld_row_bf16_raw(YS + (size_t)d1 * D, F.lane, y1n); }
#pragma unroll
        for (int j = 0; j < 4; ++j) y[j] = y0[j] * w0 + y1[j] * w1;
        const float ry = row_rinv(y);
        row_resid_r(xi, y, ry, pgv, gtv, xo);
        st_row_f32(F.out + (size_t)m * D, F.lane, xo);
    }
}
namespace pg8 {
#define PG8_LAS __attribute__((address_space(3)))
typedef unsigned short bf16_t;
typedef unsigned u32x4 __attribute__((ext_vector_type(4)));
constexpr int BM = 256, BK = 64, HALF = 128, HTB = HALF * BK * 2  , STAGE_BYTES = 8 * HTB, NXCD = 8, WGM = 8;

__host__ __device__ __forceinline__ int lds_byte(int r, int c) { const int st = (r >> 4) * 2 + (c >> 5), rr = r & 15, cc = c & 31, ob = rr * 64 + cc * 2; return st * 1024 + (ob ^ (((ob >> 9) & 1) << 5)); }
__host__ __device__ __forceinline__ void stage_rc(int b, int& R, int& C) { const int st = b / 1024, sb = b % 1024, swz = sb ^ (((sb >> 9) & 1) << 5); R = (st >> 1) * 16 + swz / 64; C = (st & 1) * 32 + (swz % 64) / 2; }
__host__ __device__ __forceinline__ int perm32(int rho) { const int n = rho >> 4, i = rho & 15; return 8 * (i >> 2) + 4 * n + (i & 3); }

struct Unit { int pm, pn; };
struct Gemm { const void* A; const void* Bt; int M, N, K; };

struct StaticOrder {
    int nM, nN, nwg, G, c;
    __host__ __device__ void init(int M, int N, int G_, int c_) { nM = M / BM; nN = N / BM; nwg = nM * nN; G = G_; c = c_; }
    __host__ __device__ bool next(int i, Unit& u) const {
        const long L = (long)i * G + c; if (L >= nwg) return false;
        int wgid = (int)L; { const int q = nwg / NXCD, r = nwg % NXCD, xcd = wgid % NXCD, off = wgid / NXCD; wgid = (xcd < r ? xcd * (q + 1) : r * (q + 1) + (xcd - r) * q) + off; }
        const int nig = WGM * nN, gid = wgid / nig, fm = gid * WGM, gsz = (nM - fm) < WGM ? (nM - fm) : WGM;
        u.pm = fm + ((wgid % nig) % gsz); u.pn = (wgid % nig) / gsz; return true;
    }
    __device__ __forceinline__ void a_ready(const Unit&) const {}
    __device__ __forceinline__ void done(const Unit&) const {}
};

__device__ __forceinline__ unsigned cvt_pk_bf16(float lo, float hi) { unsigned r; asm volatile("v_cvt_pk_bf16_f32 %0, %1, %2" : "=v"(r) : "v"(lo), "v"(hi)); return r; }
typedef int i32x8 __attribute__((ext_vector_type(8)));
__device__ __forceinline__ i32x8 cat16(bf16x8 a, bf16x8 b) { const u32x4 x = __builtin_bit_cast(u32x4, a), y = __builtin_bit_cast(u32x4, b); return (i32x8){(int)x[0], (int)x[1], (int)x[2], (int)x[3], (int)y[0], (int)y[1], (int)y[2], (int)y[3]}; }
template <class Epi, class Sched, bool ALIGN_EPI = false, bool SP2 = false, bool F8 = false>
__device__ __forceinline__ void gemm_phase(PG8_LAS unsigned char* lds, const Gemm g, const Sched& S, const Epi& E) {
    const int tid = threadIdx.x, wid = __builtin_amdgcn_readfirstlane(tid >> 6), lane = tid & 63, wr = wid >> 2, wc = wid & 3, fr = lane & 15, fq = lane >> 4;
    const int K = g.K, RS = F8 ? K : 2 * K  , nt = RS / 128;
    unsigned voffA[2], voffB[2];
#pragma unroll
    for (int i = 0; i < 2; ++i) { int R, C; stage_rc(tid * 16 + i * 8192, R, C); const int Rb = Epi::PERM ? ((R & ~31) + perm32(R & 31)) : R;
        voffA[i] = (unsigned)(R * RS + C * 2); voffB[i] = (unsigned)(Rb * RS + C * 2); }
    const size_t kstep = (size_t)(BK * 2);
    const size_t hstep = (size_t)HALF * RS;
    const size_t tstep = 2 * hstep;
    const unsigned ldsw = (unsigned)wid * 1024u;
    const int aoff = lds_byte(wr * 64 + fr, fq * 8), boff = lds_byte(wc * 32 + fr, fq * 8);
#define PG8_SA(b, h) (((b) * 2 + (h)) * HTB)
#define PG8_SB(b, h) ((4 + (b) * 2 + (h)) * HTB)
#define PG8_STAGE(bufoff, gbase, voff) do { _Pragma("unroll") for (int _i = 0; _i < 2; ++_i) \
        __builtin_amdgcn_global_load_lds((const unsigned*)((const char*)(gbase) + (voff)[_i]), (PG8_LAS unsigned*)(lds + (bufoff) + ldsw + _i * 8192), 16, 0, 0); } while (0)
#define PG8_LD16(p) (*(const PG8_LAS bf16x8*)(p))
#define PG8_LDA(dst, b, h) do { _Pragma("unroll") for (int m = 0; m < 4; ++m) { if constexpr (F8) dst##8[m] = cat16(PG8_LD16(lds + PG8_SA(b, h) + aoff + m * 2048), PG8_LD16(lds + PG8_SA(b, h) + aoff + m * 2048 + 1024)); \
        else { _Pragma("unroll") for (int k = 0; k < 2; ++k) dst[m][k] = PG8_LD16(lds + PG8_SA(b, h) + aoff + m * 2048 + k * 1024); } } } while (0)
#define PG8_LDB(dst, b, h) do { _Pragma("unroll") for (int n = 0; n < 2; ++n) { if constexpr (F8) dst##8[n] = cat16(PG8_LD16(lds + PG8_SB(b, h) + boff + n * 2048), PG8_LD16(lds + PG8_SB(b, h) + boff + n * 2048 + 1024)); \
        else { _Pragma("unroll") for (int k = 0; k < 2; ++k) dst[n][k] = PG8_LD16(lds + PG8_SB(b, h) + boff + n * 2048 + k * 1024); } } } while (0)
#define PG8_MMA(ai, bj, At, Bt) do { __builtin_amdgcn_s_setprio(1); _Pragma("unroll") for (int m = 0; m < 4; ++m) _Pragma("unroll") for (int n = 0; n < 2; ++n) { \
        if constexpr (F8) asm volatile("v_mfma_f32_16x16x128_f8f6f4 %0, %1, %2, %0" : "+v"(acc[ai][bj][m][n]) : "v"(Bt##8[n]), "v"(At##8[m]));     \
        else { _Pragma("unroll") for (int k = 0; k < 2; ++k) acc[ai][bj][m][n] = __builtin_amdgcn_mfma_f32_16x16x32_bf16(Bt[n][k], At[m][k], acc[ai][bj][m][n], 0, 0, 0); } } __builtin_amdgcn_s_setprio(0); } while (0)
#define PG8_WAIT_V(n) asm volatile("s_waitcnt vmcnt(" #n ")" ::: "memory")
#define PG8_WAIT_L(n) asm volatile("s_waitcnt lgkmcnt(" #n ")" ::: "memory")
#define PG8_BAR __builtin_amdgcn_s_barrier()
#define PG8_SCHED __builtin_amdgcn_sched_barrier(0)
    Unit cur, nxt; int ui = 0;
    if (!S.next(0, cur)) return;
    f32x4 acc[2][2][4][2];
#pragma unroll
    for (int a = 0; a < 2; ++a)
#pragma unroll
        for (int b = 0; b < 2; ++b)
#pragma unroll
            for (int m = 0; m < 4; ++m)
#pragma unroll
                for (int n = 0; n < 2; ++n) acc[a][b][m][n] = (f32x4){0.f, 0.f, 0.f, 0.f};
    bf16x8 At[4][2], B0[2][2], B1[2][2]; i32x8 At8[4], B08[2], B18[2];
    const char* cA = (const char*)g.A + (size_t)cur.pm * tstep; const char* cB = (const char*)g.Bt + (size_t)cur.pn * tstep;
    S.a_ready(cur);
    if constexpr (SP2) {
        PG8_STAGE(PG8_SB(0, 0), cB, voffB); PG8_STAGE(PG8_SB(0, 1), cB + hstep, voffB); PG8_STAGE(PG8_SA(0, 0), cA, voffA); PG8_STAGE(PG8_SA(0, 1), cA + hstep, voffA);
        if (wr == 1) PG8_BAR;
        PG8_WAIT_V(2); PG8_BAR;
        PG8_STAGE(PG8_SB(1, 0), cB + kstep, voffB); PG8_STAGE(PG8_SA(1, 0), cA + kstep, voffA); PG8_STAGE(PG8_SB(1, 1), cB + hstep + kstep, voffB);
        PG8_WAIT_V(6); PG8_BAR;
    } else {
        PG8_STAGE(PG8_SB(0, 0), cB, voffB); PG8_STAGE(PG8_SA(0, 0), cA, voffA); PG8_STAGE(PG8_SB(0, 1), cB + hstep, voffB); PG8_STAGE(PG8_SA(0, 1), cA + hstep, voffA);
        if (wr == 1) PG8_BAR;
        PG8_WAIT_V(4); PG8_BAR;
        PG8_STAGE(PG8_SB(1, 0), cB + kstep, voffB); PG8_STAGE(PG8_SA(1, 0), cA + kstep, voffA); PG8_STAGE(PG8_SB(1, 1), cB + hstep + kstep, voffB);
        PG8_WAIT_V(6); PG8_BAR;
    }
    for (;;) {
        const bool has_next = S.next(ui + 1, nxt);
        const char* nA = has_next ? (const char*)g.A + (size_t)nxt.pm * tstep : cA; const char* nB = has_next ? (const char*)g.Bt + (size_t)nxt.pn * tstep : cB;
        for (int t = 0; t < nt; t += 2) {
            const bool last = (t == nt - 2);
            const char* a1 = cA + (size_t)(t + 1) * kstep;
            const char* a2 = last ? nA : cA + (size_t)(t + 2) * kstep; const char* b2 = last ? nB : cB + (size_t)(t + 2) * kstep;
            const char* a3 = a2 + kstep; const char* b3 = b2 + kstep;
            if (last && has_next) S.a_ready(nxt);
            if constexpr (SP2) {
            PG8_LDB(B0, 0, 0); PG8_LDB(B1, 0, 1); PG8_SCHED; PG8_LDA(At, 0, 0); PG8_STAGE(PG8_SA(1, 1), a1 + hstep, voffA);
            PG8_WAIT_V(8); PG8_WAIT_L(0); PG8_BAR; PG8_MMA(0, 0, At, B0); PG8_MMA(0, 1, At, B1); PG8_BAR; PG8_SCHED;
            PG8_LDA(At, 0, 1); PG8_STAGE(PG8_SB(0, 0), b2, voffB); PG8_STAGE(PG8_SB(0, 1), b2 + hstep, voffB); PG8_STAGE(PG8_SA(0, 0), a2, voffA);
            PG8_WAIT_V(8); PG8_WAIT_L(0); PG8_BAR; PG8_MMA(1, 0, At, B0); PG8_MMA(1, 1, At, B1); PG8_BAR; PG8_SCHED;
            PG8_LDB(B0, 1, 0); PG8_LDB(B1, 1, 1); PG8_SCHED; PG8_LDA(At, 1, 0); PG8_STAGE(PG8_SA(0, 1), a2 + hstep, voffA);
            PG8_WAIT_V(8); PG8_WAIT_L(0); PG8_BAR; PG8_MMA(0, 0, At, B0); PG8_MMA(0, 1, At, B1); PG8_BAR; PG8_SCHED;
            PG8_LDA(At, 1, 1); PG8_STAGE(PG8_SB(1, 0), b3, voffB); PG8_STAGE(PG8_SB(1, 1), b3 + hstep, voffB); PG8_STAGE(PG8_SA(1, 0), a3, voffA);
            PG8_WAIT_V(8); PG8_WAIT_L(0); PG8_BAR; PG8_MMA(1, 0, At, B0); PG8_MMA(1, 1, At, B1); PG8_BAR; PG8_SCHED;
            } else {
            PG8_LDB(B0, 0, 0); PG8_SCHED; PG8_LDA(At, 0, 0); PG8_STAGE(PG8_SA(1, 1), a1 + hstep, voffA);
            PG8_WAIT_L(8); PG8_BAR; PG8_WAIT_L(0); PG8_MMA(0, 0, At, B0); PG8_BAR; PG8_SCHED;
            PG8_LDB(B1, 0, 1); PG8_STAGE(PG8_SB(0, 0), b2, voffB);
            PG8_BAR; PG8_WAIT_L(0); PG8_MMA(0, 1, At, B1); PG8_BAR;
            PG8_LDA(At, 0, 1); PG8_STAGE(PG8_SA(0, 0), a2, voffA);
            PG8_BAR; PG8_WAIT_L(0); PG8_MMA(1, 0, At, B0); PG8_BAR; PG8_SCHED;
            PG8_STAGE(PG8_SB(0, 1), b2 + hstep, voffB);
            PG8_WAIT_V(6); PG8_BAR; PG8_MMA(1, 1, At, B1); PG8_BAR;
            PG8_LDB(B0, 1, 0); PG8_SCHED; PG8_LDA(At, 1, 0); PG8_STAGE(PG8_SA(0, 1), a2 + hstep, voffA);
            PG8_WAIT_L(8); PG8_BAR; PG8_WAIT_L(0); PG8_MMA(0, 0, At, B0); PG8_BAR; PG8_SCHED;
            PG8_LDB(B1, 1, 1); PG8_STAGE(PG8_SB(1, 0), b3, voffB);
            PG8_BAR; PG8_WAIT_L(0); PG8_MMA(0, 1, At, B1); PG8_BAR;
            PG8_LDA(At, 1, 1); PG8_STAGE(PG8_SA(1, 0), a3, voffA);
            PG8_BAR; PG8_WAIT_L(0); PG8_MMA(1, 0, At, B0); PG8_BAR; PG8_SCHED;
            PG8_STAGE(PG8_SB(1, 1), b3 + hstep, voffB);
            PG8_WAIT_V(6); PG8_BAR; PG8_MMA(1, 1, At, B1); PG8_BAR;
            }
        }
        if constexpr (F8) asm volatile("s_nop 15\n\ts_nop 15" ::: "memory");
        if constexpr (ALIGN_EPI) { if (wr == 0) PG8_BAR; }
        if constexpr (!Epi::AFTER_DRAIN) { int fr2 = fr, fq2 = fq; asm volatile("" : "+v"(fr2), "+v"(fq2));
            E(acc, cur, wr, wc, fr2, fq2);
            S.done(cur); }
        if (!has_next) break;
#pragma unroll
        for (int a = 0; a < 2; ++a)
#pragma unroll
            for (int b = 0; b < 2; ++b)
#pragma unroll
                for (int m = 0; m < 4; ++m)
#pragma unroll
                    for (int n = 0; n < 2; ++n) acc[a][b][m][n] = (f32x4){0.f, 0.f, 0.f, 0.f};
        cur = nxt; cA = nA; cB = nB; ++ui;
        if constexpr (ALIGN_EPI) { if (wr == 1) PG8_BAR; }
    }
    PG8_WAIT_V(0);
    if constexpr (!ALIGN_EPI) { if (wr == 0) PG8_BAR; }
    PG8_BAR;
    if constexpr (Epi::AFTER_DRAIN) { E.fused(acc, cur, wr, wc, fr, fq, lds, wid, lane); S.done(cur); }
#undef PG8_SA
#undef PG8_SB
#undef PG8_STAGE
#undef PG8_LD16
#undef PG8_LDA
#undef PG8_LDB
#undef PG8_MMA
#undef PG8_WAIT_V
#undef PG8_WAIT_L
#undef PG8_BAR
#undef PG8_SCHED
}
}
#define LDS_WAIT() asm volatile("s_waitcnt lgkmcnt(0)" ::: "memory")
constexpr int TR_STR = 68, TR_TILE = 64 * TR_STR * 4;
#define TR_PUT(V) do { _Pragma("unroll") for (int q_ = 0; q_ < 16; ++q_) *(LAS f32x4*)(scr + lane * TR_STR + 4 * q_) = (f32x4){V[4 * q_], V[4 * q_ + 1], V[4 * q_ + 2], V[4 * q_ + 3]}; } while (0)
template <bool F8> __device__ __forceinline__ void tr_emit(const LAS float* scr, unsigned char* dst, int K, float wscale, int lane) {
    const int c = lane & 7;
#pragma unroll
    for (int j = 0; j < 8; ++j) { const int n = (lane >> 3) + 8 * j; const LAS f32x4* sp = (const LAS f32x4*)(scr + n * TR_STR + 8 * c); const f32x4 a = sp[0] * wscale, b = sp[1] * wscale;
        if (F8) { v2u o; o.x = pk4f8(a[0], a[1], a[2], a[3]); o.y = pk4f8(b[0], b[1], b[2], b[3]); *(v2u*)(dst + (size_t)n * K + 8 * c) = o; }
        else { v4u o; o.x = pk2(a[0], a[1]); o.y = pk2(a[2], a[3]); o.z = pk2(b[0], b[1]); o.w = pk2(b[2], b[3]); *(v4u*)(dst + ((size_t)n * K + 8 * c) * 2) = o; } }
}
template <bool F8> __device__ __forceinline__ void tr_item(const float* W, int ldw, int K, unsigned char* WT, int k0, int n0, int drow0, LAS float* scr, int lane, float wscale) {
    const float* src = W + (size_t)k0 * ldw + n0 + lane;
    float v[64];
#pragma unroll
    for (int i = 0; i < 64; ++i) v[i] = __builtin_nontemporal_load(src + (size_t)i * ldw);
    TR_PUT(v);
    LDS_WAIT(); asm volatile("" ::: "memory");
    tr_emit<F8>(scr, WT + ((size_t)drow0 * K + k0) * (F8 ? 1 : 2), K, wscale, lane);
    LDS_WAIT(); asm volatile("" ::: "memory");
}
template <int KINDM, bool F8> __device__ __forceinline__ void tr_matrix(Frame& F, const float* W, int ldw, int K, int N, void* WT, float wscale, int& base, int gw, int ngw) {
    LAS float* scr = (LAS float*)(F.lds + F.wave * TR_TILE);
    const int nblk = N / 64, nitems = (K / 64) * nblk;
    int first = gw - (base % ngw); if (first < 0) first += ngw;
    for (int it = first; it < nitems; it += ngw) {
        const int kb = it / nblk, nb = it % nblk, n0 = nb * 64;
        const int drow0 = KINDM == 0 ? n0 : ((n0 >> 7) * 256 + (n0 & 127) + (KINDM == 2 ? 128 : 0));
        tr_item<F8>(W, ldw, K, (unsigned char*)WT, kb * 64, n0, drow0, scr, F.lane, wscale);
    }
    base += nitems;
}
__device__ __forceinline__ void ph_weights_dense(Frame& F) {
    const int gw = F.blk * NWAVES + F.wave, ngw = GRID * NWAVES; int base = 0;
    tr_matrix<0, false>(F, F.e_w_in, L0N, D, L0N, WSP(bf16, WS_WB_L0IN), 1.f, base, gw, ngw);
    tr_matrix<0, false>(F, F.e_w_out, D, D, D, WSP(bf16, WS_WB_L0OUT), 1.f, base, gw, ngw);
    tr_matrix<1, false>(F, F.e_wg, FF, D, FF, WSP(bf16, WS_WB_L0GU), 1.f, base, gw, ngw);
    tr_matrix<2, false>(F, F.e_wu, FF, D, FF, WSP(bf16, WS_WB_L0GU), 1.f, base, gw, ngw);
    tr_matrix<0, false>(F, F.e_wd, D, FF, D, WSP(bf16, WS_WB_L0DN), 1.f, base, gw, ngw);
    tr_matrix<0, false>(F, F.o_w_in, L1N, D, 4096, WSP(bf16, WS_WB_L1IN), 1.f, base, gw, ngw);
    tr_matrix<0, false>(F, F.o_w_out, D, D, D, WSP(bf16, WS_WB_L1OUT), 1.f, base, gw, ngw);
#pragma unroll 1
    for (int g = 0; g < 4; ++g) tr_matrix<0, false>(F, F.e_pool_w + g * 16384, 128, 128, 128, WSP(bf16, WS_POOLWT) + g * 16384, 1.f, base, gw, ngw);
}
constexpr int TRB_STR = 269;
struct TrB { const float* src; unsigned char* dst; int ldw, K, which; float sc; };
__device__ __forceinline__ TrB moe_item_b(Frame& F, int it) {
    const int e = it / 336, r = it % 336, which = r / 112, q = r % 112;
    TrB t; t.which = which;
    if (which < 2) { const int kb = q / 14, nb = q % 14; const float* W = (which == 0 ? F.o_mg : F.o_mu) + (size_t)e * D * FF;
        t.src = W + (size_t)(kb * 128) * FF + nb * 256; t.ldw = FF; t.K = D; t.sc = 32.0f;
        t.dst = F.ws + WS_WB_GU + ((size_t)e * 7168 + (nb * 2) * 256 + which * 128) * D + kb * 128; }
    else { const int kb = q / 4, nb = q % 4; const float* W = F.o_md + (size_t)e * FF * D;
        t.src = W + (size_t)(kb * 128) * D + nb * 256; t.ldw = D; t.K = FF; t.sc = 64.0f;
        t.dst = F.ws + WS_WB_DN + ((size_t)e * D + nb * 256) * FF + kb * 128; }
    return t;
}
#define TRB_LOAD(V, T_) do { _Pragma("unroll") for (int i_ = 0; i_ < 16; ++i_) V[i_] = __builtin_nontemporal_load((const f32x4*)((T_).src + (size_t)(r0 + 8 * i_) * (T_).ldw) + col4); } while (0)
#define TRB_STEP(V, CUR, NXT_IT) do { \
        _Pragma("unroll") for (int i_ = 0; i_ < 16; ++i_) { const int k_ = r0 + 8 * i_; LAS float* d_ = scr + k_ * TRB_STR + 4 * col4 + 4 * (k_ >> 5); d_[0] = V[i_][0]; d_[1] = V[i_][1]; d_[2] = V[i_][2]; d_[3] = V[i_][3]; } \
        const TrB cur_ = CUR; CUR = moe_item_b(F, (NXT_IT) < NIT ? (NXT_IT) : cb); TRB_LOAD(V, CUR); \
        asm volatile("s_waitcnt lgkmcnt(0)" ::: "memory"); __builtin_amdgcn_s_barrier(); asm volatile("" ::: "memory"); \
        _Pragma("unroll") for (int j_ = 0; j_ < 8; ++j_) { const int n_ = nl + 32 * j_; const LAS float* sp_ = scr + (8 * c) * TRB_STR + n_ + 4 * (c >> 2); const float ws_ = cur_.sc; \
            v2u o_; o_.x = pk4f8(sp_[0 * TRB_STR] * ws_, sp_[1 * TRB_STR] * ws_, sp_[2 * TRB_STR] * ws_, sp_[3 * TRB_STR] * ws_); o_.y = pk4f8(sp_[4 * TRB_STR] * ws_, sp_[5 * TRB_STR] * ws_, sp_[6 * TRB_STR] * ws_, sp_[7 * TRB_STR] * ws_); \
            const size_t orow_ = cur_.which < 2 ? (size_t)((n_ >> 7) * 256 + (n_ & 127)) : (size_t)n_; \
            __builtin_nontemporal_store(o_, (v2u*)(cur_.dst + orow_ * cur_.K + 8 * c)); } \
        asm volatile("s_waitcnt lgkmcnt(0)" ::: "memory"); __builtin_amdgcn_s_barrier(); asm volatile("" ::: "memory"); } while (0)
__device__ __forceinline__ void ph_weights_moe_blk(Frame& F, int cb, int ncb) {
    constexpr int NIT = NE * 336;
    LAS float* scr = (LAS float*)F.lds;
    const int tid = F.tid, col4 = tid & 63, r0 = tid >> 6, c = tid & 15, nl = tid >> 4;
    int it = cb; if (it >= NIT) return;
    TrB tA = moe_item_b(F, it), tB = moe_item_b(F, it + ncb < NIT ? it + ncb : cb);
    f32x4 vA[16], vB[16];
    TRB_LOAD(vA, tA); TRB_LOAD(vB, tB);
#pragma unroll 1
    for (;;) {
        TRB_STEP(vA, tA, it + 2 * ncb);
        if (it + ncb >= NIT) break;
        TRB_STEP(vB, tB, it + 3 * ncb);
        it += 2 * ncb; if (it >= NIT) break;
    }
}
#undef TRB_LOAD
#undef TRB_STEP

namespace pg8 {
struct EpiPlain {
    static constexpr bool PERM = true, AFTER_DRAIN = false;
    bf16_t* O; int ldc; bf16_t* O2; int ldc2; int split; int nper; float oscale;
    __device__ __forceinline__ void operator()(const f32x4 (&acc)[2][2][4][2], const Unit& u, int wr, int wc, int fr, int fq) const {
        int pn = u.pn % nper; bf16_t* base = O; int ld = ldc;
        if (pn >= split) { pn -= split; base = O2; ld = ldc2; }
        const int row0 = u.pm * BM + wr * 64 + fr, col0 = pn * BM + wc * 32 + 8 * fq;
#pragma unroll
        for (int ai = 0; ai < 2; ++ai)
#pragma unroll
            for (int m = 0; m < 4; ++m) { bf16_t* rowp = base + (size_t)(row0 + ai * HALF + m * 16) * ld + col0;
#pragma unroll
                for (int bj = 0; bj < 2; ++bj) { const f32x4 v0 = acc[ai][bj][m][0] * oscale, v1 = acc[ai][bj][m][1] * oscale;
                    u32x4 w; w.x = cvt_pk_bf16(v0[0], v0[1]); w.y = cvt_pk_bf16(v0[2], v0[3]); w.z = cvt_pk_bf16(v1[0], v1[1]); w.w = cvt_pk_bf16(v1[2], v1[3]);
                    *(u32x4*)(rowp + bj * HALF) = w; } }
    }
};
struct EpiSwiglu {
    static constexpr bool PERM = true, AFTER_DRAIN = false;
    bf16_t* O; int ldc; int nper;
    __device__ __forceinline__ void operator()(const f32x4 (&acc)[2][2][4][2], const Unit& u, int wr, int wc, int fr, int fq) const {
        const int pn = u.pn % nper;
        const int row0 = u.pm * BM + wr * 64 + fr, col0 = pn * HALF + wc * 32 + 8 * fq;
#pragma unroll
        for (int ai = 0; ai < 2; ++ai)
#pragma unroll
            for (int m = 0; m < 4; ++m) { bf16_t* rowp = O + (size_t)(row0 + ai * HALF + m * 16) * ldc + col0;
                float o[8];
#pragma unroll
                for (int n = 0; n < 2; ++n)
#pragma unroll
                    for (int i = 0; i < 4; ++i) { const float g = acc[ai][0][m][n][i], uu = acc[ai][1][m][n][i]; o[4 * n + i] = g * __builtin_amdgcn_rcpf(1.0f + __expf(-g)) * uu; }
                u32x4 w; w.x = cvt_pk_bf16(o[0], o[1]); w.y = cvt_pk_bf16(o[2], o[3]); w.z = cvt_pk_bf16(o[4], o[5]); w.w = cvt_pk_bf16(o[6], o[7]);
                *(u32x4*)rowp = w; }
    }
};
struct EpiSwigluF8 {
    static constexpr bool PERM = true, AFTER_DRAIN = false;
    unsigned char* O; int ldc; int nper; float iscale, hscale;
    __device__ __forceinline__ void operator()(const f32x4 (&acc)[2][2][4][2], const Unit& u, int wr, int wc, int fr, int fq) const {
        const int pn = u.pn % nper;
        const int row0 = u.pm * BM + wr * 64 + fr, col0 = pn * HALF + wc * 32 + 8 * fq;
#pragma unroll
        for (int ai = 0; ai < 2; ++ai)
#pragma unroll
            for (int m = 0; m < 4; ++m) { unsigned char* rowp = O + (size_t)(row0 + ai * HALF + m * 16) * ldc + col0;
                float o[8];
#pragma unroll
                for (int n = 0; n < 2; ++n)
#pragma unroll
                    for (int i = 0; i < 4; ++i) { const float g = acc[ai][0][m][n][i] * iscale, uu = acc[ai][1][m][n][i] * (iscale * hscale); o[4 * n + i] = g * __builtin_amdgcn_rcpf(1.0f + __expf(-g)) * uu; }
                v2u w; w.x = pk4f8(o[0], o[1], o[2], o[3]); w.y = pk4f8(o[4], o[5], o[6], o[7]);
                *(v2u*)rowp = w; asm volatile("" ::: "memory"); }
    }
};
struct EpiL0In {
    static constexpr bool PERM = true, AFTER_DRAIN = false;
    bf16_t* O; const float* rope;
    __device__ __forceinline__ void operator()(const f32x4 (&acc)[2][2][4][2], const Unit& u, int wr, int wc, int fr, int fq) const {
        const int row0 = u.pm * BM + wr * 64 + fr, col0 = u.pn * BM + wc * 32 + 8 * fq;
        const bool qk = u.pn < 4, rot = qk && ((wc & 1) == 0) && (fq < 2);
        const float sc = u.pn < 2 ? 0.125f : 1.0f;
#pragma unroll
        for (int ai = 0; ai < 2; ++ai)
#pragma unroll
            for (int m = 0; m < 4; ++m) { const int r = row0 + ai * HALF + m * 16; bf16_t* rowp = O + (size_t)r * L0N + col0;
                f32x4 cs0 = {1.f, 1.f, 1.f, 1.f}, cs1 = cs0, sn0 = {0.f, 0.f, 0.f, 0.f}, sn1 = sn0;
                if (rot) { const f32x4* t = (const f32x4*)(rope + (size_t)r * 16); cs0 = t[0]; cs1 = t[1]; sn0 = t[2]; sn1 = t[3]; if (fq == 0) { sn0 = -sn0; sn1 = -sn1; } }
#pragma unroll
                for (int bj = 0; bj < 2; ++bj) { f32x4 v0 = acc[ai][bj][m][0], v1 = acc[ai][bj][m][1];
                    if (qk) {
                        f32x4 p0, p1;
#pragma unroll
                        for (int i = 0; i < 4; ++i) { p0[i] = __shfl_xor(v0[i], 16); p1[i] = __shfl_xor(v1[i], 16); }
                        v0 = v0 * cs0 + p0 * sn0; v1 = v1 * cs1 + p1 * sn1;
                    }
                    v0 = v0 * sc; v1 = v1 * sc;
                    u32x4 w; w.x = cvt_pk_bf16(v0[0], v0[1]); w.y = cvt_pk_bf16(v0[2], v0[3]); w.z = cvt_pk_bf16(v1[0], v1[1]); w.w = cvt_pk_bf16(v1[2], v1[3]);
                    *(u32x4*)(rowp + bj * HALF) = w; } }
    }
};
struct MoeOrder {
    int nM, nN, nwg, G, c; int t1, t2, t3, t4, t5, t6, t7;
#define RFL(x) __builtin_amdgcn_readfirstlane(x)
    __device__ void init(const int* tp, int nN_, int G_, int c_) { nM = RFL(tp[8]); nN = nN_; nwg = nM * nN; G = G_; c = c_; t1 = RFL(tp[1]); t2 = RFL(tp[2]); t3 = RFL(tp[3]); t4 = RFL(tp[4]); t5 = RFL(tp[5]); t6 = RFL(tp[6]); t7 = RFL(tp[7]); }
#undef RFL
    __device__ bool next(int i, Unit& u) const {
        const long L = (long)i * G + c; if (L >= nwg) return false;
        int wgid = (int)L; { const int q = nwg / NXCD, r = nwg % NXCD, xcd = wgid % NXCD, off = wgid / NXCD; wgid = (xcd < r ? xcd * (q + 1) : r * (q + 1) + (xcd - r) * q) + off; }
        const int nig = WGM * nN, gid = wgid / nig, fm = gid * WGM, gsz = (nM - fm) < WGM ? (nM - fm) : WGM;
        const int pm = fm + ((wgid % nig) % gsz), pn = (wgid % nig) / gsz;
        const int e = (pm >= t1) + (pm >= t2) + (pm >= t3) + (pm >= t4) + (pm >= t5) + (pm >= t6) + (pm >= t7);
        u.pm = pm; u.pn = e * nN + pn; return true;
    }
    __device__ __forceinline__ void a_ready(const Unit&) const {}
    __device__ __forceinline__ void done(const Unit&) const {}
};
}
#define MFMA16(a, b, c) __builtin_amdgcn_mfma_f32_16x16x32_bf16((a), (b), (c), 0, 0, 0)
__device__ __forceinline__ s16x4 tr16(LAS unsigned char* p) { return __builtin_amdgcn_ds_read_tr16_b64_v4i16((LAS s16x4*)p); }
__device__ __forceinline__ bf16x8 cat4(s16x4 a, s16x4 b) { return (bf16x8){a[0], a[1], a[2], a[3], b[0], b[1], b[2], b[3]}; }
#ifndef PROBE_POOL2
#define PROBE_POOL2 0
#endif
#ifndef PROBE_ATT2
#define PROBE_ATT2 0
#endif
constexpr int KV_STRIDE = 144;
constexpr int ATT_UNITS = NB * AH * 3 * 64;
struct AttUnit { int b, h, br, d, r, nb; };
__device__ __forceinline__ AttUnit att_decode(int u) {
    AttUnit a; a.br = u >> 10; const int rem = u & 1023; a.b = rem >> 9; a.h = (rem >> 6) & 7; const int rb = rem & 63;
    a.d = a.br == 0 ? 1 : (a.br == 1 ? 4 : 16); const int nblk = 64 / a.d; a.r = rb / nblk; a.nb = rb % nblk; return a;
}
__device__ __forceinline__ void att_issue(const bf16* P0, const AttUnit& a, int tid, int wave, int lane, v4u (&kr)[4], v4u (&vr)[4], v4u (&qr)[2]) {
    const int c = tid & 7, row0 = tid >> 3;
#pragma unroll
    for (int i = 0; i < 4; ++i) {
        int n = 128 * (a.nb - 1) + row0 + 64 * i; if (n < 0) n += 128;
        const bf16* p = P0 + (size_t)(a.b * T + n * a.d + a.r) * L0N + 64 * a.h + 8 * c;
        kr[i] = *(const v4u*)(p + 512); vr[i] = *(const v4u*)(p + 1024);
    }
    const int tq = a.b * T + (128 * a.nb + 16 * wave + (lane & 15)) * a.d + a.r;
    const bf16* q = P0 + (size_t)tq * L0N + 64 * a.h + 8 * (lane >> 4);
    qr[0] = *(const v4u*)q; qr[1] = *(const v4u*)(q + 32);
}
__device__ __forceinline__ void pool_unit(const bf16* P0, const bf16* PW, const float* pscale, bf16* MIX, int m, int t, int gg, int li, int g) {
    const int Wn = 2 << gg, cnt = (t + 1 < Wn) ? t + 1 : Wn; const float rc = 1.0f / (float)cnt;
    f32x4 acc[8];
#pragma unroll
    for (int nt = 0; nt < 8; ++nt) acc[nt] = (f32x4){0.f, 0.f, 0.f, 0.f};
#pragma unroll 1
    for (int ks = 0; ks < 4; ++ks) {
        const bf16* up = P0 + (size_t)m * L0N + 1536 + 128 * gg + 32 * ks + 8 * g;
        const v4u self = *(const v4u*)up;
        float sm[8];
#pragma unroll
        for (int q = 0; q < 8; ++q) sm[q] = 0.f;
        { v4u x[16];
#pragma unroll
          for (int j = 0; j < 16; ++j) { const int jj = j < cnt ? j : 0; x[j] = *(const v4u*)(up - (size_t)jj * L0N); }
#pragma unroll
          for (int j = 0; j < 16; ++j) { const float mk = j < cnt ? 1.0f : 0.0f;
              sm[0] += mk * bflo(x[j].x); sm[1] += mk * bfhi(x[j].x); sm[2] += mk * bflo(x[j].y); sm[3] += mk * bfhi(x[j].y); sm[4] += mk * bflo(x[j].z); sm[5] += mk * bfhi(x[j].z); sm[6] += mk * bflo(x[j].w); sm[7] += mk * bfhi(x[j].w); } }
        v4u bw; bw.x = pk2(sm[0] * rc - bflo(self.x), sm[1] * rc - bfhi(self.x)); bw.y = pk2(sm[2] * rc - bflo(self.y), sm[3] * rc - bfhi(self.y));
        bw.z = pk2(sm[4] * rc - bflo(self.z), sm[5] * rc - bfhi(self.z)); bw.w = pk2(sm[6] * rc - bflo(self.w), sm[7] * rc - bfhi(self.w));
        const bf16x8 bfrag = __builtin_bit_cast(bf16x8, bw);
        asm volatile("" ::: "memory");
        bf16x8 af[8];
#pragma unroll
        for (int nt = 0; nt < 8; ++nt) af[nt] = *(const bf16x8*)(PW + (size_t)gg * 16384 + (16 * nt + li) * 128 + 32 * ks + 8 * g);
#pragma unroll
        for (int nt = 0; nt < 8; ++nt) acc[nt] = MFMA16(af[nt], bfrag, acc[nt]);
    }
    bf16* op = MIX + (size_t)m * D + 512 + 128 * gg + 4 * g;
#pragma unroll
    for (int nt = 0; nt < 8; ++nt) {
        const f32x4 sc = *(const f32x4*)(pscale + 128 * gg + 16 * nt + 4 * g);
        v2u wv; wv.x = pk2(acc[nt][0] * sc[0], acc[nt][1] * sc[1]); wv.y = pk2(acc[nt][2] * sc[2], acc[nt][3] * sc[3]); *(v2u*)(op + 16 * nt) = wv;
    }
}
__device__ __forceinline__ void att_compute(const AttUnit& a, LAS unsigned char* Ks, LAS unsigned char* Vs, bf16x8 q0, bf16x8 q1, int w, int li, int g, bf16* AP, float* LSE) {
        f32x4 s[9];
#pragma unroll
        for (int kt = 0; kt < 9; ++kt) {
            const LAS unsigned char* kp = Ks + (16 * (w + kt) + li) * KV_STRIDE + 16 * g;
            const bf16x8 a0 = *(const LAS bf16x8*)kp, a1 = *(const LAS bf16x8*)(kp + 64);
            f32x4 z = {0.f, 0.f, 0.f, 0.f};
            z = MFMA16(a0, q0, z); s[kt] = MFMA16(a1, q1, z);
        }
        float mx = -3.0e38f;
        const int d0 = 4 * g - li;
#pragma unroll
        for (int kt = 0; kt < 9; ++kt) {
            const bool tile_ok = (a.nb > 0) || (w + kt >= 8);
#pragma unroll
            for (int i = 0; i < 4; ++i) {
                bool ok = tile_ok;
                if (kt == 0) ok = ok && (d0 + i >= 0);
                if (kt == 8) ok = ok && (d0 + i <= 0);
                s[kt][i] = ok ? s[kt][i] : -3.0e38f; mx = fmaxf(mx, s[kt][i]);
            }
        }
        mx = fmaxf(mx, __shfl_xor(mx, 16)); mx = fmaxf(mx, __shfl_xor(mx, 32));
        float l = 0.f; unsigned pk[10][2];
#pragma unroll
        for (int kt = 0; kt < 9; ++kt) {
            float p[4];
#pragma unroll
            for (int i = 0; i < 4; ++i) { p[i] = __expf(s[kt][i] - mx); l += p[i]; }
            pk[kt][0] = pk2(p[0], p[1]); pk[kt][1] = pk2(p[2], p[3]);
        }
        pk[9][0] = 0u; pk[9][1] = 0u;
        l += __shfl_xor(l, 16); l += __shfl_xor(l, 32);
        f32x4 o[4];
#pragma unroll
        for (int mt = 0; mt < 4; ++mt) o[mt] = (f32x4){0.f, 0.f, 0.f, 0.f};
#pragma unroll
        for (int sI = 0; sI < 5; ++sI) {
            const v4u bw = {pk[2 * sI][0], pk[2 * sI][1], pk[2 * sI + 1][0], pk[2 * sI + 1][1]};
            const bf16x8 bfrag = __builtin_bit_cast(bf16x8, bw);
            const int t0 = w + 2 * sI, t1 = (w + 2 * sI + 1) > 15 ? 15 : (w + 2 * sI + 1);
            LAS unsigned char* v0 = Vs + (16 * t0 + 4 * g + (li >> 2)) * KV_STRIDE + 8 * (li & 3);
            LAS unsigned char* v1 = Vs + (16 * t1 + 4 * g + (li >> 2)) * KV_STRIDE + 8 * (li & 3);
#pragma unroll
            for (int mt = 0; mt < 4; ++mt) { const bf16x8 af = cat4(tr16(v0 + 32 * mt), tr16(v1 + 32 * mt)); o[mt] = MFMA16(af, bfrag, o[mt]); }
        }
        const float rl = __builtin_amdgcn_rcpf(l);
        const int tq = a.b * T + (128 * a.nb + 16 * w + li) * a.d + a.r;
        bf16* op = AP + ((size_t)a.br * M + tq) * AW + 64 * a.h + 4 * g;
#pragma unroll
        for (int mt = 0; mt < 4; ++mt) { v2u wv; wv.x = pk2(o[mt][0] * rl, o[mt][1] * rl); wv.y = pk2(o[mt][2] * rl, o[mt][3] * rl); *(v2u*)(op + 16 * mt) = wv; }
        if (g == 0) LSE[((size_t)a.br * M + tq) * 8 + a.h] = mx + __logf(l);
}
__device__ __forceinline__ void ph_attn_pool(Frame& F) {
    const bf16* P0 = WSP(const bf16, WS_PROJ0); bf16* AP = WSP(bf16, WS_ATTP); float* LSE = WSP(float, WS_LSE);
    LAS unsigned char* Ks = F.lds; LAS unsigned char* Vs = F.lds + 256 * KV_STRIDE;
    const int lane = F.lane, w = F.wave, li = lane & 15, g = lane >> 4, tid = F.tid;
    v4u krA[4], vrA[4], qrA[2], krB[4], vrB[4], qrB[2];
    const int c8 = tid & 7, row0 = tid >> 3;
    int u = F.blk;
    { const AttUnit a = att_decode(u < ATT_UNITS ? u : 0); att_issue(P0, a, tid, w, lane, krA, vrA, qrA); }
    { const AttUnit a = att_decode(u + GRID < ATT_UNITS ? u + GRID : 0); att_issue(P0, a, tid, w, lane, krB, vrB, qrB); }
#define ATT_BAR() do { asm volatile("s_waitcnt lgkmcnt(0)" ::: "memory"); __builtin_amdgcn_s_barrier(); asm volatile("" ::: "memory"); } while (0)
#define ATT_STEP(KR, VR, QR, UU) do { \
        const AttUnit a_ = att_decode(UU); \
        _Pragma("unroll") for (int i_ = 0; i_ < 4; ++i_) { *(LAS v4u*)(Ks + (row0 + 64 * i_) * KV_STRIDE + c8 * 16) = KR[i_]; *(LAS v4u*)(Vs + (row0 + 64 * i_) * KV_STRIDE + c8 * 16) = VR[i_]; } \
        const bf16x8 q0_ = __builtin_bit_cast(bf16x8, QR[0]), q1_ = __builtin_bit_cast(bf16x8, QR[1]); \
        ATT_BAR(); \
        { const int un_ = (UU) + 2 * GRID; const AttUnit an_ = att_decode(un_ < ATT_UNITS ? un_ : 0); att_issue(P0, an_, tid, w, lane, KR, VR, QR); } \
        att_compute(a_, Ks, Vs, q0_, q1_, w, li, g, AP, LSE); \
        if (PROBE_ATT2) { asm volatile("" ::: "memory"); att_compute(a_, Ks, Vs, q0_, q1_, w, li, g, AP, LSE); } \
        ATT_BAR(); } while (0)
#pragma unroll 1
    for (; u < ATT_UNITS; u += 2 * GRID) {
        ATT_STEP(krA, vrA, qrA, u);
        if (u + GRID < ATT_UNITS) ATT_STEP(krB, vrB, qrB, u + GRID);
    }
#undef ATT_STEP
#undef ATT_BAR
    asm volatile("s_waitcnt vmcnt(0)" ::: "memory"); __syncthreads();
    {
        const bf16* PW = WSP(const bf16, WS_POOLWT); bf16* MIX = WSP(bf16, WS_MIX);
        constexpr int PSTR = 272;
        LAS unsigned char* Ut = F.lds; LAS unsigned char* Wt = F.lds + 143 * PSTR + 16;
        v4u ur[5], wr[4];
#define POOL_ISSUE(PU) do { const int tile_ = (PU) & 127, gg_ = (PU) >> 7; const int m0_ = tile_ * 128, lo_ = (m0_ / T) * T; \
            _Pragma("unroll") for (int i_ = 0; i_ < 5; ++i_) { int p_ = tid + 512 * i_; p_ = p_ < 143 * 16 ? p_ : 143 * 16 - 1; int mr_ = m0_ - 15 + (p_ >> 4); mr_ = mr_ < lo_ ? lo_ : mr_; \
                ur[i_] = *(const v4u*)(P0 + (size_t)mr_ * L0N + 1536 + 128 * gg_ + (p_ & 15) * 8); } \
            _Pragma("unroll") for (int i_ = 0; i_ < 4; ++i_) { const int p_ = tid + 512 * i_; wr[i_] = *(const v4u*)(PW + (size_t)gg_ * 16384 + (p_ >> 4) * 128 + (p_ & 15) * 8); } } while (0)
        int pu = F.blk;
        POOL_ISSUE(pu);
#pragma unroll 1
        for (; pu < 512; pu += GRID) {
            const int tile = pu & 127, gg = pu >> 7;
#pragma unroll
            for (int i = 0; i < 5; ++i) { const int p = tid + 512 * i; if (p < 143 * 16) *(LAS v4u*)(Ut + (p >> 4) * PSTR + (p & 15) * 16) = ur[i]; }
#pragma unroll
            for (int i = 0; i < 4; ++i) { const int p = tid + 512 * i; *(LAS v4u*)(Wt + (p >> 4) * PSTR + (p & 15) * 16) = wr[i]; }
            __syncthreads();
            if (pu + GRID < 512) POOL_ISSUE(pu + GRID);
            const int m = tile * 128 + 16 * w + li, t = m % T, Wn = 2 << gg, cnt = (t + 1 < Wn) ? t + 1 : Wn; const float rc = 1.0f / (float)cnt;
            const LAS unsigned char* urow = Ut + (16 * w + li + 15) * PSTR + 16 * g;
            f32x4 acc[8];
#pragma unroll
            for (int nt = 0; nt < 8; ++nt) acc[nt] = (f32x4){0.f, 0.f, 0.f, 0.f};
#pragma unroll 1
            for (int ks = 0; ks < 4; ++ks) {
                float sm[8];
#pragma unroll
                for (int q = 0; q < 8; ++q) sm[q] = 0.f;
                const v4u self = *(const LAS v4u*)(urow + 64 * ks);
#pragma unroll
                for (int j = 0; j < 16; ++j) { const v4u x = *(const LAS v4u*)(urow + 64 * ks - j * PSTR); const float mk = j < cnt ? 1.0f : 0.0f;
                    sm[0] += mk * bflo(x.x); sm[1] += mk * bfhi(x.x); sm[2] += mk * bflo(x.y); sm[3] += mk * bfhi(x.y); sm[4] += mk * bflo(x.z); sm[5] += mk * bfhi(x.z); sm[6] += mk * bflo(x.w); sm[7] += mk * bfhi(x.w); }
                v4u bw; bw.x = pk2(sm[0] * rc - bflo(self.x), sm[1] * rc - bfhi(self.x)); bw.y = pk2(sm[2] * rc - bflo(self.y), sm[3] * rc - bfhi(self.y));
                bw.z = pk2(sm[4] * rc - bflo(self.z), sm[5] * rc - bfhi(self.z)); bw.w = pk2(sm[6] * rc - bflo(self.w), sm[7] * rc - bfhi(self.w));
                const bf16x8 bfrag = __builtin_bit_cast(bf16x8, bw);
#pragma unroll
                for (int nt = 0; nt < 8; ++nt) acc[nt] = MFMA16(*(const LAS bf16x8*)(Wt + (16 * nt + li) * PSTR + 64 * ks + 16 * g), bfrag, acc[nt]);
            }
            bf16* op = MIX + (size_t)m * D + 512 + 128 * gg + 4 * g;
#pragma unroll
            for (int nt = 0; nt < 8; ++nt) {
                const f32x4 sc = *(const f32x4*)(F.e_pool_scale + 128 * gg + 16 * nt + 4 * g);
                v2u wv; wv.x = pk2(acc[nt][0] * sc[0], acc[nt][1] * sc[1]); wv.y = pk2(acc[nt][2] * sc[2], acc[nt][3] * sc[3]); *(v2u*)(op + 16 * nt) = wv;
            }
            __syncthreads();
        }
#undef POOL_ISSUE
    }
}
__device__ __forceinline__ void ph_attn_combine(Frame& F) {
    const bf16* AP = WSP(const bf16, WS_ATTP); const float* LSE = WSP(const float, WS_LSE); bf16* MIX = WSP(bf16, WS_MIX);
    const int m0 = F.blk * RPB + F.wave * 8, h = F.lane >> 3;
    v4u an, bn, cn; float l0n, l1n, l2n;
#define CMB_LOAD(M_) do { l0n = LSE[((size_t)0 * M + (M_)) * 8 + h]; l1n = LSE[((size_t)1 * M + (M_)) * 8 + h]; l2n = LSE[((size_t)2 * M + (M_)) * 8 + h]; \
        an = *((const v4u*)(AP + ((size_t)0 * M + (M_)) * AW) + F.lane); bn = *((const v4u*)(AP + ((size_t)1 * M + (M_)) * AW) + F.lane); cn = *((const v4u*)(AP + ((size_t)2 * M + (M_)) * AW) + F.lane); } while (0)
    CMB_LOAD(m0);
#pragma unroll 1
    for (int i = 0; i < 8; ++i) {
        const int m = m0 + i;
        const v4u a = an, b = bn, c = cn; const float l0 = l0n, l1 = l1n, l2 = l2n;
        if (i < 7) CMB_LOAD(m + 1);
        const float mx = fmaxf(l0, fmaxf(l1, l2)), e0 = __expf(l0 - mx), e1 = __expf(l1 - mx), e2 = __expf(l2 - mx), rs = __builtin_amdgcn_rcpf(e0 + e1 + e2);
        const float w0 = e0 * rs, w1 = e1 * rs, w2 = e2 * rs;
        v4u o;
        o.x = pk2(w0 * bflo(a.x) + w1 * bflo(b.x) + w2 * bflo(c.x), w0 * bfhi(a.x) + w1 * bfhi(b.x) + w2 * bfhi(c.x));
        o.y = pk2(w0 * bflo(a.y) + w1 * bflo(b.y) + w2 * bflo(c.y), w0 * bfhi(a.y) + w1 * bfhi(b.y) + w2 * bfhi(c.y));
        o.z = pk2(w0 * bflo(a.z) + w1 * bflo(b.z) + w2 * bflo(c.z), w0 * bfhi(a.z) + w1 * bfhi(b.z) + w2 * bfhi(c.z));
        o.w = pk2(w0 * bflo(a.w) + w1 * bflo(b.w) + w2 * bflo(c.w), w0 * bfhi(a.w) + w1 * bfhi(b.w) + w2 * bfhi(c.w));
        *((v4u*)(MIX + (size_t)m * D) + F.lane) = o;
    }
#undef CMB_LOAD
}
#ifndef PROBE_CP
#define PROBE_CP 0
#endif
constexpr int CP_STR = 272, CP_IMG = 64 * CP_STR;
constexpr int IMG_KB = 0, IMG_K = CP_IMG, IMG_Q = 2 * CP_IMG, IMG_VB = 3 * CP_IMG, IMG_KBG = 4 * CP_IMG, IMG_KG = 5 * CP_IMG, CP_GATES = 6 * CP_IMG;
constexpr int NM_STR = 144, NM_IMG = 64 * NM_STR;
__device__ __forceinline__ bf16x8 ldsb128(const LAS unsigned char* p) { return *(const LAS bf16x8*)p; }
__device__ __forceinline__ bf16x8 tr_pair(LAS unsigned char* p, int step) { return cat4(tr16(p), tr16(p + step)); }
__device__ __forceinline__ v2u pk4(f32x4 v) { v2u r; r.x = pk2(v[0], v[1]); r.y = pk2(v[2], v[3]); return r; }

struct CpIn { v4u x[3][4][2]; v4u wv; float bl, al; };
__device__ __forceinline__ void cp_issue(Frame& F, int un, int tid, CpIn& I) {
    const bf16* QKV = WSP(const bf16, WS_QKV); const float* BL = WSP(const float, WS_BL);
    const int b = un >> 10, h = (un >> 7) & 7, c = un & 127, row = tid >> 3, cg = tid & 7, t = c * CH + row;
#pragma unroll
    for (int mat = 0; mat < 3; ++mat)
#pragma unroll
        for (int j = 0; j < 4; ++j) {
            int tt = t - 3 + j; tt = tt < 0 ? 0 : tt;
            const v4u* p = (const v4u*)(QKV + ((size_t)b * T + tt) * 3072 + mat * 1024 + 128 * h + 16 * cg);
            I.x[mat][j][0] = p[0]; I.x[mat][j][1] = p[1];
        }
    { const int idx = tid < 384 ? tid : 383, j = idx / 96, r = idx % 96, mat = r >> 5, c4 = r & 31;
      I.wv = *(const v4u*)(F.o_conv_w + j * 3072 + mat * 1024 + 128 * h + 4 * c4); }
    const size_t mrow = (size_t)b * T + (size_t)c * CH + (tid & 63);
    I.bl = BL[mrow * 16 + h]; I.al = BL[mrow * 16 + 8 + h];
}
__device__ __forceinline__ void ph_chunk_prep(Frame& F) {
    unsigned char* WFp = F.ws + WS_WF; unsigned char* QGp = F.ws + WS_QGF; unsigned char* KGp = F.ws + WS_KGF; unsigned char* ATp = F.ws + WS_ATF; unsigned char* UFp = F.ws + WS_UF;
    float* CDEC = WSP(float, WS_CDEC);
    LAS unsigned char* L = F.lds; LAS float* gcs = (LAS float*)(L + CP_GATES); LAS float* betas = gcs + 64;
    LAS float* wcv = (LAS float*)(L + CP_GATES + 2048);
    const int w = F.wave;
#pragma unroll 1
    for (int un = F.blk; un < NB * DH * NCH; un += GRID) {
        int tid = F.tid; asm volatile("" : "+v"(tid));
        const int lane = tid & 63, li = lane & 15, g = lane >> 4;
        const int h = (un >> 7) & 7, c = un & 127;
        CpIn I; cp_issue(F, un, tid, I);
        if (w == 0) {
            float gl = -__expf(F.o_a_log[h]) * softplus_f(I.al + F.o_dt_bias[h]);
            DPP_ADD(gl, 0x111); DPP_ADD(gl, 0x112); DPP_ADD(gl, 0x114); DPP_ADD(gl, 0x118);
            { const int gi = __builtin_bit_cast(int, gl);
              const float t0 = __builtin_bit_cast(float, __builtin_amdgcn_readlane(gi, 15)), t1 = __builtin_bit_cast(float, __builtin_amdgcn_readlane(gi, 31)), t2 = __builtin_bit_cast(float, __builtin_amdgcn_readlane(gi, 47));
              const int rr = lane >> 4; gl += (rr >= 1 ? t0 : 0.f) + (rr >= 2 ? t1 : 0.f) + (rr >= 3 ? t2 : 0.f); }
            gcs[lane] = gl; betas[lane] = sigmoid_f(I.bl);
            if (lane == 63) CDEC[un] = __expf(gl);
        }
        if (tid < 384) *(LAS v4u*)(wcv + 4 * tid) = I.wv;
        __syncthreads();
        for (int rp_ = 0; rp_ < (PROBE_CP == 1 ? 2 : 1); ++rp_) {
        {
            const int row = tid >> 3, cg = tid & 7, t = c * CH + row;
            const float gcr = gcs[row], beta = betas[row], eg = __expf(gcr), ekl = __expf(gcs[63] - gcr);
            const int off = row * CP_STR + cg * 32;
#define ST_IMG(IMG, P) do { *(LAS v4u*)(L + (IMG) + off) = (v4u){P[0], P[1], P[2], P[3]}; *(LAS v4u*)(L + (IMG) + off + 16) = (v4u){P[4], P[5], P[6], P[7]}; } while (0)
#pragma unroll
            for (int mat = 0; mat < 3; ++mat) {
                f32x2 ac2[8];
#pragma unroll
                for (int e = 0; e < 8; ++e) ac2[e] = (f32x2){0.f, 0.f};
                f32x4 wq[4][4];
#pragma unroll
                for (int j = 0; j < 4; ++j) { const LAS f32x4* wp = (const LAS f32x4*)(wcv + (j * 3 + mat) * 128 + 16 * cg); wq[j][0] = wp[0]; wq[j][1] = wp[1]; wq[j][2] = wp[2]; wq[j][3] = wp[3]; }
                __builtin_amdgcn_sched_barrier(0);
#pragma unroll
                for (int j = 0; j < 4; ++j) {
                    v4u x0 = I.x[mat][j][0], x1 = I.x[mat][j][1];
                    if (c == 0) { const bool okr = (t - 3 + j) >= 0; const v4u z = {0u, 0u, 0u, 0u}; x0 = okr ? x0 : z; x1 = okr ? x1 : z; }
                    const unsigned xw[8] = {x0.x, x0.y, x0.z, x0.w, x1.x, x1.y, x1.z, x1.w};
#pragma unroll
                    for (int e = 0; e < 8; ++e) { const f32x2 xv = {bflo(xw[e]), bfhi(xw[e])}; const f32x2 wv = {wq[j][e >> 1][2 * (e & 1)], wq[j][e >> 1][2 * (e & 1) + 1]}; ac2[e] += wv * xv; }
                }
                float acc[16];
#pragma unroll
                for (int e = 0; e < 8; ++e) { acc[2 * e] = ac2[e].x; acc[2 * e + 1] = ac2[e].y; }
                float ss = 0.f;
#pragma unroll
                for (int e = 0; e < 16; ++e) { acc[e] = silu_f(acc[e]); ss += acc[e] * acc[e]; }
                ss = row8_sum(ss);
                const float rn = 1.0f / sqrtf(ss + EPS);
                if (mat == 0) {
                    const float rq = rn * 0.08838834764831845f;
                    unsigned pq[8], pqg[8];
#pragma unroll
                    for (int e = 0; e < 8; ++e) { const float q0 = acc[2 * e] * rq, q1 = acc[2 * e + 1] * rq; pq[e] = pk2(q0, q1); pqg[e] = pk2(q0 * eg, q1 * eg); }
                    ST_IMG(IMG_Q, pq);
                    unsigned char* qgb = QGp + (size_t)un * 16384 + (((row >> 4) * 4 + (cg >> 1)) * 64 + (row & 15)) * 16 + (cg & 1) * 8;
#pragma unroll
                    for (int gp = 0; gp < 4; ++gp) *(v2u*)(qgb + gp * 16 * 16) = (v2u){pqg[2 * gp], pqg[2 * gp + 1]};
                } else if (mat == 1) {
                    unsigned pk_[8], pkb[8], pkbg[8], pkg[8];
#pragma unroll
                    for (int e = 0; e < 8; ++e) { const float k0 = acc[2 * e] * rn, k1 = acc[2 * e + 1] * rn; pk_[e] = pk2(k0, k1); pkb[e] = pk2(k0 * beta, k1 * beta);
                        pkbg[e] = pk2(k0 * beta * eg, k1 * beta * eg); pkg[e] = pk2(k0 * ekl, k1 * ekl); }
                    ST_IMG(IMG_K, pk_); ST_IMG(IMG_KB, pkb); ST_IMG(IMG_KBG, pkbg); ST_IMG(IMG_KG, pkg);
                } else {
                    unsigned pvb[8];
#pragma unroll
                    for (int e = 0; e < 8; ++e) pvb[e] = pk2(acc[2 * e] * beta, acc[2 * e + 1] * beta);
                    ST_IMG(IMG_VB, pvb);
                }
                asm volatile("" ::: "memory");
            }
#undef ST_IMG
        }
        }
        __syncthreads();
        f32x4 m1[4];
        if (w < 4) {
            const int it = w;
            bf16x8 fa[4], fb[4][4];
#pragma unroll
            for (int ks = 0; ks < 4; ++ks) fa[ks] = ldsb128(L + IMG_KB + (16 * it + li) * CP_STR + (32 * ks + 8 * g) * 2);
#pragma unroll
            for (int nt = 0; nt < 4; ++nt)
#pragma unroll
                for (int ks = 0; ks < 4; ++ks) fb[nt][ks] = ldsb128(L + IMG_K + (16 * nt + li) * CP_STR + (32 * ks + 8 * g) * 2);
            __builtin_amdgcn_sched_barrier(0);
#pragma unroll
            for (int nt = 0; nt < 4; ++nt) {
                f32x4 acc = {0.f, 0.f, 0.f, 0.f};
#pragma unroll
                for (int ks = 0; ks < 4; ++ks) acc = MFMA16(fa[ks], fb[nt][ks], acc);
                const int j = 16 * nt + li; const float gj = gcs[j]; const f32x4 giv = *(const LAS f32x4*)(gcs + 16 * it + 4 * g);
#pragma unroll
                for (int i2 = 0; i2 < 4; ++i2) { const int i = 16 * it + 4 * g + i2; const float e = __expf(fminf(giv[i2] - gj, 0.f)); m1[nt][i2] = (i > j) ? -acc[i2] * e : 0.f; }
            }
        } else {
            const int it = w - 4, i = 16 * it + li; const float gi = gcs[i];
            v2u fr[4];
            bf16x8 fq[4], fk[4][4];
#pragma unroll
            for (int ks = 0; ks < 4; ++ks) fq[ks] = ldsb128(L + IMG_Q + (16 * it + li) * CP_STR + (32 * ks + 8 * g) * 2);
#pragma unroll
            for (int jt = 0; jt < 4; ++jt)
#pragma unroll
                for (int ks = 0; ks < 4; ++ks) fk[jt][ks] = ldsb128(L + IMG_K + (16 * jt + li) * CP_STR + (32 * ks + 8 * g) * 2);
            __builtin_amdgcn_sched_barrier(0);
#pragma unroll
            for (int jt = 0; jt < 4; ++jt) {
                f32x4 acc = {0.f, 0.f, 0.f, 0.f};
#pragma unroll
                for (int ks = 0; ks < 4; ++ks) acc = MFMA16(fk[jt][ks], fq[ks], acc);
                const f32x4 gjv = *(const LAS f32x4*)(gcs + 16 * jt + 4 * g);
#pragma unroll
                for (int i2 = 0; i2 < 4; ++i2) { const int j = 16 * jt + 4 * g + i2; const float e = __expf(fminf(gi - gjv[i2], 0.f)); acc[i2] = (j <= i) ? acc[i2] * e : 0.f; }
                fr[jt] = pk4(acc);
            }
            unsigned char* ab = ATp + (size_t)un * 8192 + ((it * 2) * 64 + lane) * 16;
            *(v4u*)ab = (v4u){fr[0].x, fr[0].y, fr[1].x, fr[1].y}; *(v4u*)(ab + 1024) = (v4u){fr[2].x, fr[2].y, fr[3].x, fr[3].y};
        }
        __syncthreads();
        LAS float* Md = (LAS float*)(L + CP_GATES + 1024);
        LAS unsigned char* Tt = L + 3 * NM_IMG;
        if (w < 4) {
#pragma unroll
            for (int nt = 0; nt < 4; ++nt) { const int o = (16 * nt + li) * NM_STR + (16 * w + 4 * g) * 2; *(LAS v2u*)(L + o) = pk4(m1[nt]); if (nt > w) *(LAS v2u*)(Tt + o) = (v2u){0u, 0u}; }
#pragma unroll
            for (int nt = 0; nt < 4; ++nt) if (nt == w) {
#pragma unroll
                for (int i2 = 0; i2 < 4; ++i2) Md[w * 256 + (4 * g + i2) * 16 + li] = m1[nt][i2]; }
        } else {
#pragma unroll
            for (int q = 0; q < 4; ++q) {
                const int f = (w - 4) * 4 + q, dkt = f >> 1, ks2 = f & 1;
                LAS unsigned char* p = L + IMG_KG + (32 * ks2 + 4 * g + (li >> 2)) * CP_STR + (16 * dkt + 4 * (li & 3)) * 2;
                const bf16x8 fr = tr_pair(p, 16 * CP_STR);
                *(bf16x8*)(KGp + (size_t)un * 16384 + ((dkt * 2 + ks2) * 64 + lane) * 16) = fr;
            }
        }
        __syncthreads();
        if (w == 0) {
            float xv[16];
#pragma unroll
            for (int i = 0; i < 16; ++i) {
                float a = (i == li) ? 1.0f : 0.0f;
#pragma unroll
                for (int k4 = 0; k4 < (i + 3) / 4; ++k4) {
                    const f32x4 mv = *(const LAS f32x4*)(Md + g * 256 + i * 16 + 4 * k4);
#pragma unroll
                    for (int e = 0; e < 4; ++e) if (4 * k4 + e < i) a += mv[e] * xv[4 * k4 + e];
                }
                xv[i] = a;
            }
            v4u lo, hi;
            lo.x = pk2(xv[0], xv[1]); lo.y = pk2(xv[2], xv[3]); lo.z = pk2(xv[4], xv[5]); lo.w = pk2(xv[6], xv[7]);
            hi.x = pk2(xv[8], xv[9]); hi.y = pk2(xv[10], xv[11]); hi.z = pk2(xv[12], xv[13]); hi.w = pk2(xv[14], xv[15]);
            LAS unsigned char* d = Tt + (16 * g + li) * NM_STR + (16 * g) * 2;
            *(LAS v4u*)d = lo; *(LAS v4u*)(d + 16) = hi;
        }
        __syncthreads();
        const bf16x8 zf = {0, 0, 0, 0, 0, 0, 0, 0};
        if (w < 2) {
            const int p = w;
            bf16x8 af = tr_pair(L + (32 * p + 8 * g + (li >> 2)) * NM_STR + (32 * p + 16 + 4 * (li & 3)) * 2, 4 * NM_STR);
            bf16x8 bfr = ldsb128(Tt + (32 * p + li) * NM_STR + (32 * p + 8 * g) * 2);
            if (g >= 2) { af = zf; bfr = zf; }
            f32x4 a = {0.f, 0.f, 0.f, 0.f}; a = MFMA16(af, bfr, a);
            *(LAS v2u*)(L + 1 * NM_IMG + (16 * p + li) * NM_STR + (4 * g) * 2) = pk4(a);
        }
        __syncthreads();
        if (w < 2) {
            const int p = w;
            bf16x8 af = tr_pair(Tt + (32 * p + 16 + 8 * g + (li >> 2)) * NM_STR + (32 * p + 16 + 4 * (li & 3)) * 2, 4 * NM_STR);
            bf16x8 bfr = ldsb128(L + 1 * NM_IMG + (16 * p + li) * NM_STR + (8 * g) * 2);
            if (g >= 2) { af = zf; bfr = zf; }
            f32x4 a = {0.f, 0.f, 0.f, 0.f}; a = MFMA16(af, bfr, a);
            *(LAS v2u*)(Tt + (32 * p + li) * NM_STR + (32 * p + 16 + 4 * g) * 2) = pk4(a);
        }
        __syncthreads();
        if (w < 4) {
            const int ti = w >> 1, tn = w & 1;
            const bf16x8 af = tr_pair(L + (8 * g + (li >> 2)) * NM_STR + (32 + 16 * ti + 4 * (li & 3)) * 2, 4 * NM_STR);
            const bf16x8 bfr = ldsb128(Tt + (16 * tn + li) * NM_STR + (8 * g) * 2);
            f32x4 a = {0.f, 0.f, 0.f, 0.f}; a = MFMA16(af, bfr, a);
            *(LAS v2u*)(L + 2 * NM_IMG + (16 * tn + li) * NM_STR + (16 * ti + 4 * g) * 2) = pk4(a);
        }
        __syncthreads();
        if (w < 4) {
            const int ti = w >> 1, tn = w & 1;
            const bf16x8 af = tr_pair(Tt + (32 + 8 * g + (li >> 2)) * NM_STR + (32 + 16 * ti + 4 * (li & 3)) * 2, 4 * NM_STR);
            const bf16x8 bfr = ldsb128(L + 2 * NM_IMG + (16 * tn + li) * NM_STR + (8 * g) * 2);
            f32x4 a = {0.f, 0.f, 0.f, 0.f}; a = MFMA16(af, bfr, a);
            *(LAS v2u*)(Tt + (16 * tn + li) * NM_STR + (32 + 16 * ti + 4 * g) * 2) = pk4(a);
        }
        __syncthreads();
        for (int rp_ = 0; rp_ < (PROBE_CP == 3 ? 2 : 1); ++rp_) {
        {
            bf16x8 tf[4][2];
#pragma unroll
            for (int it = 0; it < 4; ++it)
#pragma unroll
                for (int ks = 0; ks < 2; ++ks) tf[it][ks] = tr_pair(Tt + (32 * ks + 8 * g + (li >> 2)) * NM_STR + (16 * it + 4 * (li & 3)) * 2, 4 * NM_STR);
            bf16x8 vbf[2], kbf[2];
#pragma unroll
            for (int ks = 0; ks < 2; ++ks) {
                const int o = (32 * ks + 8 * g + (li >> 2)) * CP_STR + (16 * w + 4 * (li & 3)) * 2;
                vbf[ks] = tr_pair(L + IMG_VB + o, 4 * CP_STR); kbf[ks] = tr_pair(L + IMG_KBG + o, 4 * CP_STR);
            }
#pragma unroll
            for (int it = 0; it < 4; ++it) {
                f32x4 a = {0.f, 0.f, 0.f, 0.f}; a = MFMA16(tf[it][0], vbf[0], a); a = MFMA16(tf[it][1], vbf[1], a);
                *(f32x4*)(UFp + (size_t)un * 32768 + ((w * 4 + it) * 64 + lane) * 16) = a;
                f32x4 d = {0.f, 0.f, 0.f, 0.f}; d = MFMA16(kbf[0], tf[it][0], d); d = MFMA16(kbf[1], tf[it][1], d);
                *(v2u*)(WFp + (size_t)un * 16384 + ((it * 4 + (w >> 1)) * 64 + lane) * 16 + (w & 1) * 8) = pk4(-d);
            }
        }
        }
        __syncthreads();
    }
}

constexpr int SC_SLOT = 43008;
#define SB_() __builtin_amdgcn_sched_barrier(0)
__device__ __forceinline__ void scan_compute(const LAS unsigned char* B, f32x4 (&S)[8], float dc, unsigned char* sbp, unsigned char* vbp, int lane) {
    const LAS unsigned char* Bl = B + lane * 16;
    bf16x8 h0[8], h1[8];
    f32x4 vn[4];
#pragma unroll
    for (int mt = 0; mt < 4; ++mt) { h0[2 * mt] = ldsb128(Bl + (mt * 4 + 0) * 1024); h0[2 * mt + 1] = ldsb128(Bl + (mt * 4 + 1) * 1024); }
#pragma unroll
    for (int mt = 0; mt < 4; ++mt) vn[mt] = *(const LAS f32x4*)(Bl + 32768 + mt * 1024);
#pragma unroll
    for (int mt = 0; mt < 4; ++mt) { h1[2 * mt] = ldsb128(Bl + (mt * 4 + 2) * 1024); h1[2 * mt + 1] = ldsb128(Bl + (mt * 4 + 3) * 1024); }
    bf16x8 Sb[4];
#pragma unroll
    for (int ks = 0; ks < 4; ++ks) { const v2u lo = pk4(S[2 * ks]), hi = pk4(S[2 * ks + 1]); Sb[ks] = __builtin_bit_cast(bf16x8, (v4u){lo.x, lo.y, hi.x, hi.y}); __builtin_nontemporal_store(Sb[ks], (bf16x8*)(sbp + ks * 1024)); }
    SB_();
#pragma unroll
    for (int k2 = 0; k2 < 2; ++k2)
#pragma unroll
        for (int mt = 0; mt < 4; ++mt) vn[mt] = MFMA16(h0[2 * mt + k2], Sb[k2], vn[mt]);
    SB_();
#pragma unroll
    for (int d = 0; d < 4; ++d) { h0[2 * d] = ldsb128(Bl + 16384 + (d * 2) * 1024); h0[2 * d + 1] = ldsb128(Bl + 16384 + (d * 2 + 1) * 1024); }
    SB_();
#pragma unroll
    for (int k2 = 0; k2 < 2; ++k2)
#pragma unroll
        for (int mt = 0; mt < 4; ++mt) vn[mt] = MFMA16(h1[2 * mt + k2], Sb[2 + k2], vn[mt]);
    SB_();
#pragma unroll
    for (int d = 0; d < 4; ++d) { h1[2 * d] = ldsb128(Bl + 16384 + ((d + 4) * 2) * 1024); h1[2 * d + 1] = ldsb128(Bl + 16384 + ((d + 4) * 2 + 1) * 1024); }
    bf16x8 vb[2];
#pragma unroll
    for (int ks = 0; ks < 2; ++ks) { const v2u lo = pk4(vn[2 * ks]), hi = pk4(vn[2 * ks + 1]); vb[ks] = __builtin_bit_cast(bf16x8, (v4u){lo.x, lo.y, hi.x, hi.y}); __builtin_nontemporal_store(vb[ks], (bf16x8*)(vbp + ks * 1024)); }
#pragma unroll
    for (int d = 0; d < 8; ++d) S[d] = S[d] * dc;
    SB_();
#pragma unroll
    for (int ks = 0; ks < 2; ++ks)
#pragma unroll
        for (int d = 0; d < 4; ++d) S[d] = MFMA16(h0[2 * d + ks], vb[ks], S[d]);
#pragma unroll
    for (int ks = 0; ks < 2; ++ks)
#pragma unroll
        for (int d = 0; d < 4; ++d) S[4 + d] = MFMA16(h1[2 * d + ks], vb[ks], S[4 + d]);
    SB_();
}
#undef SB_
#define SCAN_STRIDE(i_) ((i_) == 4 ? st4 : ((i_) == 5 ? 32768u : 16384u))
#define SCAN_LOAD(R, CHK) do { const size_t un_ = (size_t)(bh * 128 + ((CHK) < NCH ? (CHK) : NCH - 1)); _Pragma("unroll") for (int i_ = 0; i_ < 6; ++i_) R[i_] = *(const v4u*)(F.ws + bo[i_] + un_ * SCAN_STRIDE(i_)); } while (0)
#define SCAN_STORE(R, SLOT) do { LAS unsigned char* Bn_ = L + (SLOT) * SC_SLOT + lt * 16; _Pragma("unroll") for (int i_ = 0; i_ < 6; ++i_) *(LAS v4u*)(Bn_ + i_ * 448 * 16) = R[i_]; } while (0)
#define SCAN_BAR() do { asm volatile("s_waitcnt lgkmcnt(0)" ::: "memory"); __builtin_amdgcn_s_barrier(); asm volatile("" ::: "memory"); } while (0)
__device__ __forceinline__ void ph_scan(Frame& F) {
    if (F.blk < 128) {
        const int x = F.blk & 7, qq = F.blk >> 3, bh = x + 8 * (qq >> 3), s = qq & 7;
        const int lane = F.lane, w = F.wave;
        LAS unsigned char* L = F.lds;
        const float* CDEC = WSP(const float, WS_CDEC);
        if (w == 0) {
            unsigned char* sbp = F.ws + WS_SBF + ((size_t)(bh * 128) * 8 + s) * 4096 + lane * 16;
            unsigned char* vbp = F.ws + WS_VBF + ((size_t)(bh * 128) * 8 + s) * 2048 + lane * 16;
            f32x4 S[8];
#pragma unroll
            for (int d = 0; d < 8; ++d) S[d] = (f32x4){0.f, 0.f, 0.f, 0.f};
            float dnext = CDEC[bh * 128];
            SCAN_BAR();
#pragma unroll 1
            for (int c = 0; c < NCH; c += 2) {
                { const float dc = dnext; dnext = CDEC[bh * 128 + c + 1]; scan_compute(L, S, dc, sbp + (size_t)c * 32768, vbp + (size_t)c * 16384, lane); }
                SCAN_BAR();
                { const float dc = dnext; dnext = CDEC[bh * 128 + (c + 2 < NCH ? c + 2 : NCH - 1)]; scan_compute(L + SC_SLOT, S, dc, sbp + (size_t)(c + 1) * 32768, vbp + (size_t)(c + 1) * 16384, lane); }
                SCAN_BAR();
            }
        } else {
            const int lt = (w - 1) * 64 + lane;
            unsigned bo[6]; unsigned st4 = 16384u;
#pragma unroll
            for (int i = 0; i < 6; ++i) {
                int j = lt + 448 * i; j = j < 2304 ? j : 2303;
                unsigned o = (unsigned)WS_WF + (unsigned)j * 16u;
                if (j >= 1024) o = (unsigned)WS_KGF + (unsigned)(j - 1024) * 16u;
                if (j >= 2048) { o = (unsigned)WS_UF + (unsigned)s * 4096u + (unsigned)(j - 2048) * 16u; if (i == 4) st4 = 32768u; }
                bo[i] = o;
            }
            v4u rA[6], rB[6], rC[6], rD[6];
            SCAN_LOAD(rA, 0); SCAN_STORE(rA, 0); SCAN_LOAD(rA, 1); SCAN_LOAD(rB, 2); SCAN_LOAD(rC, 3); SCAN_LOAD(rD, 4);
            SCAN_BAR();
#pragma unroll 1
            for (int c = 0; c < NCH; c += 4) {
                SCAN_STORE(rA, 1); SCAN_LOAD(rA, c + 5); SCAN_BAR();
                SCAN_STORE(rB, 0); SCAN_LOAD(rB, c + 6); SCAN_BAR();
                SCAN_STORE(rC, 1); SCAN_LOAD(rC, c + 7); SCAN_BAR();
                SCAN_STORE(rD, 0); SCAN_LOAD(rD, c + 8); SCAN_BAR();
            }
        }
    } else {
#if CONV_IN_SCAN
        ph_weights_moe_blk(F, F.blk - 128, 128);
#endif
    }
}
#undef SCAN_LOAD
#undef SCAN_STRIDE
#undef SCAN_STORE
#undef SCAN_BAR
#define OP_BAR() do { asm volatile("s_waitcnt lgkmcnt(0)" ::: "memory"); __builtin_amdgcn_s_barrier(); asm volatile("" ::: "memory"); } while (0)
struct OpSmall { bf16x8 sf[4], vf[2]; unsigned short gt[16]; };
__device__ __forceinline__ void op_issue(Frame& F, int un, int w, int lane, LAS unsigned char* tile, OpSmall& R) {
#pragma unroll
    for (int q = 0; q < 3; ++q) { const int f = w * 3 + q;
        const unsigned char* src = (f < 16 ? F.ws + WS_QGF + (size_t)un * 16384 + f * 1024 : F.ws + WS_ATF + (size_t)un * 8192 + (f - 16) * 1024) + lane * 16;
        __builtin_amdgcn_global_load_lds((const unsigned*)src, (LAS unsigned*)(tile + f * 1024), 16, 0, 0); }
    const unsigned char* sb = F.ws + WS_SBF + ((size_t)un * 8 + w) * 4096 + lane * 16;
    const unsigned char* vb = F.ws + WS_VBF + ((size_t)un * 8 + w) * 2048 + lane * 16;
#pragma unroll
    for (int i = 0; i < 4; ++i) R.sf[i] = *(const bf16x8*)(sb + i * 1024);
#pragma unroll
    for (int i = 0; i < 2; ++i) R.vf[i] = *(const bf16x8*)(vb + i * 1024);
    const int b = un >> 10, h = (un >> 7) & 7, c = un & 127, li = lane & 15, g = lane >> 4;
    const bf16* gp = WSP(const bf16, WS_GATE) + ((size_t)b * T + (size_t)c * CH + 4 * g) * D + 128 * h + 16 * w + li;
#pragma unroll
    for (int mt = 0; mt < 4; ++mt)
#pragma unroll
        for (int i = 0; i < 4; ++i) R.gt[mt * 4 + i] = gp[(size_t)(16 * mt + i) * D];
}
__device__ __forceinline__ void ph_ophase(Frame& F) {
    bf16* MIX = WSP(bf16, WS_MIX);
    LAS float* part = (LAS float*)F.lds;
    LAS float* rinv = part + 512;
    LAS unsigned char* tiles = F.lds + 4096;
    const int w = F.wave;
    constexpr int NU = NB * DH * NCH;
    OpSmall R;
    if (F.blk < NU) op_issue(F, F.blk, w, F.lane, tiles, R);
    int par = 0;
#pragma unroll 1
    for (int un = F.blk; un < NU; un += GRID, par ^= 1) {
        int tid = F.tid; asm volatile("" : "+v"(tid));
        const int lane = tid & 63, li = lane & 15, g = lane >> 4;
        const int b = un >> 10, h = (un >> 7) & 7, c = un & 127;
        OpSmall C = R;
        asm volatile("s_waitcnt vmcnt(0)" ::: "memory");
        OP_BAR();
        if (un + GRID < NU) op_issue(F, un + GRID, w, lane, tiles + (par ^ 1) * 24576, R);
        const LAS unsigned char* tl = tiles + par * 24576 + lane * 16;
        f32x4 oa[4];
#pragma unroll
        for (int mt = 0; mt < 4; ++mt) { oa[mt] = (f32x4){0.f, 0.f, 0.f, 0.f};
#pragma unroll
            for (int ks = 0; ks < 4; ++ks) oa[mt] = MFMA16(ldsb128(tl + (mt * 4 + ks) * 1024), C.sf[ks], oa[mt]);
#pragma unroll
            for (int ks = 0; ks < 2; ++ks) oa[mt] = MFMA16(ldsb128(tl + 16384 + (mt * 2 + ks) * 1024), C.vf[ks], oa[mt]); }
#pragma unroll
        for (int mt = 0; mt < 4; ++mt)
#pragma unroll
            for (int i = 0; i < 4; ++i) { const float q = row16_sum(oa[mt][i] * oa[mt][i]); if (li == 0) part[w * 64 + 16 * mt + 4 * g + i] = q; }
        OP_BAR();
        if (tid < 64) { float sacc = 0.f;
#pragma unroll
            for (int q = 0; q < 8; ++q) sacc += part[q * 64 + tid];
            rinv[tid] = 1.0f / sqrtf(sacc * (1.f / DHD) + EPS); }
        OP_BAR();
        const float ng = F.o_norm_g[16 * w + li];
        LAS unsigned char* ot = F.lds + 4096 + 2 * 24576;
#pragma unroll
        for (int mt = 0; mt < 4; ++mt) { const f32x4 rv = *(const LAS f32x4*)(rinv + 16 * mt + 4 * g);
#pragma unroll
            for (int i = 0; i < 4; ++i) { const float gv = bf2f(C.gt[mt * 4 + i]); *(LAS unsigned short*)(ot + (16 * mt + 4 * g + i) * 272 + (16 * w + li) * 2) = (unsigned short)f2bf(oa[mt][i] * rv[i] * ng * silu_f(gv)); } }
        OP_BAR();
        { bf16* mp = MIX + ((size_t)b * T + (size_t)c * CH) * D + 128 * h;
#pragma unroll
          for (int q = 0; q < 2; ++q) { const int p = tid + 512 * q, row = p >> 4, ch = p & 15; *(v4u*)(mp + (size_t)row * D + ch * 8) = *(const LAS v4u*)(ot + row * 272 + ch * 16); } }
    }
    asm volatile("s_waitcnt vmcnt(0)" ::: "memory"); __syncthreads();
}
#undef OP_BAR
constexpr int NPHASE = 20;
__global__ void __launch_bounds__(NTHR, 2) mega(Args args) {
    extern __shared__ __attribute__((aligned(16))) unsigned char lds_raw[];
    Frame F; frame_init(F, args, (LAS unsigned char*)lds_raw);
    volatile LAS unsigned* MISC = (volatile LAS unsigned*)(F.lds + MISC_OFF);
    for (int u = F.tid; u < (LDS_BYTES - MISC_OFF) / 4; u += NTHR) ((LAS unsigned*)(F.lds + MISC_OFF))[u] = 0u;
    __syncthreads();
    const int lo = args.ph_lo, hi = args.ph_hi;
    XcdBarrier bar; bar.bar = WSP(unsigned, WS_CTL) + CW_BAR + args.li * XCD_BAR_WORDS; bar.x = 0; bar.st = nullptr;
    if (hi - lo > 1) bar = xcd_barrier_post(WSP(unsigned, WS_CTL) + CW_BAR + args.li * XCD_BAR_WORDS, MISC + 8);
#define IN(k) (lo <= (k) && (k) < hi)
#define SEAM(k) do { if (IN(k) && IN((k) + 1)) xcd_barrier(bar); } while (0)
    if (IN(0)) { ph_mod_rope(F); __syncthreads(); ph_weights_dense(F); SEAM(0); }
    if (IN(1)) { ph_norm_a(F); SEAM(1); }
    if (IN(2)) {
        pg8::Gemm g{WSP(const bf16, WS_H), WSP(const bf16, WS_WB_L0IN), M, L0N, D}; pg8::StaticOrder S; S.init(M, L0N, GRID, F.blk);
        pg8::EpiL0In E{WSP(bf16, WS_PROJ0), WSP(const float, WS_ROPE)};
        pg8::gemm_phase<pg8::EpiL0In, pg8::StaticOrder, true, true>(F.lds, g, S, E);
        SEAM(2);
    }
    if (IN(3)) { ph_attn_pool(F); SEAM(3); }
    if (IN(4)) { ph_attn_combine(F); SEAM(4); }
    if (IN(5)) {
        pg8::Gemm g{WSP(const bf16, WS_MIX), WSP(const bf16, WS_WB_L0OUT), M, D, D}; pg8::StaticOrder S; S.init(M, D, GRID, F.blk);
        pg8::EpiPlain E{WSP(bf16, WS_Y), D, nullptr, 0, 1 << 30, 1 << 30, 1.0f};
        pg8::gemm_phase<pg8::EpiPlain, pg8::StaticOrder, true, true>(F.lds, g, S, E);
        SEAM(5);
    }
    if (IN(6)) { ph_norm_mid<0>(F); SEAM(6); }
    if (IN(7)) {
        pg8::Gemm g{WSP(const bf16, WS_H), WSP(const bf16, WS_WB_L0GU), M, 2 * FF, D}; pg8::StaticOrder S; S.init(M, 2 * FF, GRID, F.blk);
        pg8::EpiSwiglu E{WSP(bf16, WS_HID0), FF, 1 << 30};
        pg8::gemm_phase<pg8::EpiSwiglu, pg8::StaticOrder, true, true>(F.lds, g, S, E);
        SEAM(7);
    }
    if (IN(8)) {
        pg8::Gemm g{WSP(const bf16, WS_HID0), WSP(const bf16, WS_WB_L0DN), M, D, FF}; pg8::StaticOrder S; S.init(M, D, GRID, F.blk);
        pg8::EpiPlain E{WSP(bf16, WS_Y), D, nullptr, 0, 1 << 30, 1 << 30, 1.0f};
        pg8::gemm_phase<pg8::EpiPlain, pg8::StaticOrder, true, true>(F.lds, g, S, E);
        SEAM(8);
    }
    if (IN(9)) { ph_norm_mid<1>(F); SEAM(9); }
    if (IN(10)) {
        pg8::Gemm g{WSP(const bf16, WS_H), WSP(const bf16, WS_WB_L1IN), M, 4096, D}; pg8::StaticOrder S; S.init(M, 4096, GRID, F.blk);
        pg8::EpiPlain E{WSP(bf16, WS_QKV), 3072, WSP(bf16, WS_GATE), D, 12, 1 << 30, 1.0f};
        pg8::gemm_phase<pg8::EpiPlain, pg8::StaticOrder, true, true>(F.lds, g, S, E);
        SEAM(10);
    }
    if (IN(11)) { ph_chunk_prep(F); SEAM(11); }
    if (IN(12)) { ph_scan(F); SEAM(12); }
    if (IN(13)) { ph_ophase(F); SEAM(13); }
    if (IN(14)) {
        pg8::Gemm g{WSP(const bf16, WS_MIX), WSP(const bf16, WS_WB_L1OUT), M, D, D}; pg8::StaticOrder S; S.init(M, D, GRID, F.blk);
        pg8::EpiPlain E{WSP(bf16, WS_Y), D, nullptr, 0, 1 << 30, 1 << 30, 1.0f};
        pg8::gemm_phase<pg8::EpiPlain, pg8::StaticOrder, true, true>(F.lds, g, S, E);
        SEAM(14);
    }
    if (IN(15)) { ph_norm_mid<2>(F); SEAM(15); }
    if (IN(16)) { ph_moe_gather(F);
        SEAM(16); }
    if (IN(17)) {
        pg8::Gemm g{F.ws + WS_ASORT, F.ws + WS_WB_GU, MAXROWS, NE * 2 * FF, D}; pg8::MoeOrder S; S.init(WSP(const int, WS_CTL) + CW_TP, 28, GRID, F.blk);
        pg8::EpiSwigluF8 E{F.ws + WS_HID, FF, 28, 0.03125f, 4.0f};
        pg8::gemm_phase<pg8::EpiSwigluF8, pg8::MoeOrder, true, true, true>(F.lds, g, S, E);
        SEAM(17);
    }
    if (IN(18)) {
        pg8::Gemm g{F.ws + WS_HID, F.ws + WS_WB_DN, MAXROWS, NE * D, FF}; pg8::MoeOrder S; S.init(WSP(const int, WS_CTL) + CW_TP, 4, GRID, F.blk);
        pg8::EpiPlain E{WSP(bf16, WS_YS), D, nullptr, 0, 1 << 30, 4, 0.00390625f};
        pg8::gemm_phase<pg8::EpiPlain, pg8::MoeOrder, true, true, true>(F.lds, g, S, E);
        SEAM(18);
    }
    if (IN(19)) { ph_final(F); }
#undef IN
#undef SEAM
}

extern "C" void kernel_launch(void* const* d_in, const int* in_sizes, int n_in, void* d_out, int out_size, void* d_ws, size_t ws_size, hipStream_t stream) {
    static int ok = 0;
    if (ok == 0) {
        if (n_in != 26 || in_sizes[0] != M * D || out_size != M * D || ws_size < WS_NEED) { fprintf(stderr, "kernel_launch: unexpected shapes (n_in %d, in0 %d, out %d, ws %zu)\n", n_in, n_in > 0 ? in_sizes[0] : -1, out_size, ws_size); ok = -1; return; }
        if (hipFuncSetAttribute((const void*)mega, hipFuncAttributeMaxDynamicSharedMemorySize, LDS_BYTES) != hipSuccess) { fprintf(stderr, "kernel_launch: hipFuncSetAttribute failed\n"); ok = -1; return; }
        int per_cu = 0; (void)hipOccupancyMaxActiveBlocksPerMultiprocessor(&per_cu, (const void*)mega, NTHR, LDS_BYTES); (void)hipGetLastError();
        if (per_cu < 1) fprintf(stderr, "kernel_launch: occupancy query says %d\n", per_cu);
        ok = 1;
    }
    if (ok < 0) return;
    (void)hipMemsetAsync((char*)d_ws + WS_CTL, 0, CTL_BYTES, stream);
    Args a{}; for (int i = 0; i < 26; ++i) a.in[i] = d_in[i]; a.out = (float*)d_out; a.ws = (unsigned char*)d_ws;
    a.ph_lo = 0; a.ph_hi = NPHASE; a.li = 0;
    hipLaunchKernelGGL(mega, dim3(GRID), dim3(NTHR), LDS_BYTES, stream, a);
}
```

```cpp
#include <hip/hip_runtime.h>
#include <cstdio>
#include <cstdint>

#ifndef CONV_IN_SCAN
#define CONV_IN_SCAN 1
#endif
#define GAS __attribute__((address_space(1)))
#define LAS __attribute__((address_space(3)))
typedef unsigned short bf16;
typedef float f32x4 __attribute__((ext_vector_type(4)));
typedef float f32x2 __attribute__((ext_vector_type(2)));
typedef short bf16x8 __attribute__((ext_vector_type(8)));
typedef short s16x4 __attribute__((ext_vector_type(4)));
typedef unsigned v4u __attribute__((ext_vector_type(4)));
typedef unsigned v2u __attribute__((ext_vector_type(2)));

constexpr int NB = 2, T = 8192, D = 1024, M = NB * T;
constexpr int AH = 8, AHD = 64, AW = 512;
constexpr int L0N = 2048;
constexpr int FF = 3584;
constexpr int DH = 8, DHD = 128;
constexpr int L1N = 4112;
constexpr int NE = 8;
constexpr int CH = 64, NCH = T / CH;
constexpr float EPS = 1e-6f;
constexpr int MAXTILES = 136;
constexpr int MAXROWS = MAXTILES * 256;

constexpr size_t MiB = 1u << 20;
constexpr size_t WS_CTL = 0, CTL_BYTES = 1 * MiB;
constexpr size_t WS_MOD = 1 * MiB;
constexpr size_t WS_ROPE = 2 * MiB;
constexpr size_t WS_BL = 3 * MiB;
constexpr size_t WS_ROUTE = 4 * MiB;
constexpr size_t WS_XB = 4 * MiB + 512 * 1024;
constexpr size_t WS_LSE = 5 * MiB;
constexpr size_t WS_POOLWT = 7 * MiB;
constexpr size_t WS_H = 8 * MiB;
constexpr size_t WS_WB_L1IN = 40 * MiB;
constexpr size_t WS_WB_L1OUT = 48 * MiB;
constexpr size_t WS_WB_L0IN = 50 * MiB;
constexpr size_t WS_WB_L0OUT = 54 * MiB;
constexpr size_t WS_WB_L0GU = 56 * MiB;
constexpr size_t WS_WB_L0DN = 70 * MiB;
constexpr size_t WS_Y = 78 * MiB;
constexpr size_t WS_MIX = 110 * MiB;
constexpr size_t WS_G0 = 142 * MiB;
constexpr size_t WS_PROJ0 = WS_G0;
constexpr size_t WS_ATTP = WS_G0 + 64 * MiB;
constexpr size_t WS_HID0 = WS_G0 + 112 * MiB;
constexpr size_t WS_QKV = WS_G0;
constexpr size_t WS_GATE = WS_G0 + 96 * MiB;
constexpr size_t WS_WF = WS_G0 + 128 * MiB;
constexpr size_t WS_QGF = WS_G0 + 160 * MiB;
constexpr size_t WS_KGF = WS_G0 + 192 * MiB;
constexpr size_t WS_ATF = WS_G0 + 224 * MiB;
constexpr size_t WS_UF = WS_G0 + 240 * MiB;
constexpr size_t WS_O = WS_G0 + 304 * MiB;
constexpr size_t WS_SBF = WS_G0 + 304 * MiB;
constexpr size_t WS_VBF = WS_H;
constexpr size_t WS_CDEC = 6 * MiB + 512 * 1024;
constexpr size_t WS_ASORT = 8 * MiB;
constexpr size_t WS_YS = 42 * MiB;
constexpr size_t WS_YSP = 8 * MiB;
constexpr size_t WS_WB_GU = WS_G0;
constexpr size_t WS_WB_DN = WS_G0 + 56 * MiB;
constexpr size_t WS_H2 = WS_G0 + 84 * MiB;
constexpr size_t WS_HID = WS_G0 + 112 * MiB;
constexpr size_t WS_NEED = 512 * MiB;
constexpr int CW_BAR = 4096;
constexpr int CW_CNT = 120000;
constexpr int CW_TP = 130000;

__device__ __forceinline__ unsigned f2bf(float f) { unsigned u = __builtin_bit_cast(unsigned, f); return (u + 0x7fffu + ((u >> 16) & 1u)) >> 16; }
typedef __bf16 bf16x2_t __attribute__((ext_vector_type(2)));
__device__ __forceinline__ unsigned pk2(float lo, float hi) { const f32x2 v = {lo, hi}; return __builtin_bit_cast(unsigned, __builtin_convertvector(v, bf16x2_t)); }
__device__ __forceinline__ float bf2f(unsigned b) { return __builtin_bit_cast(float, (b & 0xffffu) << 16); }
__device__ __forceinline__ float bflo(unsigned w) { return __builtin_bit_cast(float, w << 16); }
__device__ __forceinline__ float bfhi(unsigned w) { return __builtin_bit_cast(float, w & 0xffff0000u); }
__device__ __forceinline__ unsigned pk4f8(float a, float b, float c, float d) {
    a = __builtin_amdgcn_fmed3f(a, -448.f, 448.f); b = __builtin_amdgcn_fmed3f(b, -448.f, 448.f); c = __builtin_amdgcn_fmed3f(c, -448.f, 448.f); d = __builtin_amdgcn_fmed3f(d, -448.f, 448.f);
    unsigned w = 0u; w = __builtin_amdgcn_cvt_pk_fp8_f32(a, b, w, false); w = __builtin_amdgcn_cvt_pk_fp8_f32(c, d, w, true); return w; }
#define DPP_ADD(v, ctrl) v += __builtin_bit_cast(float, __builtin_amdgcn_mov_dpp(__builtin_bit_cast(int, v), ctrl, 0xf, 0xf, true))
__device__ __forceinline__ float row16_sum(float v) { DPP_ADD(v, 0xB1); DPP_ADD(v, 0x4E); DPP_ADD(v, 0x141); DPP_ADD(v, 0x140); return v; }
__device__ __forceinline__ float row8_sum(float v) { DPP_ADD(v, 0xB1); DPP_ADD(v, 0x4E); DPP_ADD(v, 0x141); return v; }
__device__ __forceinline__ float wave_sum(float v) {
    const int r = __builtin_bit_cast(int, row16_sum(v));
    return (__builtin_bit_cast(float, __builtin_amdgcn_readlane(r, 0)) + __builtin_bit_cast(float, __builtin_amdgcn_readlane(r, 16))) + (__builtin_bit_cast(float, __builtin_amdgcn_readlane(r, 32)) + __builtin_bit_cast(float, __builtin_amdgcn_readlane(r, 48)));
}
__device__ __forceinline__ float silu_f(float x) { return x * __builtin_amdgcn_rcpf(1.f + __expf(-x)); }
__device__ __forceinline__ float sigmoid_f(float x) { return __builtin_amdgcn_rcpf(1.f + __expf(-x)); }
__device__ __forceinline__ float softplus_f(float x) { return fmaxf(x, 0.f) + __logf(1.0f + __expf(-fabsf(x))); }
#define SWAP16(v) const unsigned u_ = __builtin_bit_cast(unsigned, v); const auto r_ = __builtin_amdgcn_permlane16_swap(u_, u_, false, false); const unsigned a_ = r_[0], b_ = r_[1]
#define SWAP32(v) const unsigned u_ = __builtin_bit_cast(unsigned, v); const auto r_ = __builtin_amdgcn_permlane32_swap(u_, u_, false, false); const unsigned a_ = r_[0], b_ = r_[1]
__device__ __forceinline__ float xmax16(float v) { SWAP16(v); return fmaxf(__builtin_bit_cast(float, a_), __builtin_bit_cast(float, b_)); }
__device__ __forceinline__ float xmax32(float v) { SWAP32(v); return fmaxf(__builtin_bit_cast(float, a_), __builtin_bit_cast(float, b_)); }
__device__ __forceinline__ float xsum16(float v) { SWAP16(v); return __builtin_bit_cast(float, a_) + __builtin_bit_cast(float, b_); }
__device__ __forceinline__ float xsum32(float v) { SWAP32(v); return __builtin_bit_cast(float, a_) + __builtin_bit_cast(float, b_); }
__device__ __forceinline__ float xchg16(float v, bool oddrow) { SWAP16(v); return __builtin_bit_cast(float, oddrow ? a_ : b_); }
#undef SWAP16
#undef SWAP32
__device__ __forceinline__ float red4(float a0, float a1, float a2, float a3) {
    const auto p = __builtin_amdgcn_permlane32_swap(__builtin_bit_cast(unsigned, a0), __builtin_bit_cast(unsigned, a1), false, false); const unsigned p0 = p[0], p1 = p[1];
    const auto q = __builtin_amdgcn_permlane32_swap(__builtin_bit_cast(unsigned, a2), __builtin_bit_cast(unsigned, a3), false, false); const unsigned q0 = q[0], q1 = q[1];
    const float s = __builtin_bit_cast(float, p0) + __builtin_bit_cast(float, p1), t = __builtin_bit_cast(float, q0) + __builtin_bit_cast(float, q1);
    const auto r = __builtin_amdgcn_permlane16_swap(__builtin_bit_cast(unsigned, s), __builtin_bit_cast(unsigned, t), false, false); const unsigned r0 = r[0], r1 = r[1];
    return row16_sum(__builtin_bit_cast(float, r0) + __builtin_bit_cast(float, r1));
}
#define RED4_ROW(q) ((q) == 1 ? 2 : ((q) == 2 ? 1 : (q)))
__device__ __forceinline__ float dot16(const f32x4 (&h)[4], const f32x4 (&w)[4]) {
    f32x2 acc = {0.f, 0.f};
#pragma unroll
    for (int jj = 0; jj < 4; ++jj) { acc += (f32x2){h[jj].x, h[jj].y} * (f32x2){w[jj].x, w[jj].y}; acc += (f32x2){h[jj].z, h[jj].w} * (f32x2){w[jj].z, w[jj].w}; }
    return acc.x + acc.y;
}
#define XB_TMO      128
#define XB_XCNT(j)  (256  + 64 * (j))
#define XB_XSUB(j)  (1280 + 64 * (j))
#define XB_XGEN(j)  (2304 + 64 * (j))
#define XB_TOP      3328
#define XB_TOPGEN   3392
#define XCD_BAR_WORDS 3456
#define XB_SPIN_CAP (1u << 18)

__device__ __forceinline__ unsigned xb_ld(unsigned* p)              { return __hip_atomic_load(p, __ATOMIC_RELAXED, __HIP_MEMORY_SCOPE_AGENT); }
__device__ __forceinline__ unsigned xb_add(unsigned* p, unsigned v) { return __hip_atomic_fetch_add(p, v, __ATOMIC_RELAXED, __HIP_MEMORY_SCOPE_AGENT); }
__device__ __forceinline__ unsigned xb_xcc_id() { return (unsigned)__builtin_amdgcn_s_getreg((3 << 11) | 20) & 0xFu; }
#define XB_SPIN(cond, bar) do { unsigned _sp = 0; while (cond) { __builtin_amdgcn_s_sleep(1); \
    if ((++_sp & 255u) == 0u) { if (xb_ld(&(bar)[XB_TMO])) break; if (_sp > XB_SPIN_CAP) { atomicAdd(&(bar)[XB_TMO], 1u); break; } } } } while (0)

struct XcdBarrier {
    unsigned* bar; unsigned x;
    volatile LAS unsigned* st;
};

__device__ __forceinline__ XcdBarrier xcd_barrier_post(unsigned* bar, volatile LAS unsigned* st) {
    XcdBarrier b; b.bar = bar; b.x = xb_xcc_id(); b.st = st;
    if (threadIdx.x == 0) (void)xb_add(&bar[XB_XCNT(b.x)], 1u);
    return b;
}
__device__ __forceinline__ void xcd_barrier_complete(unsigned* bar, unsigned x, unsigned& nloc, unsigned& nx) {
    const unsigned G = gridDim.x * gridDim.y * gridDim.z;
    unsigned sum, cnt, mine, sp = 0u;
    for (;;) {
        sum = 0u; cnt = 0u; mine = 0u;
#pragma unroll
        for (unsigned j = 0; j < 16; ++j) { const unsigned c = xb_ld(&bar[XB_XCNT(j)]); sum += c; cnt += (c > 0u) ? 1u : 0u; mine = (j == x) ? c : mine; }
        if (sum == G) break;
        __builtin_amdgcn_s_sleep(1);
        if ((++sp & 255u) == 0u) { if (xb_ld(&bar[XB_TMO])) break; if (sp > XB_SPIN_CAP) { atomicAdd(&bar[XB_TMO], 1u); break; } }
    }
    nloc = mine > 0u ? mine : 1u; nx = cnt > 0u ? cnt : 1u;
}

__device__ __forceinline__ void xcd_barrier(const XcdBarrier& b, const int tid) {
    asm volatile("s_waitcnt vmcnt(0)" ::: "memory");
    __syncthreads();
    if (tid == 0) {
        unsigned* bar = b.bar;
        __builtin_amdgcn_s_waitcnt(0);
        unsigned nloc = b.st[0], nx = b.st[1];
        if (nloc == 0u) { xcd_barrier_complete(bar, b.x, nloc, nx); b.st[0] = nloc; b.st[1] = nx; }
        const unsigned old = xb_add(&bar[XB_XSUB(b.x)], 1u);
        const unsigned gen = old / nloc;
        if (old + 1u == (gen + 1u) * nloc) {
            __builtin_amdgcn_fence(__ATOMIC_RELEASE, "agent");
            asm volatile("s_waitcnt vmcnt(0)" ::: "memory");
            const unsigned og = xb_add(&bar[XB_TOP], 1u);
            const unsigned tg = og / nx;
            if (og + 1u == (tg + 1u) * nx) xb_add(&bar[XB_TOPGEN], 1u);
            else XB_SPIN(xb_ld(&bar[XB_TOPGEN]) == tg, bar);
            __builtin_amdgcn_fence(__ATOMIC_ACQUIRE, "agent");
            xb_add(&bar[XB_XGEN(b.x)], 1u);
            asm volatile("s_waitcnt vmcnt(0)" ::: "memory");
        } else {
            XB_SPIN(xb_ld(&bar[XB_XGEN(b.x)]) == gen, bar);
            __builtin_amdgcn_fence(__ATOMIC_ACQUIRE, "agent");
            asm volatile("s_waitcnt vmcnt(0)" ::: "memory");
        }
    }
    __syncthreads();
}

__global__ void placement_pad(int* p) {
    asm volatile("s_nop 0\n\ts_nop 0\n\ts_nop 0\n\ts_nop 0\n\ts_nop 0\n\ts_nop 0\n\ts_nop 0\n\ts_nop 0\n\ts_nop 0\n\ts_nop 0\n\ts_nop 0\n\ts_nop 0\n\ts_nop 0\n\ts_nop 0\n\ts_nop 0\n\ts_nop 0\n\ts_nop 0\n\ts_nop 0\n\ts_nop 0\n\ts_nop 0\n\ts_nop 0\n\ts_nop 0\n\ts_nop 0\n\ts_nop 0\n\ts_nop 0\n\ts_nop 0\n\ts_nop 0\n\ts_nop 0\n\ts_nop 0\n\ts_nop 0\n\ts_nop 0\n\ts_nop 0\n\ts_nop 0\n\ts_nop 0\n\ts_nop 0\n\ts_nop 0\n\ts_nop 0\n\ts_nop 0\n\ts_nop 0\n\ts_nop 0\n\ts_nop 0\n\ts_nop 0\n\ts_nop 0\n\ts_nop 0\n\ts_nop 0\n\ts_nop 0\n\ts_nop 0\n\ts_nop 0\n\ts_nop 0\n\ts_nop 0\n\ts_nop 0\n\ts_nop 0\n\ts_nop 0\n\ts_nop 0\n\ts_nop 0\n\ts_nop 0\n\ts_nop 0\n\ts_nop 0\n\ts_nop 0\n\ts_nop 0\n\ts_nop 0\n\ts_nop 0\n\ts_nop 0\n\ts_nop 0\n\ts_nop 0\n\ts_nop 0\n\ts_nop 0\n\ts_nop 0\n\ts_nop 0\n\ts_nop 0\n\ts_nop 0\n\ts_nop 0\n\ts_nop 0\n\ts_nop 0\n\ts_nop 0\n\ts_nop 0\n\ts_nop 0\n\ts_nop 0\n\ts_nop 0\n\ts_nop 0\n\ts_nop 0\n\ts_nop 0\n\ts_nop 0\n\ts_nop 0\n\ts_nop 0\n\ts_nop 0\n\ts_nop 0\n\ts_nop 0\n\ts_nop 0\n\ts_nop 0\n\ts_nop 0\n\ts_nop 0\n\ts_nop 0\n\ts_nop 0\n\ts_nop 0\n\ts_nop 0\n\ts_nop 0\n\ts_nop 0\n\ts_nop 0\n\ts_nop 0\n\ts_nop 0\n\ts_nop 0\n\ts_nop 0\n\ts_nop 0\n\ts_nop 0\n\ts_nop 0\n\ts_nop 0\n\ts_nop 0\n\ts_nop 0\n\ts_nop 0\n\ts_nop 0\n\ts_nop 0\n\ts_nop 0\n\ts_nop 0\n\ts_nop 0\n\ts_nop 0\n\ts_nop 0\n\ts_nop 0\n\ts_nop 0\n\ts_nop 0\n\ts_nop 0\n\ts_nop 0\n\ts_nop 0\n\ts_nop 0\n\ts_nop 0\n\ts_nop 0\n\ts_nop 0\n\ts_nop 0\n\ts_nop 0\n\ts_nop 0\n\ts_nop 0\n\ts_nop 0\n\ts_nop 0\n\ts_nop 0\n\ts_nop 0\n\ts_nop 0\n\ts_nop 0\n\ts_nop 0\n\ts_nop 0\n\ts_nop 0\n\ts_nop 0\n\ts_nop 0\n\ts_nop 0\n\ts_nop 0\n\ts_nop 0\n\ts_nop 0\n\ts_nop 0\n\ts_nop 0\n\ts_nop 0\n\ts_nop 0\n\ts_nop 0\n\ts_nop 0\n\ts_nop 0\n\ts_nop 0\n\ts_nop 0\n\ts_nop 0\n\ts_nop 0\n\ts_nop 0\n\ts_nop 0\n\ts_nop 0\n\ts_nop 0\n\ts_nop 0\n\ts_nop 0\n\ts_nop 0\n\ts_nop 0\n\ts_nop 0\n\ts_nop 0\n\ts_nop 0\n\ts_nop 0\n\ts_nop 0\n\ts_nop 0\n\ts_nop 0\n\ts_nop 0\n\ts_nop 0\n\ts_nop 0\n\ts_nop 0\n\ts_nop 0\n\ts_nop 0\n\ts_nop 0\n\ts_nop 0\n\ts_nop 0\n\ts_nop 0\n\ts_nop 0\n\ts_nop 0\n\ts_nop 0\n\ts_nop 0\n\ts_nop 0\n\ts_nop 0\n\ts_nop 0\n\ts_nop 0\n\ts_nop 0\n\ts_nop 0\n\ts_nop 0\n\ts_nop 0\n\ts_nop 0\n\ts_nop 0\n\ts_nop 0\n\ts_nop 0\n\ts_nop 0\n\ts_nop 0\n\ts_nop 0\n\ts_nop 0\n\ts_nop 0\n\ts_nop 0\n\ts_nop 0\n\ts_nop 0\n\ts_nop 0\n\ts_nop 0\n\ts_nop 0\n\ts_nop 0\n\ts_nop 0\n\ts_nop 0\n\ts_nop 0\n\ts_nop 0\n\ts_nop 0\n\ts_nop 0\n\ts_nop 0\n\ts_nop 0\n\ts_nop 0\n\ts_nop 0\n\ts_nop 0\n\ts_nop 0\n\ts_nop 0\n\ts_nop 0\n\ts_nop 0\n\ts_nop 0\n\ts_nop 0\n\ts_nop 0\n\ts_nop 0\n\ts_nop 0\n\ts_nop 0\n\ts_nop 0\n\ts_nop 0\n\ts_nop 0\n\ts_nop 0\n\ts_nop 0\n\ts_nop 0\n\ts_nop 0\n\ts_nop 0\n\ts_nop 0\n\ts_nop 0\n\ts_nop 0\n\ts_nop 0\n\ts_nop 0\n\ts_nop 0\n\ts_nop 0\n\ts_nop 0\n\ts_nop 0\n\ts_nop 0\n\ts_nop 0\n\ts_nop 0\n\ts_nop 0\n\ts_nop 0\n\ts_nop 0\n\ts_nop 0\n\ts_nop 0\n\ts_nop 0\n\ts_nop 0\n\ts_nop 0\n\ts_nop 0\n\ts_nop 0\n\ts_nop 0\n\ts_nop 0\n\ts_nop 0\n\ts_nop 0\n\ts_nop 0\n\ts_nop 0\n\ts_nop 0\n\ts_nop 0\n\ts_nop 0\n\ts_nop 0\n\ts_nop 0\n\ts_nop 0\n\ts_nop 0\n\ts_nop 0\n\ts_nop 0\n\ts_nop 0\n\ts_nop 0\n\ts_nop 0\n\ts_nop 0\n\ts_nop 0\n\ts_nop 0\n\ts_nop 0\n\ts_nop 0\n\ts_nop 0\n\ts_nop 0\n\ts_nop 0\n\ts_nop 0\n\ts_nop 0\n\ts_nop 0\n\ts_nop 0\n\ts_nop 0\n\ts_nop 0\n\ts_nop 0\n\ts_nop 0\n\ts_nop 0\n\ts_nop 0\n\ts_nop 0\n\ts_nop 0\n\ts_nop 0\n\ts_nop 0\n\ts_nop 0\n\ts_nop 0\n\ts_nop 0\n\ts_nop 0\n\ts_nop 0\n\ts_nop 0\n\ts_nop 0\n\ts_nop 0\n\ts_nop 0\n\ts_nop 0\n\ts_nop 0\n\ts_nop 0\n\ts_nop 0\n\ts_nop 0\n\ts_nop 0\n\ts_nop 0\n\ts_nop 0\n\ts_nop 0\n\ts_nop 0\n\ts_nop 0\n\ts_nop 0\n\ts_nop 0\n\ts_nop 0\n\ts_nop 0\n\ts_nop 0\n\ts_nop 0\n\ts_nop 0\n\ts_nop 0\n\ts_nop 0\n\ts_nop 0\n\ts_nop 0\n\ts_nop 0\n\ts_nop 0\n\ts_nop 0\n\ts_nop 0\n\ts_nop 0\n\ts_nop 0\n\ts_nop 0\n\ts_nop 0\n\ts_nop 0\n\ts_nop 0\n\ts_nop 0\n\ts_nop 0\n\ts_nop 0\n\ts_nop 0\n\ts_nop 0\n\ts_nop 0\n\ts_nop 0\n\ts_nop 0\n\ts_nop 0\n\ts_nop 0\n\ts_nop 0\n\ts_nop 0\n\ts_nop 0\n\ts_nop 0\n\ts_nop 0\n\ts_nop 0\n\ts_nop 0\n\ts_nop 0\n\ts_nop 0\n\ts_nop 0\n\ts_nop 0\n\ts_nop 0\n\ts_nop 0\n\ts_nop 0\n\ts_nop 0\n\ts_nop 0\n\ts_nop 0\n\ts_nop 0\n\ts_nop 0\n\ts_nop 0\n\ts_nop 0\n\ts_nop 0\n\ts_nop 0\n\ts_nop 0\n\ts_nop 0\n\ts_nop 0\n\ts_nop 0\n\ts_nop 0\n\ts_nop 0\n\ts_nop 0\n\ts_nop 0\n\ts_nop 0\n\ts_nop 0\n\ts_nop 0\n\ts_nop 0\n\ts_nop 0\n\ts_nop 0\n\ts_nop 0\n\ts_nop 0\n\ts_nop 0\n\ts_nop 0\n\ts_nop 0\n\ts_nop 0\n\ts_nop 0\n\ts_nop 0\n\ts_nop 0\n\ts_nop 0\n\ts_nop 0\n\ts_nop 0\n\ts_nop 0\n\ts_nop 0\n\ts_nop 0\n\ts_nop 0\n\ts_nop 0\n\ts_nop 0\n\ts_nop 0\n\ts_nop 0\n\ts_nop 0\n\ts_nop 0\n\ts_nop 0\n\ts_nop 0\n\ts_nop 0\n\ts_nop 0\n\ts_nop 0\n\ts_nop 0\n\ts_nop 0\n\ts_nop 0\n\ts_nop 0\n\ts_nop 0\n\ts_nop 0\n\ts_nop 0\n\ts_nop 0\n\ts_nop 0\n\ts_nop 0\n\ts_nop 0\n\ts_nop 0\n\ts_nop 0\n\ts_nop 0\n\ts_nop 0\n\ts_nop 0\n\ts_nop 0\n\ts_nop 0\n\ts_nop 0\n\ts_nop 0\n\ts_nop 0\n\ts_nop 0\n\ts_nop 0\n\ts_nop 0\n\ts_nop 0\n\ts_nop 0\n\ts_nop 0\n\ts_nop 0\n\ts_nop 0\n\ts_nop 0\n\ts_nop 0\n\ts_nop 0" ::: "memory");
    if (p) *p = 0;
}
constexpr int NWAVES = 8, NTHR = 512;
constexpr int LDS_BYTES = 147456;
constexpr int RING_BYTES = 131072;
constexpr int MISC_OFF = LDS_BYTES - 256;
constexpr int GRID = 256;
constexpr int RPB = M / GRID;
static_assert(RPB == 64, "thin phases assume 64 rows per workgroup");

struct Args { const void* in[26]; float* out; unsigned char* ws; int ph_lo, ph_hi, li, pad; };
struct Frame {
    LAS unsigned char* lds;
    int tid, lane, wave, blk;
    const float *x, *c; const int* pos; const float *ada_w, *ada_b, *mix_pre_g, *mix_post_g, *ffn_pre_g, *ffn_post_g;
    const float *e_w_in, *e_pool_w, *e_pool_scale, *e_w_out, *e_wg, *e_wu, *e_wd;
    const float *o_w_in, *o_conv_w, *o_a_log, *o_dt_bias, *o_norm_g, *o_w_out, *o_router, *o_mg, *o_mu, *o_md;
    float* out; unsigned char* ws;
};
__device__ __forceinline__ void frame_init(Frame& F, const Args& a, LAS unsigned char* lds) {
    F.lds = lds; F.tid = threadIdx.x; F.lane = F.tid & 63; F.wave = __builtin_amdgcn_readfirstlane(F.tid >> 6); F.blk = blockIdx.x;
    F.x = (const float*)a.in[0]; F.c = (const float*)a.in[1]; F.pos = (const int*)a.in[2]; F.ada_w = (const float*)a.in[3]; F.ada_b = (const float*)a.in[4];
    F.mix_pre_g = (const float*)a.in[5]; F.mix_post_g = (const float*)a.in[6]; F.ffn_pre_g = (const float*)a.in[7]; F.ffn_post_g = (const float*)a.in[8];
    F.e_w_in = (const float*)a.in[9]; F.e_pool_w = (const float*)a.in[10]; F.e_pool_scale = (const float*)a.in[11]; F.e_w_out = (const float*)a.in[12];
    F.e_wg = (const float*)a.in[13]; F.e_wu = (const float*)a.in[14]; F.e_wd = (const float*)a.in[15];
    F.o_w_in = (const float*)a.in[16]; F.o_conv_w = (const float*)a.in[17]; F.o_a_log = (const float*)a.in[18]; F.o_dt_bias = (const float*)a.in[19];
    F.o_norm_g = (const float*)a.in[20]; F.o_w_out = (const float*)a.in[21]; F.o_router = (const float*)a.in[22];
    F.o_mg = (const float*)a.in[23]; F.o_mu = (const float*)a.in[24]; F.o_md = (const float*)a.in[25];
    F.out = a.out; F.ws = a.ws;
}
#define WSP(T_, off) ((T_*)(F.ws + (off)))

__device__ __forceinline__ void ld_row_f32(const float* p, int lane, f32x4 (&v)[4]) {
    const f32x4* q = (const f32x4*)p + lane;
#pragma unroll
    for (int j = 0; j < 4; ++j) v[j] = q[64 * j];
}
__device__ __forceinline__ void ld_row_f32_nt(const float* p, int lane, f32x4 (&v)[4]) {
    const f32x4* q = (const f32x4*)p + lane;
#pragma unroll
    for (int j = 0; j < 4; ++j) v[j] = __builtin_nontemporal_load(q + 64 * j);
}
__device__ __forceinline__ void ld_row_bf16(const bf16* p, int lane, f32x4 (&v)[4]) {
    const v2u* q = (const v2u*)p + lane;
#pragma unroll
    for (int j = 0; j < 4; ++j) { const v2u w = q[64 * j]; v[j] = (f32x4){bflo(w.x), bfhi(w.x), bflo(w.y), bfhi(w.y)}; }
}
__device__ __forceinline__ void st_row_f32(float* p, int lane, const f32x4 (&v)[4]) {
    f32x4* q = (f32x4*)p + lane;
#pragma unroll
    for (int j = 0; j < 4; ++j) q[64 * j] = v[j];
}
__device__ __forceinline__ void st_row_bf16(bf16* p, int lane, const f32x4 (&v)[4]) {
    v2u* q = (v2u*)p + lane;
#pragma unroll
    for (int j = 0; j < 4; ++j) { v2u w; w.x = pk2(v[j].x, v[j].y); w.y = pk2(v[j].z, v[j].w); q[64 * j] = w; }
}
__device__ __forceinline__ float row_rinv(const f32x4 (&v)[4]) {
    float s = 0.f;
#pragma unroll
    for (int j = 0; j < 4; ++j) s += (v[j].x * v[j].x + v[j].y * v[j].y) + (v[j].z * v[j].z + v[j].w * v[j].w);
    return 1.0f / sqrtf(wave_sum(s) * (1.f / D) + EPS);
}
__device__ __forceinline__ void row_mod(const f32x4 (&v)[4], float r, const float* g, const float* sc, const float* sh, int lane, f32x4 (&h)[4]) {
    f32x4 gv[4], scv[4], shv[4]; ld_row_f32(g, lane, gv); ld_row_f32(sc, lane, scv); ld_row_f32(sh, lane, shv);
#pragma unroll
    for (int j = 0; j < 4; ++j) h[j] = v[j] * r * gv[j] * (scv[j] + 1.0f) + shv[j];
}
__device__ __forceinline__ void row_resid(const f32x4 (&xi)[4], const f32x4 (&y)[4], float ry, const float* pg, const float* gt, int lane, f32x4 (&xo)[4]) {
    f32x4 gv[4], gtv[4]; ld_row_f32(pg, lane, gv); ld_row_f32(gt, lane, gtv);
#pragma unroll
    for (int j = 0; j < 4; ++j) xo[j] = xi[j] + gtv[j] * (y[j] * ry * gv[j]);
}
__device__ __forceinline__ void row_mod2(const f32x4 (&v)[4], float r, const f32x4 (&ga)[4], const f32x4 (&shv)[4], f32x4 (&h)[4]) {
#pragma unroll
    for (int j = 0; j < 4; ++j) h[j] = (v[j] * r) * ga[j] + shv[j];
}
__device__ __forceinline__ void row_resid2(const f32x4 (&xi)[4], const f32x4 (&y)[4], float ry, const f32x4 (&gp)[4], f32x4 (&xo)[4]) {
#pragma unroll
    for (int j = 0; j < 4; ++j) xo[j] = xi[j] + gp[j] * (y[j] * ry);
}
__device__ __forceinline__ void row_mod_r(const f32x4 (&v)[4], float r, const f32x4 (&gv)[4], const f32x4 (&scv)[4], const f32x4 (&shv)[4], f32x4 (&h)[4]) {
#pragma unroll
    for (int j = 0; j < 4; ++j) h[j] = v[j] * r * gv[j] * (scv[j] + 1.0f) + shv[j];
}
__device__ __forceinline__ void row_resid_r(const f32x4 (&xi)[4], const f32x4 (&y)[4], float ry, const f32x4 (&gv)[4], const f32x4 (&gtv)[4], f32x4 (&xo)[4]) {
#pragma unroll
    for (int j = 0; j < 4; ++j) xo[j] = xi[j] + gtv[j] * (y[j] * ry * gv[j]);
}
__device__ __forceinline__ void ld_row_bf16_raw(const bf16* p, int lane, v2u (&w)[4]) {
    const v2u* q = (const v2u*)p + lane;
#pragma unroll
    for (int j = 0; j < 4; ++j) w[j] = __builtin_nontemporal_load(q + 64 * j);
}
__device__ __forceinline__ void cvt_row_bf16(const v2u (&w)[4], f32x4 (&v)[4]) {
#pragma unroll
    for (int j = 0; j < 4; ++j) v[j] = (f32x4){bflo(w[j].x), bfhi(w[j].x), bflo(w[j].y), bfhi(w[j].y)};
}
#define MODP(l, b, k) (WSP(const float, WS_MOD) + ((l) * 2 + (b)) * 6144 + (k) * 1024)

__device__ __forceinline__ void ph_mod_rope(Frame& F) {
    const int posv = F.pos[(F.blk * NTHR + F.tid) >> 3];
    LAS float* red = (LAS float*)F.lds;
    LAS float* cact = red + 1024;
    for (int i = F.tid; i < 2 * D; i += NTHR) cact[i] = silu_f(F.c[i]);
    __syncthreads();
    for (int u = F.blk; u < 192; u += GRID) {
        const int l = u / 96, n = (u % 96) * 64 + F.lane;
        const float* W = F.ada_w + (size_t)l * D * 6144 + n;
        const float bb = F.ada_b[l * 6144 + n];
        float a0 = 0.f, a1 = 0.f;
#pragma unroll 1
        for (int k0 = F.wave * 128; k0 < F.wave * 128 + 128; k0 += 32) {
            float wv[32];
#pragma unroll
            for (int q = 0; q < 32; ++q) wv[q] = __builtin_nontemporal_load(W + (size_t)(k0 + q) * 6144);
#pragma unroll
            for (int q = 0; q < 32; ++q) { a0 += cact[k0 + q] * wv[q]; a1 += cact[D + k0 + q] * wv[q]; }
        }
        red[(F.wave * 2 + 0) * 64 + F.lane] = a0; red[(F.wave * 2 + 1) * 64 + F.lane] = a1;
        __syncthreads();
        if (F.wave == 0) {
            float s0 = 0.f, s1 = 0.f;
#pragma unroll
            for (int w = 0; w < 8; ++w) { s0 += red[(w * 2 + 0) * 64 + F.lane]; s1 += red[(w * 2 + 1) * 64 + F.lane]; }
            float* MOD = WSP(float, WS_MOD);
            MOD[(l * 2 + 0) * 6144 + n] = s0 + bb; MOD[(l * 2 + 1) * 6144 + n] = s1 + bb;
        }
        __syncthreads();
    }
    const float invf[8] = {1.0f, 0.1939227432012558f, 0.03760603070259094f, 0.007292664609849453f, 0.0014142135623842478f, 0.00027424818836152554f, 5.318296098266728e-05f, 1.0313386155758053e-05f};
    float* ROPE = WSP(float, WS_ROPE);
    for (int idx = F.blk * NTHR + F.tid; idx < M * 8; idx += GRID * NTHR) {
        const int m = idx >> 3, i = idx & 7;
        float fi = invf[0];
#pragma unroll
        for (int q = 1; q < 8; ++q) fi = (i == q) ? invf[q] : fi;
        const float ang = (float)posv * fi;
        const double a = (double)ang, n2 = rint(a * 0.15915494309189535), r = a - n2 * 6.283185307179586;
        const float rf = (float)r;
        ROPE[m * 16 + i] = cosf(rf); ROPE[m * 16 + 8 + i] = sinf(rf);
    }
}

__device__ __forceinline__ void ph_norm_a(Frame& F) {
    bf16* H = WSP(bf16, WS_H);
    const int m0 = F.blk * RPB + F.wave * 8, b = m0 / T;
    f32x4 gv[4], scv[4], shv[4]; ld_row_f32(F.mix_pre_g, F.lane, gv); ld_row_f32(MODP(0, b, 1), F.lane, scv); ld_row_f32(MODP(0, b, 0), F.lane, shv);
#pragma unroll
    for (int j = 0; j < 4; ++j) gv[j] = gv[j] * (scv[j] + 1.0f);
    f32x4 vn[4]; ld_row_f32_nt(F.x + (size_t)m0 * D, F.lane, vn);
#pragma unroll 1
    for (int i = 0; i < 8; ++i) {
        const int m = m0 + i;
        f32x4 v[4], h[4];
#pragma unroll
        for (int j = 0; j < 4; ++j) v[j] = vn[j];
        if (i < 7) ld_row_f32_nt(F.x + (size_t)(m + 1) * D, F.lane, vn);
        const float r = row_rinv(v);
        row_mod2(v, r, gv, shv, h);
        st_row_bf16(H + (size_t)m * D, F.lane, h);
    }
}
template <int KIND> __device__ __forceinline__ void ph_norm_mid(Frame& F) {
    const bf16* Y = WSP(const bf16, WS_Y);
    bf16* H = WSP(bf16, WS_H);
    LAS float* WT = (LAS float*)F.lds;
    LAS int* selE = (LAS int*)(F.lds + 65536);
    LAS int* selR = (LAS int*)(F.lds + 65536 + 512);
    LAS int* cntE = (LAS int*)(F.lds + 65536 + 1024);
    const int mrow0 = F.blk * RPB + F.wave * 8, b = mrow0 / T;
    const bf16* xsb = (const bf16*)F.out; bf16* xdb = (KIND == 2) ? WSP(bf16, WS_MIX) : (bf16*)F.out;
    f32x4 pgv[4], gtv[4], g2v[4], scv[4], shv[4];
    if (KIND == 0) { ld_row_f32(F.mix_post_g, F.lane, pgv); ld_row_f32(MODP(0, b, 2), F.lane, gtv); ld_row_f32(F.ffn_pre_g, F.lane, g2v); ld_row_f32(MODP(0, b, 4), F.lane, scv); ld_row_f32(MODP(0, b, 3), F.lane, shv); }
    if (KIND == 1) { ld_row_f32(F.ffn_post_g, F.lane, pgv); ld_row_f32(MODP(0, b, 5), F.lane, gtv); ld_row_f32(F.mix_pre_g + D, F.lane, g2v); ld_row_f32(MODP(1, b, 1), F.lane, scv); ld_row_f32(MODP(1, b, 0), F.lane, shv); }
    if (KIND == 2) { ld_row_f32(F.mix_post_g + D, F.lane, pgv); ld_row_f32(MODP(1, b, 2), F.lane, gtv); ld_row_f32(F.ffn_pre_g + D, F.lane, g2v); ld_row_f32(MODP(1, b, 4), F.lane, scv); ld_row_f32(MODP(1, b, 3), F.lane, shv); }
#pragma unroll
    for (int j = 0; j < 4; ++j) { pgv[j] = pgv[j] * gtv[j]; g2v[j] = g2v[j] * (scv[j] + 1.0f); }
    f32x4 xnx[4]; v2u xnb[4], ynx[4];
    if (KIND == 0) ld_row_f32_nt(F.x + (size_t)mrow0 * D, F.lane, xnx); else ld_row_bf16_raw(xsb + (size_t)mrow0 * D, F.lane, xnb);
    ld_row_bf16_raw(Y + (size_t)mrow0 * D, F.lane, ynx);
    if (KIND == 1) { float wt[32];
#pragma unroll
        for (int q = 0; q < 32; ++q) { const int i = F.tid + NTHR * q, k = i >> 4, j = i & 15; wt[q] = F.o_w_in[(size_t)k * L1N + 4096 + j]; }
#pragma unroll
        for (int q = 0; q < 32; ++q) { const int i = F.tid + NTHR * q, k = i >> 4, j = i & 15; WT[j * D + k] = wt[q]; }
        __syncthreads(); }
    if (KIND == 2) { float wt[16];
#pragma unroll
        for (int q = 0; q < 16; ++q) { const int i = F.tid + NTHR * q, k = i >> 3, j = i & 7; wt[q] = F.o_router[k * 8 + j]; }
#pragma unroll
        for (int q = 0; q < 16; ++q) { const int i = F.tid + NTHR * q, k = i >> 3, j = i & 7; WT[j * D + k] = wt[q]; }
        __syncthreads(); }
    auto body = [&](const int i, f32x4 (&h)[4]) __attribute__((always_inline)) {
        const int lt = F.wave * 8 + i, m = F.blk * RPB + lt;
        f32x4 xi[4], y[4], xo[4];
        if (KIND == 0) {
#pragma unroll
            for (int j = 0; j < 4; ++j) xi[j] = xnx[j];
        } else cvt_row_bf16(xnb, xi);
        cvt_row_bf16(ynx, y);
        if (i < 7) { if (KIND == 0) ld_row_f32_nt(F.x + (size_t)(m + 1) * D, F.lane, xnx); else ld_row_bf16_raw(xsb + (size_t)(m + 1) * D, F.lane, xnb);
            ld_row_bf16_raw(Y + (size_t)(m + 1) * D, F.lane, ynx); }
        const float ry = row_rinv(y);
        row_resid2(xi, y, ry, pgv, xo);
        { v2u* q_ = (v2u*)(xdb + (size_t)m * D) + F.lane;
#pragma unroll
          for (int j = 0; j < 4; ++j) { v2u w_; w_.x = pk2(xo[j].x, xo[j].y); w_.y = pk2(xo[j].z, xo[j].w); __builtin_nontemporal_store(w_, q_ + 64 * j); } }
        const float r = row_rinv(xo);
        row_mod2(xo, r, g2v, shv, h);
        if (KIND == 2) { unsigned* q = WSP(unsigned, WS_H2) + (size_t)m * (D / 4) + F.lane;
#pragma unroll
            for (int j = 0; j < 4; ++j) q[64 * j] = pk4f8(h[j].x, h[j].y, h[j].z, h[j].w); }
        else st_row_bf16(H + (size_t)m * D, F.lane, h);
    };
    _Pragma("unroll 1") for (int i4 = 0; i4 < 8; i4 += 4) {
        f32x4 hb[4][4];
        body(i4, hb[0]); body(i4 + 1, hb[1]); body(i4 + 2, hb[2]); body(i4 + 3, hb[3]);
        const int lt0 = F.wave * 8 + i4, mb = F.blk * RPB + lt0;
        const int lq = F.lane >> 4, lj = F.lane & 15, rq = RED4_ROW(lq);
        if (KIND == 1) {
            float* BL = WSP(float, WS_BL);
            float mine = 0.f;
#pragma unroll 1
            for (int j = 0; j < 16; ++j) {
                f32x4 w[4];
#pragma unroll
                for (int jj = 0; jj < 4; ++jj) w[jj] = *(const LAS f32x4*)(WT + j * D + 4 * F.lane + 256 * jj);
                const float t = red4(dot16(hb[0], w), dot16(hb[1], w), dot16(hb[2], w), dot16(hb[3], w));
                mine = (lj == j) ? t : mine;
            }
            BL[(size_t)(mb + rq) * 16 + lj] = mine;
        }
        if (KIND == 2) {
            float lg[8];
#pragma unroll
            for (int j = 0; j < 8; ++j) {
                f32x4 w[4];
#pragma unroll
                for (int jj = 0; jj < 4; ++jj) w[jj] = *(const LAS f32x4*)(WT + j * D + 4 * F.lane + 256 * jj);
                lg[j] = red4(dot16(hb[0], w), dot16(hb[1], w), dot16(hb[2], w), dot16(hb[3], w));
            }
            int e0 = 0; float v0 = lg[0];
#pragma unroll
            for (int j = 1; j < 8; ++j) { const bool gt = lg[j] > v0; v0 = gt ? lg[j] : v0; e0 = gt ? j : e0; }
            int e1 = -1; float v1 = -3.0e38f;
#pragma unroll
            for (int j = 0; j < 8; ++j) { const bool gt = (j != e0) && (lg[j] > v1); v1 = gt ? lg[j] : v1; e1 = gt ? j : e1; }
            const float w0 = 1.f / (1.f + __expf(v1 - v0)), w1 = 1.f - w0;
            if (lj == 0) {
                unsigned* R = WSP(unsigned, WS_ROUTE) + (size_t)(mb + rq) * 8;
                R[0] = (unsigned)e0; R[1] = (unsigned)e1; R[2] = __builtin_bit_cast(unsigned, w0); R[3] = __builtin_bit_cast(unsigned, w1);
                selE[(lt0 + rq) * 2 + 0] = e0; selE[(lt0 + rq) * 2 + 1] = e1;
            }
        }
    }
    if (KIND == 2) {
        __syncthreads();
        int my = -1, rank = 0, cme = 0;
        if (F.tid < 2 * RPB) {
            my = selE[F.tid];
#pragma unroll
            for (int e = 0; e < 8; ++e) { const unsigned long long mk = __ballot(my == e); const int below = (int)__builtin_amdgcn_mbcnt_hi((unsigned)(mk >> 32), __builtin_amdgcn_mbcnt_lo((unsigned)mk, 0u));
                rank = (my == e) ? below : rank; cme = (F.lane == e) ? (int)__popcll(mk) : cme; }
            if (F.tid < 8) cntE[F.tid] = cme;
        }
        __syncthreads();
        if (F.tid < 2 * RPB) {
            if (F.tid >= 64) { rank += cntE[my]; if (F.lane < 8) WSP(int, WS_CTL)[CW_CNT + F.blk * 8 + F.lane] = cntE[F.lane] + cme; }
            const int lt = F.tid >> 1, k = F.tid & 1; WSP(unsigned, WS_ROUTE)[(size_t)(F.blk * RPB + lt) * 8 + 4 + k] = (unsigned)rank;
        }
    }
}
__device__ __forceinline__ void ph_gated_norm(Frame& F) {
    const float* O = WSP(const float, WS_O); const bf16* GT = WSP(const bf16, WS_GATE); bf16* MIX = WSP(bf16, WS_MIX);
    const f32x4 ng = *((const f32x4*)F.o_norm_g + (F.lane & 31));
    const int m0 = F.blk * RPB + F.wave * 8;
    f32x4 on[4]; v2u gn[4]; ld_row_f32(O + (size_t)m0 * D, F.lane, on); ld_row_bf16_raw(GT + (size_t)m0 * D, F.lane, gn);
    _Pragma("unroll 1") for (int i = 0; i < 8; ++i) {
        const int m = m0 + i;
        f32x4 o[4], g[4], r[4];
#pragma unroll
        for (int j = 0; j < 4; ++j) o[j] = on[j];
        cvt_row_bf16(gn, g);
        if (i < 7) { ld_row_f32(O + (size_t)(m + 1) * D, F.lane, on); ld_row_bf16_raw(GT + (size_t)(m + 1) * D, F.lane, gn); }
#pragma unroll
        for (int j = 0; j < 4; ++j) {
            float s = (o[j].x * o[j].x + o[j].y * o[j].y) + (o[j].z * o[j].z + o[j].w * o[j].w);
#pragma unroll
            for (int q = 1; q < 32; q <<= 1) s += __shfl_xor(s, q);
            const float rr = 1.0f / sqrtf(s * (1.f / DHD) + EPS);
            r[j].x = o[j].x * rr * ng.x * silu_f(g[j].x); r[j].y = o[j].y * rr * ng.y * silu_f(g[j].y);
            r[j].z = o[j].z * rr * ng.z * silu_f(g[j].z); r[j].w = o[j].w * rr * ng.w * silu_f(g[j].w);
        }
        st_row_bf16(MIX + (size_t)m * D, F.lane, r);
    }
}
__device__ __forceinline__ void ph_moe_gather(Frame& F) {
    LAS int* cnt = (LAS int*)F.lds;
    LAS int* tot = cnt + GRID * 8;
    LAS int* myo = tot + 8; LAS int* tp = myo + 8;
    const int* C = WSP(const int, WS_CTL) + CW_CNT;
#define GB_BAR() do { asm volatile("s_waitcnt lgkmcnt(0)" ::: "memory"); __builtin_amdgcn_s_barrier(); asm volatile("" ::: "memory"); } while (0)
    int cr[4];
#pragma unroll
    for (int k = 0; k < 4; ++k) cr[k] = C[F.tid + NTHR * k];
    const unsigned char* H2 = F.ws + WS_H2; unsigned char* AS = F.ws + WS_ASORT;
    const int m0 = F.blk * RPB + F.wave * 8;
    v4u rw0[8], rw1[8], dat[8];
#pragma unroll
    for (int i = 0; i < 8; ++i) { const v4u* R = (const v4u*)(WSP(const unsigned, WS_ROUTE) + (size_t)(m0 + i) * 8); rw0[i] = R[0]; rw1[i] = R[1]; dat[i] = __builtin_nontemporal_load((const v4u*)(H2 + (size_t)(m0 + i) * D) + F.lane); }
#pragma unroll
    for (int k = 0; k < 4; ++k) cnt[F.tid + NTHR * k] = cr[k];
    GB_BAR();
    { const int e = F.wave, l = F.lane;
      const int c0 = cnt[(4 * l + 0) * 8 + e], c1 = cnt[(4 * l + 1) * 8 + e], c2 = cnt[(4 * l + 2) * 8 + e], c3 = cnt[(4 * l + 3) * 8 + e], s4 = (c0 + c1) + (c2 + c3);
      int inc = s4;
#define DPP_ADDI(v, ctrl) v += __builtin_amdgcn_mov_dpp(v, ctrl, 0xf, 0xf, true)
      DPP_ADDI(inc, 0x111); DPP_ADDI(inc, 0x112); DPP_ADDI(inc, 0x114); DPP_ADDI(inc, 0x118);
#undef DPP_ADDI
      { const int t0 = __builtin_amdgcn_readlane(inc, 15), t1 = __builtin_amdgcn_readlane(inc, 31), t2 = __builtin_amdgcn_readlane(inc, 47), rr = l >> 4; inc += (rr >= 1 ? t0 : 0) + (rr >= 2 ? t1 : 0) + (rr >= 3 ? t2 : 0); }
      const int total = __builtin_amdgcn_readlane(inc, 63), r = F.blk & 3;
      const int mol = (inc - s4) + (r > 0 ? c0 : 0) + (r > 1 ? c1 : 0) + (r > 2 ? c2 : 0), mo = __builtin_amdgcn_readlane(mol, F.blk >> 2);
      if (l == 0) { tot[e] = total; myo[e] = mo; } }
    GB_BAR();
    if (F.tid < 9) { int p_ = 0; for (int e = 0; e < 8; ++e) p_ += (e < F.tid) ? ((tot[e] + 255) >> 8) : 0; tp[F.tid] = p_; }
    GB_BAR();
#undef GB_BAR
    if (F.blk == 0 && F.tid < 9) WSP(int, WS_CTL)[CW_TP + F.tid] = tp[F.tid];
    if (F.tid < 9) ((LAS int*)(F.lds + MISC_OFF + 128))[F.tid] = tp[F.tid];
#pragma unroll
    for (int i = 0; i < 8; ++i) {
        const int m = m0 + i;
        const int e0 = (int)rw0[i].x, e1 = (int)rw0[i].y, r0 = (int)rw1[i].x, r1 = (int)rw1[i].y;
        const int d0 = tp[e0] * 256 + myo[e0] + r0, d1 = tp[e1] * 256 + myo[e1] + r1;
        if (F.lane == 0) { unsigned* R = WSP(unsigned, WS_ROUTE) + (size_t)m * 8; R[6] = (unsigned)d0; R[7] = (unsigned)d1; }
        *((v4u*)(AS + (size_t)d0 * D) + F.lane) = dat[i]; *((v4u*)(AS + (size_t)d1 * D) + F.lane) = dat[i];
    }
}
__device__ __forceinline__ void ys_tail_add(const bf16* YP, int d, int lane, f32x4 (&y)[4]) {
    const bf16* p = YP + (size_t)(__builtin_amdgcn_readfirstlane(d) - 32768) * D;
    _Pragma("unroll 1") for (int q = 0; q < 6; q += 3) {
        v2u t0[4], t1[4], t2[4]; ld_row_bf16_raw(p + (size_t)q * 2048 * D, lane, t0); ld_row_bf16_raw(p + (size_t)(q + 1) * 2048 * D, lane, t1); ld_row_bf16_raw(p + (size_t)(q + 2) * 2048 * D, lane, t2);
        f32x4 f0[4], f1[4], f2[4]; cvt_row_bf16(t0, f0); cvt_row_bf16(t1, f1); cvt_row_bf16(t2, f2);
#pragma unroll
        for (int j = 0; j < 4; ++j) y[j] += (f0[j] + f1[j]) + f2[j];
    }
}
__device__ __forceinline__ void ph_final(Frame& F) {
    const bf16* YS = WSP(const bf16, WS_YS); const bf16* YP = WSP(const bf16, WS_YSP);
    const int m0 = F.blk * RPB + F.wave * 8, b = m0 / T;
    const unsigned rwv = WSP(const unsigned, WS_ROUTE)[(size_t)m0 * 8 + F.lane];
    f32x4 pgv[4], gtv[4]; ld_row_f32(F.ffn_post_g + D, F.lane, pgv); ld_row_f32(MODP(1, b, 5), F.lane, gtv);
#pragma unroll
    for (int j = 0; j < 4; ++j) pgv[j] = pgv[j] * gtv[j];
    const bf16* X3 = WSP(const bf16, WS_MIX);
#define RW(i_, f_) __builtin_amdgcn_readlane((int)rwv, (i_) * 8 + (f_))
    v2u xn[4], y0n[4], y1n[4]; int d0n = RW(0, 6), d1n = RW(0, 7);
    ld_row_bf16_raw(X3 + (size_t)m0 * D, F.lane, xn); ld_row_bf16_raw(YS + (size_t)d0n * D, F.lane, y0n); ld_row_bf16_raw(YS + (size_t)d1n * D, F.lane, y1n);
    _Pragma("unroll 1") for (int i = 0; i < 8; ++i) {
        const int m = m0 + i;
        f32x4 xi[4], y0[4], y1[4], y[4], xo[4]; const float w0 = __builtin_bit_cast(float, RW(i, 2)), w1 = __builtin_bit_cast(float, RW(i, 3)); const int d0 = d0n, d1 = d1n;
        cvt_row_bf16(xn, xi);
        cvt_row_bf16(y0n, y0); cvt_row_bf16(y1n, y1);
        if (i < 7) { d0n = RW(i + 1, 6); d1n = RW(i + 1, 7);
            ld_row_bf16_raw(X3 + (size_t)(m + 1) * D, F.lane, xn); ld_row_bf16_raw(YS + (size_t)d0n * D, F.lane, y0n); ld_row_bf16_raw(YS + (size_t)d1n * D, F.lane, y1n); }
        if (d0 >= 32768) ys_tail_add(YP, d0, F.lane, y0);
        if (d1 >= 32768) ys_tail_add(YP, d1, F.lane, y1);
#pragma unroll
        for (int j = 0; j < 4; ++j) y[j] = y0[j] * w0 + y1[j] * w1;
        const float ry = row_rinv(y);
        row_resid2(xi, y, ry, pgv, xo);
        { f32x4* q_ = (f32x4*)(F.out + (size_t)m * D) + F.lane;
#pragma unroll
          for (int j = 0; j < 4; ++j) __builtin_nontemporal_store(xo[j], q_ + 64 * j); }
    }
#undef RW
}
namespace pg8 {
#define PG8_LAS __attribute__((address_space(3)))
typedef unsigned short bf16_t;
typedef unsigned u32x4 __attribute__((ext_vector_type(4)));
constexpr int BM = 256, BK = 64, HALF = 128, HTB = HALF * BK * 2  , STAGE_BYTES = 8 * HTB, NXCD = 8, WGM = 4;

__host__ __device__ __forceinline__ int lds_byte(int r, int c) { const int st = (r >> 4) * 2 + (c >> 5), rr = r & 15, cc = c & 31, ob = rr * 64 + cc * 2; return st * 1024 + (ob ^ (((ob >> 9) & 1) << 5)); }
__host__ __device__ __forceinline__ void stage_rc(int b, int& R, int& C) { const int st = b / 1024, sb = b % 1024, swz = sb ^ (((sb >> 9) & 1) << 5); R = (st >> 1) * 16 + swz / 64; C = (st & 1) * 32 + (swz % 64) / 2; }
__host__ __device__ __forceinline__ int perm32(int rho) { const int n = rho >> 4, i = rho & 15; return 8 * (i >> 2) + 4 * n + (i & 3); }

struct Unit { int pm, pn, ko, kq; };
struct Gemm { const void* A; const void* Bt; int M, N, K; };

struct StaticOrder {
    static constexpr bool SPLITK = false; static constexpr int NT_SPLIT = 0;
    int nM, nN, nwg, G, c;
    __host__ __device__ void init(int M, int N, int G_, int c_) { nM = M / BM; nN = N / BM; nwg = nM * nN; G = G_; c = c_; }
    __host__ __device__ bool next(int i, Unit& u) const {
        const long L = (long)i * G + c; if (L >= nwg) return false;
        int wgid = (int)L; { const int q = nwg / NXCD, r = nwg % NXCD, xcd = wgid % NXCD, off = wgid / NXCD; wgid = (xcd < r ? xcd * (q + 1) : r * (q + 1) + (xcd - r) * q) + off; }
        const int nig = WGM * nN, gid = wgid / nig, fm = gid * WGM, gsz = (nM - fm) < WGM ? (nM - fm) : WGM;
        u.pm = fm + ((wgid % nig) % gsz); u.pn = (wgid % nig) / gsz; return true;
    }
    __device__ __forceinline__ void a_ready(const Unit&) const {}
    __device__ __forceinline__ void done(const Unit&) const {}
};

__device__ __forceinline__ unsigned cvt_pk_bf16(float lo, float hi) { unsigned r; asm volatile("v_cvt_pk_bf16_f32 %0, %1, %2" : "=v"(r) : "v"(lo), "v"(hi)); return r; }
typedef int i32x8 __attribute__((ext_vector_type(8)));
__device__ __forceinline__ i32x8 cat16(bf16x8 a, bf16x8 b) { const u32x4 x = __builtin_bit_cast(u32x4, a), y = __builtin_bit_cast(u32x4, b); return (i32x8){(int)x[0], (int)x[1], (int)x[2], (int)x[3], (int)y[0], (int)y[1], (int)y[2], (int)y[3]}; }
template <class Epi, class Sched, bool ALIGN_EPI = false, bool SP2 = false, bool F8 = false>
__device__ __forceinline__ void gemm_phase(PG8_LAS unsigned char* lds, const Gemm g, const Sched& S, const Epi& E, const int tid0) {
    int tid_ = tid0; asm volatile("" : "+v"(tid_));
    const int tid = tid_, wid = __builtin_amdgcn_readfirstlane(tid >> 6), lane = tid & 63, wr = wid >> 2, wc = wid & 3, fr = lane & 15, fq = lane >> 4;
    const int K = g.K, RS = F8 ? K : 2 * K  , nt = RS / 128;
    unsigned voffA[2], voffB[2];
#pragma unroll
    for (int i = 0; i < 2; ++i) { int R, C; stage_rc(tid * 16 + i * 8192, R, C); const int Rb = Epi::PERM ? ((R & ~31) + perm32(R & 31)) : R;
        voffA[i] = (unsigned)(R * RS + C * 2); voffB[i] = (unsigned)(Rb * RS + C * 2); }
    const size_t kstep = (size_t)(BK * 2);
    const size_t hstep = (size_t)HALF * RS;
    const size_t tstep = 2 * hstep;
    const unsigned ldsw = (unsigned)wid * 1024u;
    const int aoff = lds_byte(wr * 64 + fr, fq * 8), boff = lds_byte(wc * 32 + fr, fq * 8);
#define PG8_SA(b, h) (((b) * 2 + (h)) * HTB)
#define PG8_SB(b, h) ((4 + (b) * 2 + (h)) * HTB)
#define PG8_STAGE(bufoff, gbase, voff) do { _Pragma("unroll") for (int _i = 0; _i < 2; ++_i) \
        __builtin_amdgcn_global_load_lds((const unsigned*)((const char*)(gbase) + (voff)[_i]), (PG8_LAS unsigned*)(lds + (bufoff) + ldsw + _i * 8192), 16, 0, 0); } while (0)
#define PG8_LD16(p) (*(const PG8_LAS bf16x8*)(p))
#define PG8_LDA(dst, b, h) do { _Pragma("unroll") for (int m = 0; m < 4; ++m) { if constexpr (F8) dst##8[m] = cat16(PG8_LD16(lds + PG8_SA(b, h) + aoff + m * 2048), PG8_LD16(lds + PG8_SA(b, h) + aoff + m * 2048 + 1024)); \
        else { _Pragma("unroll") for (int k = 0; k < 2; ++k) dst[m][k] = PG8_LD16(lds + PG8_SA(b, h) + aoff + m * 2048 + k * 1024); } } } while (0)
#define PG8_LDB(dst, b, h) do { _Pragma("unroll") for (int n = 0; n < 2; ++n) { if constexpr (F8) dst##8[n] = cat16(PG8_LD16(lds + PG8_SB(b, h) + boff + n * 2048), PG8_LD16(lds + PG8_SB(b, h) + boff + n * 2048 + 1024)); \
        else { _Pragma("unroll") for (int k = 0; k < 2; ++k) dst[n][k] = PG8_LD16(lds + PG8_SB(b, h) + boff + n * 2048 + k * 1024); } } } while (0)
#define PG8_MMA(ai, bj, At, Bt) do { __builtin_amdgcn_s_setprio(1); _Pragma("unroll") for (int m = 0; m < 4; ++m) _Pragma("unroll") for (int n = 0; n < 2; ++n) { \
        if constexpr (F8) asm volatile("v_mfma_f32_16x16x128_f8f6f4 %0, %1, %2, %0" : "+v"(acc[ai][bj][m][n]) : "v"(Bt##8[n]), "v"(At##8[m]));     \
        else { _Pragma("unroll") for (int k = 0; k < 2; ++k) acc[ai][bj][m][n] = __builtin_amdgcn_mfma_f32_16x16x32_bf16(Bt[n][k], At[m][k], acc[ai][bj][m][n], 0, 0, 0); } } __builtin_amdgcn_s_setprio(0); } while (0)
#define PG8_WAIT_V(n) asm volatile("s_waitcnt vmcnt(" #n ")" ::: "memory")
#define PG8_WAIT_L(n) asm volatile("s_waitcnt lgkmcnt(" #n ")" ::: "memory")
#define PG8_BAR __builtin_amdgcn_s_barrier()
#define PG8_SCHED __builtin_amdgcn_sched_barrier(0)
    Unit cur, nxt; int ui = 0;
    if (!S.next(0, cur)) return;
    f32x4 acc[2][2][4][2];
#pragma unroll
    for (int a = 0; a < 2; ++a)
#pragma unroll
        for (int b = 0; b < 2; ++b)
#pragma unroll
            for (int m = 0; m < 4; ++m)
#pragma unroll
                for (int n = 0; n < 2; ++n) acc[a][b][m][n] = (f32x4){0.f, 0.f, 0.f, 0.f};
    bf16x8 At[4][2], B0[2][2], B1[2][2]; i32x8 At8[4], B08[2], B18[2];
    const char* cA = (const char*)g.A + (size_t)cur.pm * tstep; const char* cB = (const char*)g.Bt + (size_t)cur.pn * tstep;
    if constexpr (Sched::SPLITK) { cA += cur.ko; cB += cur.ko; }
    S.a_ready(cur);
    if constexpr (SP2) {
        PG8_STAGE(PG8_SB(0, 0), cB, voffB); PG8_STAGE(PG8_SB(0, 1), cB + hstep, voffB); PG8_STAGE(PG8_SA(0, 0), cA, voffA); PG8_STAGE(PG8_SA(0, 1), cA + hstep, voffA);
        if (wr == 1) PG8_BAR;
        PG8_WAIT_V(2); PG8_BAR;
        PG8_STAGE(PG8_SB(1, 0), cB + kstep, voffB); PG8_STAGE(PG8_SA(1, 0), cA + kstep, voffA); PG8_STAGE(PG8_SB(1, 1), cB + hstep + kstep, voffB);
        PG8_WAIT_V(6); PG8_BAR;
    } else {
        PG8_STAGE(PG8_SB(0, 0), cB, voffB); PG8_STAGE(PG8_SA(0, 0), cA, voffA); PG8_STAGE(PG8_SB(0, 1), cB + hstep, voffB); PG8_STAGE(PG8_SA(0, 1), cA + hstep, voffA);
        if (wr == 1) PG8_BAR;
        PG8_WAIT_V(4); PG8_BAR;
        PG8_STAGE(PG8_SB(1, 0), cB + kstep, voffB); PG8_STAGE(PG8_SA(1, 0), cA + kstep, voffA); PG8_STAGE(PG8_SB(1, 1), cB + hstep + kstep, voffB);
        PG8_WAIT_V(6); PG8_BAR;
    }
    for (;;) {
        const bool has_next = S.next(ui + 1, nxt);
        const char* nA = has_next ? (const char*)g.A + (size_t)nxt.pm * tstep : cA; const char* nB = has_next ? (const char*)g.Bt + (size_t)nxt.pn * tstep : cB;
        if constexpr (Sched::SPLITK) { if (has_next) { nA += nxt.ko; nB += nxt.ko; } }
        const int ntu = Sched::SPLITK ? (cur.kq >= 0 ? Sched::NT_SPLIT : nt) : nt;
        for (int t = 0; t < ntu; t += 2) {
            const bool last = (t == ntu - 2);
            const char* a1 = cA + (size_t)(t + 1) * kstep;
            const char* a2 = last ? nA : cA + (size_t)(t + 2) * kstep; const char* b2 = last ? nB : cB + (size_t)(t + 2) * kstep;
            const char* a3 = a2 + kstep; const char* b3 = b2 + kstep;
            if (last && has_next) S.a_ready(nxt);
            if constexpr (SP2) {
            PG8_LDB(B0, 0, 0); PG8_LDB(B1, 0, 1); PG8_SCHED; PG8_LDA(At, 0, 0); PG8_STAGE(PG8_SA(1, 1), a1 + hstep, voffA);
            PG8_WAIT_V(8); PG8_WAIT_L(0); PG8_BAR; PG8_MMA(0, 0, At, B0); PG8_MMA(0, 1, At, B1); PG8_BAR; PG8_SCHED;
            PG8_LDA(At, 0, 1); PG8_STAGE(PG8_SB(0, 0), b2, voffB); PG8_STAGE(PG8_SB(0, 1), b2 + hstep, voffB); PG8_STAGE(PG8_SA(0, 0), a2, voffA);
            PG8_WAIT_V(8); PG8_WAIT_L(0); PG8_BAR; PG8_MMA(1, 0, At, B0); PG8_MMA(1, 1, At, B1); PG8_BAR; PG8_SCHED;
            PG8_LDB(B0, 1, 0); PG8_LDB(B1, 1, 1); PG8_SCHED; PG8_LDA(At, 1, 0); PG8_STAGE(PG8_SA(0, 1), a2 + hstep, voffA);
            PG8_WAIT_V(8); PG8_WAIT_L(0); PG8_BAR; PG8_MMA(0, 0, At, B0); PG8_MMA(0, 1, At, B1); PG8_BAR; PG8_SCHED;
            PG8_LDA(At, 1, 1); PG8_STAGE(PG8_SB(1, 0), b3, voffB); PG8_STAGE(PG8_SB(1, 1), b3 + hstep, voffB); PG8_STAGE(PG8_SA(1, 0), a3, voffA);
            PG8_WAIT_V(8); PG8_WAIT_L(0); PG8_BAR; PG8_MMA(1, 0, At, B0); PG8_MMA(1, 1, At, B1); PG8_BAR; PG8_SCHED;
            } else {
            PG8_LDB(B0, 0, 0); PG8_SCHED; PG8_LDA(At, 0, 0); PG8_STAGE(PG8_SA(1, 1), a1 + hstep, voffA);
            PG8_WAIT_L(8); PG8_BAR; PG8_WAIT_L(0); PG8_MMA(0, 0, At, B0); PG8_BAR; PG8_SCHED;
            PG8_LDB(B1, 0, 1); PG8_STAGE(PG8_SB(0, 0), b2, voffB);
            PG8_BAR; PG8_WAIT_L(0); PG8_MMA(0, 1, At, B1); PG8_BAR;
            PG8_LDA(At, 0, 1); PG8_STAGE(PG8_SA(0, 0), a2, voffA);
            PG8_BAR; PG8_WAIT_L(0); PG8_MMA(1, 0, At, B0); PG8_BAR; PG8_SCHED;
            PG8_STAGE(PG8_SB(0, 1), b2 + hstep, voffB);
            PG8_WAIT_V(6); PG8_BAR; PG8_MMA(1, 1, At, B1); PG8_BAR;
            PG8_LDB(B0, 1, 0); PG8_SCHED; PG8_LDA(At, 1, 0); PG8_STAGE(PG8_SA(0, 1), a2 + hstep, voffA);
            PG8_WAIT_L(8); PG8_BAR; PG8_WAIT_L(0); PG8_MMA(0, 0, At, B0); PG8_BAR; PG8_SCHED;
            PG8_LDB(B1, 1, 1); PG8_STAGE(PG8_SB(1, 0), b3, voffB);
            PG8_BAR; PG8_WAIT_L(0); PG8_MMA(0, 1, At, B1); PG8_BAR;
            PG8_LDA(At, 1, 1); PG8_STAGE(PG8_SA(1, 0), a3, voffA);
            PG8_BAR; PG8_WAIT_L(0); PG8_MMA(1, 0, At, B0); PG8_BAR; PG8_SCHED;
            PG8_STAGE(PG8_SB(1, 1), b3 + hstep, voffB);
            PG8_WAIT_V(6); PG8_BAR; PG8_MMA(1, 1, At, B1); PG8_BAR;
            }
        }
        if constexpr (F8) asm volatile("s_nop 15\n\ts_nop 15" ::: "memory");
        if constexpr (ALIGN_EPI) { if (wr == 0) PG8_BAR; }
        if constexpr (!Epi::AFTER_DRAIN) { int fr2 = fr, fq2 = fq; asm volatile("" : "+v"(fr2), "+v"(fq2));
            E(acc, cur, wr, wc, fr2, fq2);
            S.done(cur); }
        if (!has_next) break;
#pragma unroll
        for (int a = 0; a < 2; ++a)
#pragma unroll
            for (int b = 0; b < 2; ++b)
#pragma unroll
                for (int m = 0; m < 4; ++m)
#pragma unroll
                    for (int n = 0; n < 2; ++n) acc[a][b][m][n] = (f32x4){0.f, 0.f, 0.f, 0.f};
        cur = nxt; cA = nA; cB = nB; ++ui;
        if constexpr (ALIGN_EPI) { if (wr == 1) PG8_BAR; }
    }
    PG8_WAIT_V(0);
    if constexpr (!ALIGN_EPI) { if (wr == 0) PG8_BAR; }
    PG8_BAR;
    if constexpr (Epi::AFTER_DRAIN) { int fr2 = fr, fq2 = fq, lane2 = lane; asm volatile("" : "+v"(fr2), "+v"(fq2), "+v"(lane2));
        E.fused(acc, cur, wr, wc, fr2, fq2, lds, wid, lane2); S.done(cur); }
#undef PG8_SA
#undef PG8_SB
#undef PG8_STAGE
#undef PG8_LD16
#undef PG8_LDA
#undef PG8_LDB
#undef PG8_MMA
#undef PG8_WAIT_V
#undef PG8_WAIT_L
#undef PG8_BAR
#undef PG8_SCHED
}
}
#define LDS_WAIT() asm volatile("s_waitcnt lgkmcnt(0)" ::: "memory")
constexpr int TR_STR = 68, TR_TILE = 64 * TR_STR * 4;
#define TR_PUT(V) do { _Pragma("unroll") for (int q_ = 0; q_ < 16; ++q_) *(LAS f32x4*)(scr + lane * TR_STR + 4 * q_) = (f32x4){V[4 * q_], V[4 * q_ + 1], V[4 * q_ + 2], V[4 * q_ + 3]}; } while (0)
template <bool F8> __device__ __forceinline__ void tr_emit(const LAS float* scr, unsigned char* dst, int K, float wscale, int lane, bool swz = false) {
    const int c = lane & 7;
#pragma unroll
    for (int j = 0; j < 8; ++j) { const int ns = (lane >> 3) + 8 * j, n = (swz && ns >= 4 && ns < 12) ? (ns ^ 12) : ns; const LAS f32x4* sp = (const LAS f32x4*)(scr + ns * TR_STR + 8 * c); const f32x4 a = sp[0] * wscale, b = sp[1] * wscale;
        if (F8) { v2u o; o.x = pk4f8(a[0], a[1], a[2], a[3]); o.y = pk4f8(b[0], b[1], b[2], b[3]); *(v2u*)(dst + (size_t)n * K + 8 * c) = o; }
        else { v4u o; o.x = pk2(a[0], a[1]); o.y = pk2(a[2], a[3]); o.z = pk2(b[0], b[1]); o.w = pk2(b[2], b[3]); *(v4u*)(dst + ((size_t)n * K + 8 * c) * 2) = o; } }
}
template <bool F8> __device__ __forceinline__ void tr_item(const float* W, int ldw, int K, unsigned char* WT, int k0, int n0, int drow0, LAS float* scr, int lane, float wscale, bool swz = false) {
    const float* src = W + (size_t)k0 * ldw + n0 + lane;
    float v[64];
#pragma unroll
    for (int i = 0; i < 64; ++i) v[i] = __builtin_nontemporal_load(src + (size_t)i * ldw);
    TR_PUT(v);
    LDS_WAIT(); asm volatile("" ::: "memory");
    tr_emit<F8>(scr, WT + ((size_t)drow0 * K + k0) * (F8 ? 1 : 2), K, wscale, lane, swz);
    LDS_WAIT(); asm volatile("" ::: "memory");
}
template <int KINDM, bool F8> __device__ __forceinline__ void tr_matrix(Frame& F, const float* W, int ldw, int K, int N, void* WT, float wscale, int& base, int gw, int ngw) {
    LAS float* scr = (LAS float*)(F.lds + F.wave * TR_TILE);
    const int nblk = N / 64, nitems = (K / 64) * nblk;
    int first = gw - (base % ngw); if (first < 0) first += ngw;
    for (int it = first; it < nitems; it += ngw) {
        const int kb = it / nblk, nb = it % nblk, n0 = nb * 64;
        const int drow0 = (KINDM == 0 || KINDM == 3) ? n0 : ((n0 >> 7) * 256 + (n0 & 127) + (KINDM == 2 ? 128 : 0));
        tr_item<F8>(W, ldw, K, (unsigned char*)WT, kb * 64, n0, drow0, scr, F.lane, wscale, KINDM == 3 && n0 < 1024);
    }
    base += nitems;
}
__device__ __forceinline__ void ph_weights_dense(Frame& F) {
    const int gw = F.blk * NWAVES + F.wave, ngw = GRID * NWAVES; int base = 0;
    tr_matrix<3, false>(F, F.e_w_in, L0N, D, L0N, WSP(bf16, WS_WB_L0IN), 1.f, base, gw, ngw);
    tr_matrix<0, false>(F, F.e_w_out, D, D, D, WSP(bf16, WS_WB_L0OUT), 1.f, base, gw, ngw);
    tr_matrix<1, false>(F, F.e_wg, FF, D, FF, WSP(bf16, WS_WB_L0GU), 1.f, base, gw, ngw);
    tr_matrix<2, false>(F, F.e_wu, FF, D, FF, WSP(bf16, WS_WB_L0GU), 1.f, base, gw, ngw);
    tr_matrix<0, false>(F, F.e_wd, D, FF, D, WSP(bf16, WS_WB_L0DN), 1.f, base, gw, ngw);
    tr_matrix<0, false>(F, F.o_w_in, L1N, D, 4096, WSP(bf16, WS_WB_L1IN), 1.f, base, gw, ngw);
    tr_matrix<0, false>(F, F.o_w_out, D, D, D, WSP(bf16, WS_WB_L1OUT), 1.f, base, gw, ngw);
#pragma unroll 1
    for (int g = 0; g < 4; ++g) tr_matrix<0, false>(F, F.e_pool_w + g * 16384, 128, 128, 128, WSP(bf16, WS_POOLWT) + g * 16384, 1.f, base, gw, ngw);
}
constexpr int TRB_STR = 269;
struct TrB { const float* src; unsigned char* dst; int ldw, K, which; float sc; };
__device__ __forceinline__ TrB moe_item_b(Frame& F, int it) {
    const int e = it / 336, r = it % 336, which = r / 112, q = r % 112;
    TrB t; t.which = which;
    if (which < 2) { const int kb = q / 14, nb = q % 14; const float* W = (which == 0 ? F.o_mg : F.o_mu) + (size_t)e * D * FF;
        t.src = W + (size_t)(kb * 128) * FF + nb * 256; t.ldw = FF; t.K = D; t.sc = 32.0f;
        t.dst = F.ws + WS_WB_GU + ((size_t)e * 7168 + (nb * 2) * 256 + which * 128) * D + kb * 128; }
    else { const int kb = q / 4, nb = q % 4; const float* W = F.o_md + (size_t)e * FF * D;
        t.src = W + (size_t)(kb * 128) * D + nb * 256; t.ldw = D; t.K = FF; t.sc = 64.0f;
        t.dst = F.ws + WS_WB_DN + ((size_t)e * D + nb * 256) * FF + kb * 128; }
    return t;
}
#define TRB_LOAD(V, T_) do { _Pragma("unroll") for (int i_ = 0; i_ < 16; ++i_) V[i_] = __builtin_nontemporal_load((const f32x4*)((T_).src + (size_t)(r0 + 8 * i_) * (T_).ldw) + col4); } while (0)
#define TRB_STEP(V, CUR, NXT_IT) do { \
        _Pragma("unroll") for (int i_ = 0; i_ < 16; ++i_) { const int k_ = r0 + 8 * i_; LAS float* d_ = scr + k_ * TRB_STR + 4 * col4 + 4 * (k_ >> 5); d_[0] = V[i_][0]; d_[1] = V[i_][1]; d_[2] = V[i_][2]; d_[3] = V[i_][3]; } \
        const TrB cur_ = CUR; CUR = moe_item_b(F, (NXT_IT) < NIT ? (NXT_IT) : cb); TRB_LOAD(V, CUR); \
        asm volatile("s_waitcnt lgkmcnt(0)" ::: "memory"); __builtin_amdgcn_s_barrier(); asm volatile("" ::: "memory"); \
        _Pragma("unroll") for (int j_ = 0; j_ < 8; ++j_) { const int n_ = nl + 32 * j_; const LAS float* sp_ = scr + (8 * c) * TRB_STR + n_ + 4 * (c >> 2); const float ws_ = cur_.sc; \
            v2u o_; o_.x = pk4f8(sp_[0 * TRB_STR] * ws_, sp_[1 * TRB_STR] * ws_, sp_[2 * TRB_STR] * ws_, sp_[3 * TRB_STR] * ws_); o_.y = pk4f8(sp_[4 * TRB_STR] * ws_, sp_[5 * TRB_STR] * ws_, sp_[6 * TRB_STR] * ws_, sp_[7 * TRB_STR] * ws_); \
            const size_t orow_ = cur_.which < 2 ? (size_t)((n_ >> 7) * 256 + (n_ & 127)) : (size_t)n_; \
            __builtin_nontemporal_store(o_, (v2u*)(cur_.dst + orow_ * cur_.K + 8 * c)); } \
        asm volatile("s_waitcnt lgkmcnt(0)" ::: "memory"); __builtin_amdgcn_s_barrier(); asm volatile("" ::: "memory"); } while (0)
__device__ __forceinline__ void ph_weights_moe_blk(Frame& F, int cb, int ncb) {
    constexpr int NIT = NE * 336;
    LAS float* scr = (LAS float*)F.lds;
    const int tid = F.tid, col4 = tid & 63, r0 = tid >> 6, c = tid & 15, nl = tid >> 4;
    int it = cb; if (it >= NIT) return;
    TrB tA = moe_item_b(F, it), tB = moe_item_b(F, it + ncb < NIT ? it + ncb : cb);
    f32x4 vA[16], vB[16];
    TRB_LOAD(vA, tA); TRB_LOAD(vB, tB);
#pragma unroll 1
    for (;;) {
        TRB_STEP(vA, tA, it + 2 * ncb);
        if (it + ncb >= NIT) break;
        TRB_STEP(vB, tB, it + 3 * ncb);
        it += 2 * ncb; if (it >= NIT) break;
    }
}
#undef TRB_LOAD
#undef TRB_STEP

namespace pg8 {
struct EpiPlain {
    static constexpr bool PERM = true, AFTER_DRAIN = false;
    bf16_t* O; int ldc; bf16_t* O2; int ldc2; int split; int nper; float oscale;
    __device__ __forceinline__ void operator()(const f32x4 (&acc)[2][2][4][2], const Unit& u, int wr, int wc, int fr, int fq) const {
        int pn = u.pn % nper; bf16_t* base = O; int ld = ldc;
        if (pn >= split) { pn -= split; base = O2; ld = ldc2; }
        const int row0 = u.pm * BM + wr * 64 + fr, col0 = pn * BM + wc * 32 + 8 * fq;
#pragma unroll
        for (int ai = 0; ai < 2; ++ai)
#pragma unroll
            for (int m = 0; m < 4; ++m) { bf16_t* rowp = base + (size_t)(row0 + ai * HALF + m * 16) * ld + col0;
#pragma unroll
                for (int bj = 0; bj < 2; ++bj) { const f32x4 v0 = acc[ai][bj][m][0] * oscale, v1 = acc[ai][bj][m][1] * oscale;
                    u32x4 w; w.x = cvt_pk_bf16(v0[0], v0[1]); w.y = cvt_pk_bf16(v0[2], v0[3]); w.z = cvt_pk_bf16(v1[0], v1[1]); w.w = cvt_pk_bf16(v1[2], v1[3]);
                    if (base == O2) __builtin_nontemporal_store(w, (u32x4*)(rowp + bj * HALF)); else *(u32x4*)(rowp + bj * HALF) = w; } }
    }
};
struct EpiSwiglu {
    static constexpr bool PERM = true, AFTER_DRAIN = false;
    bf16_t* O; int ldc; int nper;
    __device__ __forceinline__ void operator()(const f32x4 (&acc)[2][2][4][2], const Unit& u, int wr, int wc, int fr, int fq) const {
        const int pn = u.pn % nper;
        const int row0 = u.pm * BM + wr * 64 + fr, col0 = pn * HALF + wc * 32 + 8 * fq;
#pragma unroll
        for (int ai = 0; ai < 2; ++ai)
#pragma unroll
            for (int m = 0; m < 4; ++m) { bf16_t* rowp = O + (size_t)(row0 + ai * HALF + m * 16) * ldc + col0;
                float o[8];
#pragma unroll
                for (int n = 0; n < 2; ++n)
#pragma unroll
                    for (int hh = 0; hh < 2; ++hh) { const f32x2 g = {acc[ai][0][m][n][2 * hh], acc[ai][0][m][n][2 * hh + 1]}, uu = {acc[ai][1][m][n][2 * hh], acc[ai][1][m][n][2 * hh + 1]};
                        const f32x2 t = g * -1.4426950408889634f; f32x2 a = {__builtin_amdgcn_exp2f(t.x), __builtin_amdgcn_exp2f(t.y)}; a = a + 1.0f;
                        const f32x2 r = {__builtin_amdgcn_rcpf(a.x), __builtin_amdgcn_rcpf(a.y)}, q = (g * uu) * r; o[4 * n + 2 * hh] = q.x; o[4 * n + 2 * hh + 1] = q.y; }
                u32x4 w; w.x = cvt_pk_bf16(o[0], o[1]); w.y = cvt_pk_bf16(o[2], o[3]); w.z = cvt_pk_bf16(o[4], o[5]); w.w = cvt_pk_bf16(o[6], o[7]);
                *(u32x4*)rowp = w; }
    }
};
struct EpiSwigluF8 {
    static constexpr bool PERM = true, AFTER_DRAIN = false;
    unsigned char* O; int ldc; int nper; float iscale, hscale;
    __device__ __forceinline__ void operator()(const f32x4 (&acc)[2][2][4][2], const Unit& u, int wr, int wc, int fr, int fq) const {
        const int pn = u.pn % nper;
        const int row0 = u.pm * BM + wr * 64 + fr, col0 = pn * HALF + wc * 32 + 8 * fq;
#pragma unroll
        for (int ai = 0; ai < 2; ++ai)
#pragma unroll
            for (int m = 0; m < 4; ++m) { unsigned char* rowp = O + (size_t)(row0 + ai * HALF + m * 16) * ldc + col0;
                float o[8];
                const float c1 = -1.4426950408889634f * iscale, c2 = iscale * iscale * hscale;
#pragma unroll
                for (int n = 0; n < 2; ++n)
#pragma unroll
                    for (int hh = 0; hh < 2; ++hh) { const f32x2 g = {acc[ai][0][m][n][2 * hh], acc[ai][0][m][n][2 * hh + 1]}, uu = {acc[ai][1][m][n][2 * hh], acc[ai][1][m][n][2 * hh + 1]};
                        const f32x2 t = g * c1; f32x2 a = {__builtin_amdgcn_exp2f(t.x), __builtin_amdgcn_exp2f(t.y)}; a = a + 1.0f;
                        const f32x2 r = {__builtin_amdgcn_rcpf(a.x), __builtin_amdgcn_rcpf(a.y)}, q = ((g * c2) * uu) * r; o[4 * n + 2 * hh] = q.x; o[4 * n + 2 * hh + 1] = q.y; }
                v2u w; w.x = pk4f8(o[0], o[1], o[2], o[3]); w.y = pk4f8(o[4], o[5], o[6], o[7]);
                *(v2u*)rowp = w; asm volatile("" ::: "memory"); }
    }
};
struct EpiL0In {
    static constexpr bool PERM = true, AFTER_DRAIN = false;
    bf16_t* O; const float* rope;
    __device__ __forceinline__ void operator()(const f32x4 (&acc)[2][2][4][2], const Unit& u, int wr, int wc, int fr, int fq) const {
        const int row0 = u.pm * BM + wr * 64 + fr, col0 = u.pn * BM + wc * 32 + 8 * fq;
        const bool qkw = u.pn < 4 && ((wc & 1) == 0), rot = qkw && (fq < 2);
        const float sc = u.pn < 2 ? 0.125f * 1.4426950408889634f : 1.0f;
#pragma unroll
        for (int ai = 0; ai < 2; ++ai)
#pragma unroll
            for (int m = 0; m < 4; ++m) { const int r = row0 + ai * HALF + m * 16; bf16_t* rowp = O + (size_t)r * L0N + col0;
                f32x4 cs = {1.f, 1.f, 1.f, 1.f}, sn = {0.f, 0.f, 0.f, 0.f};
                if (rot) { const f32x4* t = (const f32x4*)(rope + (size_t)r * 16); cs = t[fq]; sn = t[2 + fq]; }
#pragma unroll
                for (int bj = 0; bj < 2; ++bj) { f32x4 v0 = acc[ai][bj][m][0], v1 = acc[ai][bj][m][1];
                    if (qkw) { const f32x4 a = v0, b = v1; v0 = a * cs - b * sn; v1 = b * cs + a * sn; }
                    v0 = v0 * sc; v1 = v1 * sc;
                    u32x4 w; w.x = cvt_pk_bf16(v0[0], v0[1]); w.y = cvt_pk_bf16(v0[2], v0[3]); w.z = cvt_pk_bf16(v1[0], v1[1]); w.w = cvt_pk_bf16(v1[2], v1[3]);
                    *(u32x4*)(rowp + bj * HALF) = w; } }
    }
};
struct EpiNormB {
    static constexpr bool PERM = true, AFTER_DRAIN = true;
    const float* x; bf16_t* x1; bf16_t* H; const float* pg; const float* g2; const float* mod;
    unsigned* xb1; unsigned* xb2; unsigned* cnt;
    __device__ __forceinline__ void put(int k, float s, int wr, int wc, int fr, int fq, PG8_LAS unsigned char* lds) const {
        PG8_LAS float* P = (PG8_LAS float*)lds; float v = xsum16(s); v = xsum32(v);
        if (fq == 0) P[((k >> 2) * HALF + wr * 64 + (k & 3) * 16 + fr) * 4 + wc] = v; }
    __device__ __forceinline__ void run(unsigned* xb, unsigned* cw, const Unit& u, PG8_LAS unsigned char* lds, int wid, int lane) const {
        asm volatile("" : "+v"(lane));
        PG8_LAS float* P = (PG8_LAS float*)lds; PG8_LAS float* S = (PG8_LAS float*)(lds + 8192);
        asm volatile("s_waitcnt lgkmcnt(0)" ::: "memory"); __builtin_amdgcn_s_barrier(); asm volatile("" ::: "memory");
        const int row = wid * 32 + (lane & 31);
        if (lane < 32) { const f32x4 t = *(const PG8_LAS f32x4*)(P + row * 4);
            __hip_atomic_store(xb + ((size_t)(u.pm * BM + row) * 4 + u.pn), __builtin_bit_cast(unsigned, (t[0] + t[1]) + (t[2] + t[3])), __ATOMIC_RELAXED, __HIP_MEMORY_SCOPE_AGENT); }
        asm volatile("s_waitcnt vmcnt(0)" ::: "memory");
        if (lane == 0) __hip_atomic_fetch_add(cw, 1u, __ATOMIC_RELAXED, __HIP_MEMORY_SCOPE_AGENT);
        if (wid == 0) { unsigned sp = 0u;
            while ((unsigned)__builtin_amdgcn_readfirstlane(__hip_atomic_load(cw, __ATOMIC_RELAXED, __HIP_MEMORY_SCOPE_AGENT)) < 32u) { __builtin_amdgcn_s_sleep(2); if (++sp > (1u << 20)) break; }
            __builtin_amdgcn_fence(__ATOMIC_ACQUIRE, "agent"); }
        asm volatile("s_waitcnt vmcnt(0) lgkmcnt(0)" ::: "memory"); __builtin_amdgcn_s_barrier(); asm volatile("" ::: "memory");
        if (lane < 32) { const unsigned* sl = xb + (size_t)(u.pm * BM + row) * 4; float a = 0.f;
#pragma unroll
            for (int t = 0; t < 4; ++t) a += __builtin_bit_cast(float, __hip_atomic_load(sl + t, __ATOMIC_RELAXED, __HIP_MEMORY_SCOPE_AGENT));
            S[row] = a; }
        asm volatile("s_waitcnt vmcnt(0) lgkmcnt(0)" ::: "memory"); __builtin_amdgcn_s_barrier(); asm volatile("" ::: "memory");
    }
    __device__ __forceinline__ void fused(f32x4 (&acc)[2][2][4][2], const Unit& u, int wr, int wc, int fr, int fq, PG8_LAS unsigned char* lds, int wid, int lane) const {
        const PG8_LAS float* S = (const PG8_LAS float*)(lds + 8192);
        PG8_LAS float* GP = (PG8_LAS float*)(lds + 12288); PG8_LAS float* GA = GP + 256; PG8_LAS float* SH = GA + 256;
        const int tid = wid * 64 + lane, b = (u.pm * BM) / T;
        if (tid < 256) { const int c = u.pn * BM + tid; const float* mb = mod + b * 6144;
            GP[tid] = mb[2 * 1024 + c] * pg[c]; GA[tid] = g2[c] * (mb[4 * 1024 + c] + 1.0f); SH[tid] = mb[3 * 1024 + c]; }
#pragma unroll
        for (int ai = 0; ai < 2; ++ai)
#pragma unroll
            for (int m = 0; m < 4; ++m) { float s = 0.f;
#pragma unroll
                for (int bj = 0; bj < 2; ++bj)
#pragma unroll
                    for (int n = 0; n < 2; ++n) { const f32x4 v = acc[ai][bj][m][n]; s += (v[0] * v[0] + v[1] * v[1]) + (v[2] * v[2] + v[3] * v[3]); }
                put(ai * 4 + m, s, wr, wc, fr, fq, lds); }
        run(xb1, cnt + (2 * u.pm) * 32, u, lds, wid, lane);
        const int cl0 = wc * 32 + 8 * fq;
#pragma unroll
        for (int ai = 0; ai < 2; ++ai)
#pragma unroll
            for (int m = 0; m < 4; ++m) { const int r = ai * HALF + wr * 64 + m * 16 + fr; const float ry = 1.0f / sqrtf(S[r] * (1.f / D) + EPS);
                const size_t off = (size_t)(u.pm * BM + r) * D + u.pn * BM + cl0; float s = 0.f;
#pragma unroll
                for (int bj = 0; bj < 2; ++bj) { const f32x4 x0 = *(const f32x4*)(x + off + bj * HALF), xq = *(const f32x4*)(x + off + bj * HALF + 4);
                    const f32x4 g0 = *(const PG8_LAS f32x4*)(GP + cl0 + bj * HALF), g1 = *(const PG8_LAS f32x4*)(GP + cl0 + bj * HALF + 4);
                    const f32x4 v0 = x0 + g0 * (acc[ai][bj][m][0] * ry), v1 = xq + g1 * (acc[ai][bj][m][1] * ry);
                    acc[ai][bj][m][0] = v0; acc[ai][bj][m][1] = v1;
                    s += ((v0[0] * v0[0] + v0[1] * v0[1]) + (v0[2] * v0[2] + v0[3] * v0[3])) + ((v1[0] * v1[0] + v1[1] * v1[1]) + (v1[2] * v1[2] + v1[3] * v1[3]));
                    u32x4 w; w.x = cvt_pk_bf16(v0[0], v0[1]); w.y = cvt_pk_bf16(v0[2], v0[3]); w.z = cvt_pk_bf16(v1[0], v1[1]); w.w = cvt_pk_bf16(v1[2], v1[3]);
                    __builtin_nontemporal_store(w, (u32x4*)(x1 + off + bj * HALF)); }
                put(ai * 4 + m, s, wr, wc, fr, fq, lds);
                asm volatile("" : "+v"(acc[ai][0][m][0]), "+v"(acc[ai][0][m][1]), "+v"(acc[ai][1][m][0]), "+v"(acc[ai][1][m][1]));
                asm volatile("" ::: "memory"); }
        run(xb2, cnt + (2 * u.pm + 1) * 32, u, lds, wid, lane);
        asm volatile("" : "+v"(fr), "+v"(fq));
        const int cl3 = wc * 32 + 8 * fq;
#pragma unroll
        for (int ai = 0; ai < 2; ++ai)
#pragma unroll
            for (int m = 0; m < 4; ++m) { const int r = ai * HALF + wr * 64 + m * 16 + fr; const float rr = 1.0f / sqrtf(S[r] * (1.f / D) + EPS);
                const size_t off = (size_t)(u.pm * BM + r) * D + u.pn * BM + cl3;
#pragma unroll
                for (int bj = 0; bj < 2; ++bj) { const f32x4 a0 = *(const PG8_LAS f32x4*)(GA + cl3 + bj * HALF), a1 = *(const PG8_LAS f32x4*)(GA + cl3 + bj * HALF + 4);
                    const f32x4 s0 = *(const PG8_LAS f32x4*)(SH + cl3 + bj * HALF), s1 = *(const PG8_LAS f32x4*)(SH + cl3 + bj * HALF + 4);
                    const f32x4 h0 = acc[ai][bj][m][0] * rr * a0 + s0, h1 = acc[ai][bj][m][1] * rr * a1 + s1;
                    u32x4 w; w.x = cvt_pk_bf16(h0[0], h0[1]); w.y = cvt_pk_bf16(h0[2], h0[3]); w.z = cvt_pk_bf16(h1[0], h1[1]); w.w = cvt_pk_bf16(h1[2], h1[3]);
                    *(u32x4*)(H + off + bj * HALF) = w; }
                asm volatile("" ::: "memory"); }
    }
};
struct MoeOrder {
    static constexpr bool SPLITK = false; static constexpr int NT_SPLIT = 0;
    int nM, nN, nwg, G, c; int t1, t2, t3, t4, t5, t6, t7;
#define RFL(x) __builtin_amdgcn_readfirstlane(x)
    __device__ void init(const LAS int* tp, int nN_, int G_, int c_) {     nM = RFL(tp[8]); nN = nN_; nwg = nM * nN; G = G_; c = c_; t1 = RFL(tp[1]); t2 = RFL(tp[2]); t3 = RFL(tp[3]); t4 = RFL(tp[4]); t5 = RFL(tp[5]); t6 = RFL(tp[6]); t7 = RFL(tp[7]); }
#undef RFL
    __device__ bool next(int i, Unit& u) const {
        const long L = (long)i * G + c; if (L >= nwg) return false;
        int wgid = (int)L; { const int q = nwg / NXCD, r = nwg % NXCD, xcd = wgid % NXCD, off = wgid / NXCD; wgid = (xcd < r ? xcd * (q + 1) : r * (q + 1) + (xcd - r) * q) + off; }
        const int nig = WGM * nN, gid = wgid / nig, fm = gid * WGM, gsz = (nM - fm) < WGM ? (nM - fm) : WGM;
        const int pm = fm + ((wgid % nig) % gsz), pn = (wgid % nig) / gsz;
        const int e = (pm >= t1) + (pm >= t2) + (pm >= t3) + (pm >= t4) + (pm >= t5) + (pm >= t6) + (pm >= t7);
        u.pm = pm; u.pn = e * nN + pn; return true;
    }
    __device__ __forceinline__ void a_ready(const Unit&) const {}
    __device__ __forceinline__ void done(const Unit&) const {}
};
struct MoeDnOrder {
    static constexpr bool SPLITK = true; static constexpr int KSPLIT = 7, NT_SPLIT = 4  , FULLM = 128;
    int ntail, c; int t1, t2, t3, t4, t5, t6, t7;
#define RFL(x) __builtin_amdgcn_readfirstlane(x)
    __device__ void init(const LAS int* tp, int c_) { ntail = (RFL(tp[8]) - FULLM) * 4 * KSPLIT; c = c_; t1 = RFL(tp[1]); t2 = RFL(tp[2]); t3 = RFL(tp[3]); t4 = RFL(tp[4]); t5 = RFL(tp[5]); t6 = RFL(tp[6]); t7 = RFL(tp[7]); }
#undef RFL
    __device__ bool next(int i, Unit& u) const {
        int pm, pn;
        if (i < 2) { const int L = i * 256 + c, wgid = (L % NXCD) * (FULLM * 4 / NXCD) + L / NXCD;
            const int nig = WGM * 4, fm = (wgid / nig) * WGM; pm = fm + ((wgid % nig) % WGM); pn = (wgid % nig) / WGM; u.ko = 0; u.kq = -1; }
        else { if (i > 2 || c >= ntail) return false;
            const int kq = c % KSPLIT, rest = c / KSPLIT; pn = rest & 3; pm = FULLM + (rest >> 2); u.ko = kq * (NT_SPLIT * 128); u.kq = kq; }
        const int e = (pm >= t1) + (pm >= t2) + (pm >= t3) + (pm >= t4) + (pm >= t5) + (pm >= t6) + (pm >= t7);
        u.pm = pm; u.pn = e * 4 + pn; return true;
    }
    __device__ __forceinline__ void a_ready(const Unit&) const {}
    __device__ __forceinline__ void done(const Unit&) const {}
};
struct EpiMoeDn {
    static constexpr bool PERM = true, AFTER_DRAIN = false;
    bf16_t* O; bf16_t* P; float oscale;
    __device__ __forceinline__ void operator()(const f32x4 (&acc)[2][2][4][2], const Unit& u, int wr, int wc, int fr, int fq) const {
        const int pn = u.pn & 3;
        bf16_t* base = O; if (u.kq > 0) base = P + ((long)(u.kq - 1) * 2048 - 32768) * (long)D;
        const int row0 = u.pm * BM + wr * 64 + fr, col0 = pn * BM + wc * 32 + 8 * fq;
#pragma unroll
        for (int ai = 0; ai < 2; ++ai)
#pragma unroll
            for (int m = 0; m < 4; ++m) { bf16_t* rowp = base + (long)(row0 + ai * HALF + m * 16) * D + col0;
#pragma unroll
                for (int bj = 0; bj < 2; ++bj) { const f32x4 v0 = acc[ai][bj][m][0] * oscale, v1 = acc[ai][bj][m][1] * oscale;
                    u32x4 w; w.x = cvt_pk_bf16(v0[0], v0[1]); w.y = cvt_pk_bf16(v0[2], v0[3]); w.z = cvt_pk_bf16(v1[0], v1[1]); w.w = cvt_pk_bf16(v1[2], v1[3]);
                    *(u32x4*)(rowp + bj * HALF) = w; } }
    }
};

}
#define MFMA16(a, b, c) __builtin_amdgcn_mfma_f32_16x16x32_bf16((a), (b), (c), 0, 0, 0)
__device__ __forceinline__ s16x4 tr16(LAS unsigned char* p) { return __builtin_amdgcn_ds_read_tr16_b64_v4i16((LAS s16x4*)p); }
__device__ __forceinline__ bf16x8 cat4(s16x4 a, s16x4 b) { return (bf16x8){a[0], a[1], a[2], a[3], b[0], b[1], b[2], b[3]}; }
#ifndef PROBE_POOL2
#define PROBE_POOL2 0
#endif
#ifndef PROBE_ATT2
#define PROBE_ATT2 0
#endif
constexpr int KV_STRIDE = 144;
constexpr int ATT_UNITS = NB * AH * 3 * 64;
struct AttUnit { int b, h, br, d, r, nb; };
__device__ __forceinline__ AttUnit att_decode(int u) {
    AttUnit a; a.br = u >> 10; const int rem = u & 1023; a.b = rem >> 9; a.h = (rem >> 6) & 7; const int rb = rem & 63;
    a.d = a.br == 0 ? 1 : (a.br == 1 ? 4 : 16); const int nblk = 64 / a.d; a.r = rb / nblk; a.nb = rb % nblk; return a;
}
__device__ __forceinline__ void att_issue(const bf16* P0, const AttUnit& a, int tid, int wave, int lane, v4u (&kr)[4], v4u (&vr)[4], v4u (&qr)[2]) {
    const int c = tid & 7, row0 = tid >> 3;
#pragma unroll
    for (int i = 0; i < 4; ++i) {
        int n = 128 * (a.nb - 1) + row0 + 64 * i; if (n < 0) n += 128;
        const bf16* p = P0 + (size_t)(a.b * T + n * a.d + a.r) * L0N + 64 * a.h + 8 * c;
        kr[i] = *(const v4u*)(p + 512); vr[i] = *(const v4u*)(p + 1024);
    }
    const int tq = a.b * T + (128 * a.nb + 16 * wave + (lane & 15)) * a.d + a.r;
    const bf16* q = P0 + (size_t)tq * L0N + 64 * a.h + 8 * (lane >> 4);
    qr[0] = *(const v4u*)q; qr[1] = *(const v4u*)(q + 32);
}
__device__ __forceinline__ void pool_unit(const bf16* P0, const bf16* PW, const float* pscale, bf16* MIX, int m, int t, int gg, int li, int g) {
    const int Wn = 2 << gg, cnt = (t + 1 < Wn) ? t + 1 : Wn; const float rc = 1.0f / (float)cnt;
    f32x4 acc[8];
#pragma unroll
    for (int nt = 0; nt < 8; ++nt) acc[nt] = (f32x4){0.f, 0.f, 0.f, 0.f};
#pragma unroll 1
    for (int ks = 0; ks < 4; ++ks) {
        const bf16* up = P0 + (size_t)m * L0N + 1536 + 128 * gg + 32 * ks + 8 * g;
        const v4u self = *(const v4u*)up;
        float sm[8];
#pragma unroll
        for (int q = 0; q < 8; ++q) sm[q] = 0.f;
        { v4u x[16];
#pragma unroll
          for (int j = 0; j < 16; ++j) { const int jj = j < cnt ? j : 0; x[j] = *(const v4u*)(up - (size_t)jj * L0N); }
#pragma unroll
          for (int j = 0; j < 16; ++j) { const float mk = j < cnt ? 1.0f : 0.0f;
              sm[0] += mk * bflo(x[j].x); sm[1] += mk * bfhi(x[j].x); sm[2] += mk * bflo(x[j].y); sm[3] += mk * bfhi(x[j].y); sm[4] += mk * bflo(x[j].z); sm[5] += mk * bfhi(x[j].z); sm[6] += mk * bflo(x[j].w); sm[7] += mk * bfhi(x[j].w); } }
        v4u bw; bw.x = pk2(sm[0] * rc - bflo(self.x), sm[1] * rc - bfhi(self.x)); bw.y = pk2(sm[2] * rc - bflo(self.y), sm[3] * rc - bfhi(self.y));
        bw.z = pk2(sm[4] * rc - bflo(self.z), sm[5] * rc - bfhi(self.z)); bw.w = pk2(sm[6] * rc - bflo(self.w), sm[7] * rc - bfhi(self.w));
        const bf16x8 bfrag = __builtin_bit_cast(bf16x8, bw);
        asm volatile("" ::: "memory");
        bf16x8 af[8];
#pragma unroll
        for (int nt = 0; nt < 8; ++nt) af[nt] = *(const bf16x8*)(PW + (size_t)gg * 16384 + (16 * nt + li) * 128 + 32 * ks + 8 * g);
#pragma unroll
        for (int nt = 0; nt < 8; ++nt) acc[nt] = MFMA16(af[nt], bfrag, acc[nt]);
    }
    bf16* op = MIX + (size_t)m * D + 512 + 128 * gg + 4 * g;
#pragma unroll
    for (int nt = 0; nt < 8; ++nt) {
        const f32x4 sc = *(const f32x4*)(pscale + 128 * gg + 16 * nt + 4 * g);
        v2u wv; wv.x = pk2(acc[nt][0] * sc[0], acc[nt][1] * sc[1]); wv.y = pk2(acc[nt][2] * sc[2], acc[nt][3] * sc[3]); *(v2u*)(op + 16 * nt) = wv;
    }
}
__device__ __forceinline__ void att_compute(const AttUnit& a, LAS unsigned char* Ks, LAS unsigned char* Vs, bf16x8 q0, bf16x8 q1, int w, int li, int g, bf16* AP, float* LSE) {
        f32x4 s[9];
#pragma unroll
        for (int kt = 0; kt < 9; ++kt) {
            const LAS unsigned char* kp = Ks + (16 * (w + kt) + li) * KV_STRIDE + 16 * g;
            const bf16x8 a0 = *(const LAS bf16x8*)kp, a1 = *(const LAS bf16x8*)(kp + 64);
            f32x4 z = {0.f, 0.f, 0.f, 0.f};
            z = MFMA16(a0, q0, z); s[kt] = MFMA16(a1, q1, z);
        }
        float mx = -3.0e38f;
        const int d0 = 4 * g - li;
        if (a.nb == 0) {
#pragma unroll
            for (int kt = 0; kt < 9; ++kt) if (w + kt < 8) s[kt] = (f32x4){-3.0e38f, -3.0e38f, -3.0e38f, -3.0e38f};
        }
#pragma unroll
        for (int i = 0; i < 4; ++i) { s[0][i] = (d0 + i >= 0) ? s[0][i] : -3.0e38f; s[8][i] = (d0 + i <= 0) ? s[8][i] : -3.0e38f; }
#pragma unroll
        for (int kt = 0; kt < 9; ++kt)
#pragma unroll
            for (int i = 0; i < 4; ++i) mx = fmaxf(mx, s[kt][i]);
        mx = xmax16(mx); mx = xmax32(mx);
        float l = 0.f; unsigned pk[10][2];
#pragma unroll
        for (int kt = 0; kt < 9; ++kt) {
            float p[4];
#pragma unroll
            for (int i = 0; i < 4; ++i) { p[i] = __builtin_amdgcn_exp2f(s[kt][i] - mx); l += p[i]; }
            pk[kt][0] = pk2(p[0], p[1]); pk[kt][1] = pk2(p[2], p[3]);
        }
        pk[9][0] = 0u; pk[9][1] = 0u;
        l = xsum16(l); l = xsum32(l);
        f32x4 o[4];
#pragma unroll
        for (int mt = 0; mt < 4; ++mt) o[mt] = (f32x4){0.f, 0.f, 0.f, 0.f};
#pragma unroll
        for (int sI = 0; sI < 5; ++sI) {
            const v4u bw = {pk[2 * sI][0], pk[2 * sI][1], pk[2 * sI + 1][0], pk[2 * sI + 1][1]};
            const bf16x8 bfrag = __builtin_bit_cast(bf16x8, bw);
            const int t0 = w + 2 * sI, t1 = (w + 2 * sI + 1) > 15 ? 15 : (w + 2 * sI + 1);
            LAS unsigned char* v0 = Vs + (16 * t0 + 4 * g + (li >> 2)) * KV_STRIDE + 8 * (li & 3);
            LAS unsigned char* v1 = Vs + (16 * t1 + 4 * g + (li >> 2)) * KV_STRIDE + 8 * (li & 3);
#pragma unroll
            for (int mt = 0; mt < 4; ++mt) { const s16x4 x0 = tr16(v0 + 32 * mt); const bf16x8 af = cat4(x0, sI == 4 ? x0 : tr16(v1 + 32 * mt)); o[mt] = MFMA16(af, bfrag, o[mt]); }
        }
        const float rl = __builtin_amdgcn_rcpf(l);
        const int tq = a.b * T + (128 * a.nb + 16 * w + li) * a.d + a.r;
        bf16* op = AP + ((size_t)a.br * M + tq) * AW + 64 * a.h + 4 * g;
#pragma unroll
        for (int mt = 0; mt < 4; ++mt) { v2u wv; wv.x = pk2(o[mt][0] * rl, o[mt][1] * rl); wv.y = pk2(o[mt][2] * rl, o[mt][3] * rl); *(v2u*)(op + 16 * mt) = wv; }
        if (g == 0) LSE[((size_t)a.br * M + tq) * 8 + a.h] = mx * 0.6931471805599453f + __logf(l);
}
template <int WN> __device__ __forceinline__ void pool_body(const LAS unsigned char* urow, const LAS unsigned char* Wt, int t, int li, int g, f32x4 (&acc)[8]) {
    constexpr int PSTR = 272;
    const int cnt = (t + 1 < WN) ? t + 1 : WN; const float rc = 1.0f / (float)cnt;
#pragma unroll 1
    for (int ks = 0; ks < 4; ++ks) {
        float sm[8];
#pragma unroll
        for (int q = 0; q < 8; ++q) sm[q] = 0.f;
        const v4u self = *(const LAS v4u*)(urow + 64 * ks);
#pragma unroll
        for (int j = 0; j < WN; ++j) { const v4u x = *(const LAS v4u*)(urow + 64 * ks - j * PSTR); const float mk = j < cnt ? 1.0f : 0.0f;
            sm[0] += mk * bflo(x.x); sm[1] += mk * bfhi(x.x); sm[2] += mk * bflo(x.y); sm[3] += mk * bfhi(x.y); sm[4] += mk * bflo(x.z); sm[5] += mk * bfhi(x.z); sm[6] += mk * bflo(x.w); sm[7] += mk * bfhi(x.w); }
        v4u bw; bw.x = pk2(sm[0] * rc - bflo(self.x), sm[1] * rc - bfhi(self.x)); bw.y = pk2(sm[2] * rc - bflo(self.y), sm[3] * rc - bfhi(self.y));
        bw.z = pk2(sm[4] * rc - bflo(self.z), sm[5] * rc - bfhi(self.z)); bw.w = pk2(sm[6] * rc - bflo(self.w), sm[7] * rc - bfhi(self.w));
        const bf16x8 bfrag = __builtin_bit_cast(bf16x8, bw);
#pragma unroll
        for (int nt = 0; nt < 8; ++nt) acc[nt] = MFMA16(*(const LAS bf16x8*)(Wt + (16 * nt + li) * PSTR + 64 * ks + 16 * g), bfrag, acc[nt]);
    }
}
__device__ __forceinline__ void ph_attn_pool(Frame& F) {
    const bf16* P0 = WSP(const bf16, WS_PROJ0); bf16* AP = WSP(bf16, WS_ATTP); float* LSE = WSP(float, WS_LSE);
    LAS unsigned char* Ks = F.lds; LAS unsigned char* Vs = F.lds + 256 * KV_STRIDE;
    const int lane = F.lane, w = F.wave, li = lane & 15, g = lane >> 4, tid = F.tid;
    v4u krA[4], vrA[4], qrA[2], krB[4], vrB[4], qrB[2];
    const int c8 = tid & 7, row0 = tid >> 3;
    int u = F.blk;
    { const AttUnit a = att_decode(u < ATT_UNITS ? u : 0); att_issue(P0, a, tid, w, lane, krA, vrA, qrA); }
    { const AttUnit a = att_decode(u + GRID < ATT_UNITS ? u + GRID : 0); att_issue(P0, a, tid, w, lane, krB, vrB, qrB); }
#define ATT_BAR() do { asm volatile("s_waitcnt lgkmcnt(0)" ::: "memory"); __builtin_amdgcn_s_barrier(); asm volatile("" ::: "memory"); } while (0)
#define ATT_STEP(KR, VR, QR, UU) do { \
        const AttUnit a_ = att_decode(UU); \
        _Pragma("unroll") for (int i_ = 0; i_ < 4; ++i_) { *(LAS v4u*)(Ks + (row0 + 64 * i_) * KV_STRIDE + c8 * 16) = KR[i_]; *(LAS v4u*)(Vs + (row0 + 64 * i_) * KV_STRIDE + c8 * 16) = VR[i_]; } \
        const bf16x8 q0_ = __builtin_bit_cast(bf16x8, QR[0]), q1_ = __builtin_bit_cast(bf16x8, QR[1]); \
        ATT_BAR(); \
        { const int un_ = (UU) + 2 * GRID; const AttUnit an_ = att_decode(un_ < ATT_UNITS ? un_ : 0); att_issue(P0, an_, tid, w, lane, KR, VR, QR); } \
        att_compute(a_, Ks, Vs, q0_, q1_, w, li, g, AP, LSE); \
        if (PROBE_ATT2) { asm volatile("" ::: "memory"); att_compute(a_, Ks, Vs, q0_, q1_, w, li, g, AP, LSE); } \
        ATT_BAR(); } while (0)
#pragma unroll 1
    for (; u < ATT_UNITS; u += 2 * GRID) {
        ATT_STEP(krA, vrA, qrA, u);
        if (u + GRID < ATT_UNITS) ATT_STEP(krB, vrB, qrB, u + GRID);
    }
#undef ATT_STEP
#undef ATT_BAR
    asm volatile("s_waitcnt vmcnt(0)" ::: "memory"); __syncthreads();
    {
        const bf16* PW = WSP(const bf16, WS_POOLWT); bf16* MIX = WSP(bf16, WS_MIX);
        constexpr int PSTR = 272;
        LAS unsigned char* Ut = F.lds; LAS unsigned char* Wt = F.lds + 143 * PSTR + 16;
        v4u ur[5], wr[4];
#define POOL_GG(PU) (((PU) >> 8) ? 3 - (((PU) >> 7) & 1) : ((PU) >> 7))
#define POOL_ISSUE(PU) do { const int tile_ = (PU) & 127, gg_ = POOL_GG(PU); const int m0_ = tile_ * 128, lo_ = (m0_ / T) * T; \
            _Pragma("unroll") for (int i_ = 0; i_ < 5; ++i_) { int p_ = tid + 512 * i_; p_ = p_ < 143 * 16 ? p_ : 143 * 16 - 1; int mr_ = m0_ - 15 + (p_ >> 4); mr_ = mr_ < lo_ ? lo_ : mr_; \
                ur[i_] = *(const v4u*)(P0 + (size_t)mr_ * L0N + 1536 + 128 * gg_ + (p_ & 15) * 8); } \
            _Pragma("unroll") for (int i_ = 0; i_ < 4; ++i_) { const int p_ = tid + 512 * i_; wr[i_] = *(const v4u*)(PW + (size_t)gg_ * 16384 + (p_ >> 4) * 128 + (p_ & 15) * 8); } } while (0)
        int pu = F.blk;
        POOL_ISSUE(pu);
#pragma unroll 1
        for (; pu < 512; pu += GRID) {
            const int tile = pu & 127, gg = POOL_GG(pu);
#pragma unroll
            for (int i = 0; i < 5; ++i) { const int p = tid + 512 * i; if (p < 143 * 16) *(LAS v4u*)(Ut + (p >> 4) * PSTR + (p & 15) * 16) = ur[i]; }
#pragma unroll
            for (int i = 0; i < 4; ++i) { const int p = tid + 512 * i; *(LAS v4u*)(Wt + (p >> 4) * PSTR + (p & 15) * 16) = wr[i]; }
            __syncthreads();
            if (pu + GRID < 512) POOL_ISSUE(pu + GRID);
            const int m = tile * 128 + 16 * w + li, t = m % T;
            const LAS unsigned char* urow = Ut + (16 * w + li + 15) * PSTR + 16 * g;
            f32x4 acc[8];
#pragma unroll
            for (int nt = 0; nt < 8; ++nt) acc[nt] = (f32x4){0.f, 0.f, 0.f, 0.f};
            if (gg == 0) pool_body<2>(urow, Wt, t, li, g, acc); else if (gg == 1) pool_body<4>(urow, Wt, t, li, g, acc); else if (gg == 2) pool_body<8>(urow, Wt, t, li, g, acc); else pool_body<16>(urow, Wt, t, li, g, acc);
            bf16* op = MIX + (size_t)m * D + 512 + 128 * gg + 4 * g;
#pragma unroll
            for (int nt = 0; nt < 8; ++nt) {
                const f32x4 sc = *(const f32x4*)(F.e_pool_scale + 128 * gg + 16 * nt + 4 * g);
                v2u wv; wv.x = pk2(acc[nt][0] * sc[0], acc[nt][1] * sc[1]); wv.y = pk2(acc[nt][2] * sc[2], acc[nt][3] * sc[3]); *(v2u*)(op + 16 * nt) = wv;
            }
            __syncthreads();
        }
#undef POOL_ISSUE
#undef POOL_GG
    }
}
__device__ __forceinline__ void ph_attn_combine(Frame& F) {
    const bf16* AP = WSP(const bf16, WS_ATTP); const float* LSE = WSP(const float, WS_LSE); bf16* MIX = WSP(bf16, WS_MIX);
    const int m0 = F.blk * RPB + F.wave * 8, h = F.lane >> 3;
    v4u an, bn, cn; float l0n, l1n, l2n;
#define CMB_LOAD(M_) do { l0n = LSE[((size_t)0 * M + (M_)) * 8 + h]; l1n = LSE[((size_t)1 * M + (M_)) * 8 + h]; l2n = LSE[((size_t)2 * M + (M_)) * 8 + h]; \
        an = __builtin_nontemporal_load((const v4u*)(AP + ((size_t)0 * M + (M_)) * AW) + F.lane); bn = __builtin_nontemporal_load((const v4u*)(AP + ((size_t)1 * M + (M_)) * AW) + F.lane); cn = __builtin_nontemporal_load((const v4u*)(AP + ((size_t)2 * M + (M_)) * AW) + F.lane); } while (0)
    CMB_LOAD(m0);
#pragma unroll 1
    for (int i = 0; i < 8; ++i) {
        const int m = m0 + i;
        const v4u a = an, b = bn, c = cn; const float l0 = l0n, l1 = l1n, l2 = l2n;
        if (i < 7) CMB_LOAD(m + 1);
        const float mx = fmaxf(l0, fmaxf(l1, l2)), e0 = __expf(l0 - mx), e1 = __expf(l1 - mx), e2 = __expf(l2 - mx), rs = __builtin_amdgcn_rcpf(e0 + e1 + e2);
        const float w0 = e0 * rs, w1 = e1 * rs, w2 = e2 * rs;
        v4u o;
        o.x = pk2(w0 * bflo(a.x) + w1 * bflo(b.x) + w2 * bflo(c.x), w0 * bfhi(a.x) + w1 * bfhi(b.x) + w2 * bfhi(c.x));
        o.y = pk2(w0 * bflo(a.y) + w1 * bflo(b.y) + w2 * bflo(c.y), w0 * bfhi(a.y) + w1 * bfhi(b.y) + w2 * bfhi(c.y));
        o.z = pk2(w0 * bflo(a.z) + w1 * bflo(b.z) + w2 * bflo(c.z), w0 * bfhi(a.z) + w1 * bfhi(b.z) + w2 * bfhi(c.z));
        o.w = pk2(w0 * bflo(a.w) + w1 * bflo(b.w) + w2 * bflo(c.w), w0 * bfhi(a.w) + w1 * bfhi(b.w) + w2 * bfhi(c.w));
        *((v4u*)(MIX + (size_t)m * D) + F.lane) = o;
    }
#undef CMB_LOAD
}
#ifndef PROBE_CP
#define PROBE_CP 0
#endif
constexpr int CP_STR = 272, CP_IMG = 64 * CP_STR;
constexpr int IMG_KB = 0, IMG_K = CP_IMG, IMG_Q = 2 * CP_IMG, IMG_VB = 3 * CP_IMG, IMG_KBG = 4 * CP_IMG, IMG_KG = 5 * CP_IMG, CP_GATES = 6 * CP_IMG;
constexpr int NM_STR = 144, NM_IMG = 64 * NM_STR;
__device__ __forceinline__ bf16x8 ldsb128(const LAS unsigned char* p) { return *(const LAS bf16x8*)p; }
__device__ __forceinline__ bf16x8 tr_pair(LAS unsigned char* p, int step) { return cat4(tr16(p), tr16(p + step)); }
__device__ __forceinline__ v2u pk4(f32x4 v) { v2u r; r.x = pk2(v[0], v[1]); r.y = pk2(v[2], v[3]); return r; }

struct CpIn { v4u x[3][4][2]; v4u wv; float bl, al, alog, dtb; };
__device__ __forceinline__ void cp_issue(Frame& F, int un, int tid, CpIn& I) {
    const bf16* QKV = WSP(const bf16, WS_QKV); const float* BL = WSP(const float, WS_BL);
    const int b = un >> 10, h = (un >> 7) & 7, c = un & 127, row = tid >> 3, cg = tid & 7, t = c * CH + row;
#pragma unroll
    for (int mat = 0; mat < 3; ++mat)
#pragma unroll
        for (int j = 0; j < 4; ++j) {
            int tt = t - 3 + j; tt = tt < 0 ? 0 : tt;
            const v4u* p = (const v4u*)(QKV + ((size_t)b * T + tt) * 3072 + mat * 1024 + 128 * h + 16 * cg);
            I.x[mat][j][0] = p[0]; I.x[mat][j][1] = p[1];
        }
    { const int idx = tid < 384 ? tid : 383, j = idx / 96, r = idx % 96, mat = r >> 5, c4 = r & 31;
      I.wv = *(const v4u*)(F.o_conv_w + j * 3072 + mat * 1024 + 128 * h + 4 * c4); }
    const size_t mrow = (size_t)b * T + (size_t)c * CH + (tid & 63);
    I.bl = BL[mrow * 16 + h]; I.al = BL[mrow * 16 + 8 + h]; I.alog = F.o_a_log[h]; I.dtb = F.o_dt_bias[h];
}
#define CP_BAR() do { asm volatile("s_waitcnt lgkmcnt(0)" ::: "memory"); __builtin_amdgcn_s_barrier(); asm volatile("" ::: "memory"); } while (0)
__device__ __forceinline__ void ph_chunk_prep(Frame& F) {
    unsigned char* WFp = F.ws + WS_WF; unsigned char* QGp = F.ws + WS_QGF; unsigned char* KGp = F.ws + WS_KGF; unsigned char* ATp = F.ws + WS_ATF; unsigned char* UFp = F.ws + WS_UF;
    float* CDEC = WSP(float, WS_CDEC);
    LAS unsigned char* L = F.lds; LAS float* gcs = (LAS float*)(L + CP_GATES); LAS float* betas = gcs + 64;
    LAS float* wcv = (LAS float*)(L + CP_GATES + 2048);
    const int w = F.wave;
#define CP_S0(UN) do { const int un_ = (UN); \
        if (w == 0) { const int lane_ = F.lane; \
            float gl = -__expf(I.alog) * softplus_f(I.al + I.dtb); \
              \
            DPP_ADD(gl, 0x111); DPP_ADD(gl, 0x112); DPP_ADD(gl, 0x114); DPP_ADD(gl, 0x118); \
            { const int gi = __builtin_bit_cast(int, gl); \
              const float t0 = __builtin_bit_cast(float, __builtin_amdgcn_readlane(gi, 15)), t1 = __builtin_bit_cast(float, __builtin_amdgcn_readlane(gi, 31)), t2 = __builtin_bit_cast(float, __builtin_amdgcn_readlane(gi, 47)); \
              const int rr = lane_ >> 4; gl += (rr >= 1 ? t0 : 0.f) + (rr >= 2 ? t1 : 0.f) + (rr >= 3 ? t2 : 0.f); } \
            gcs[lane_] = gl; betas[lane_] = sigmoid_f(I.bl); \
            if (lane_ == 63) CDEC[un_] = __expf(gl); } \
        if (F.tid < 384) *(LAS v4u*)(wcv + 4 * F.tid) = I.wv; } while (0)
    CpIn I; cp_issue(F, F.blk, F.tid, I);
    CP_S0(F.blk);
    CP_BAR();
#pragma unroll 1
    for (int un = F.blk; un < NB * DH * NCH; un += GRID) {
        int tid = F.tid; asm volatile("" : "+v"(tid));
        const int lane = tid & 63, li = lane & 15, g = lane >> 4;
        const int c = un & 127;
        const int unn = un + GRID < NB * DH * NCH ? un + GRID : un;
        for (int rp_ = 0; rp_ < (PROBE_CP == 1 ? 2 : 1); ++rp_) {
        {
            const int row = tid >> 3, cg = tid & 7, t = c * CH + row;
            const float gcr = gcs[row], beta = betas[row], eg = __expf(gcr), ekl = __expf(gcs[63] - gcr);
            const int off = row * CP_STR + cg * 32;
#define ST_IMG(IMG, P) do { *(LAS v4u*)(L + (IMG) + off) = (v4u){P[0], P[1], P[2], P[3]}; *(LAS v4u*)(L + (IMG) + off + 16) = (v4u){P[4], P[5], P[6], P[7]}; } while (0)
#pragma unroll
            for (int mat = 0; mat < 3; ++mat) {
                f32x2 ac2[8];
#pragma unroll
                for (int e = 0; e < 8; ++e) ac2[e] = (f32x2){0.f, 0.f};
                f32x4 wq[4][4];
#pragma unroll
                for (int j = 0; j < 4; ++j) { const LAS f32x4* wp = (const LAS f32x4*)(wcv + (j * 3 + mat) * 128 + 16 * cg); wq[j][0] = wp[0]; wq[j][1] = wp[1]; wq[j][2] = wp[2]; wq[j][3] = wp[3]; }
                __builtin_amdgcn_sched_barrier(0);
#pragma unroll
                for (int j = 0; j < 4; ++j) {
                    v4u x0 = I.x[mat][j][0], x1 = I.x[mat][j][1];
                    if (c == 0) { const bool okr = (t - 3 + j) >= 0; const v4u z = {0u, 0u, 0u, 0u}; x0 = okr ? x0 : z; x1 = okr ? x1 : z; }
                    const unsigned xw[8] = {x0.x, x0.y, x0.z, x0.w, x1.x, x1.y, x1.z, x1.w};
#pragma unroll
                    for (int e = 0; e < 8; ++e) { const f32x2 xv = {bflo(xw[e]), bfhi(xw[e])}; const f32x2 wv = {wq[j][e >> 1][2 * (e & 1)], wq[j][e >> 1][2 * (e & 1) + 1]}; ac2[e] += wv * xv; }
                }
                float acc[16];
#pragma unroll
                for (int e = 0; e < 8; ++e) { acc[2 * e] = ac2[e].x; acc[2 * e + 1] = ac2[e].y; }
                float ss = 0.f;
#pragma unroll
                for (int e = 0; e < 16; ++e) { acc[e] = silu_f(acc[e]); ss += acc[e] * acc[e]; }
                ss = row8_sum(ss);
                const float rn = 1.0f / sqrtf(ss + EPS);
                if (mat == 0) {
                    const float rq = rn * 0.08838834764831845f;
                    unsigned pq[8], pqg[8];
#pragma unroll
                    for (int e = 0; e < 8; ++e) { const float q0 = acc[2 * e] * rq, q1 = acc[2 * e + 1] * rq; pq[e] = pk2(q0, q1); pqg[e] = pk2(q0 * eg, q1 * eg); }
                    ST_IMG(IMG_Q, pq);
                    unsigned char* qgb = QGp + (size_t)un * 16384 + (((row >> 4) * 4 + (cg >> 1)) * 64 + (row & 15)) * 16 + (cg & 1) * 8;
#pragma unroll
                    for (int gp = 0; gp < 4; ++gp) __builtin_nontemporal_store((v2u){pqg[2 * gp], pqg[2 * gp + 1]}, (v2u*)(qgb + gp * 16 * 16));
                } else if (mat == 1) {
                    unsigned pk_[8], pkb[8], pkbg[8], pkg[8];
#pragma unroll
                    for (int e = 0; e < 8; ++e) { const float k0 = acc[2 * e] * rn, k1 = acc[2 * e + 1] * rn; pk_[e] = pk2(k0, k1); pkb[e] = pk2(k0 * beta, k1 * beta);
                        pkbg[e] = pk2(k0 * beta * eg, k1 * beta * eg); pkg[e] = pk2(k0 * ekl, k1 * ekl); }
                    ST_IMG(IMG_K, pk_); ST_IMG(IMG_KB, pkb); ST_IMG(IMG_KBG, pkbg); ST_IMG(IMG_KG, pkg);
                } else {
                    unsigned pvb[8];
#pragma unroll
                    for (int e = 0; e < 8; ++e) pvb[e] = pk2(acc[2 * e] * beta, acc[2 * e + 1] * beta);
                    ST_IMG(IMG_VB, pvb);
                }
                asm volatile("" ::: "memory");
            }
#undef ST_IMG
        }
        }
        cp_issue(F, unn, tid, I);
        CP_BAR();
        f32x4 m1[4];
        if (w < 4) {
            const int it = w;
            bf16x8 fa[4], fb[4][4];
#pragma unroll
            for (int ks = 0; ks < 4; ++ks) fa[ks] = ldsb128(L + IMG_KB + (16 * it + li) * CP_STR + (32 * ks + 8 * g) * 2);
#pragma unroll
            for (int nt = 0; nt < 4; ++nt)
#pragma unroll
                for (int ks = 0; ks < 4; ++ks) fb[nt][ks] = ldsb128(L + IMG_K + (16 * nt + li) * CP_STR + (32 * ks + 8 * g) * 2);
            __builtin_amdgcn_sched_barrier(0);
#pragma unroll
            for (int nt = 0; nt < 4; ++nt) {
                f32x4 acc = {0.f, 0.f, 0.f, 0.f};
#pragma unroll
                for (int ks = 0; ks < 4; ++ks) acc = MFMA16(fa[ks], fb[nt][ks], acc);
                const int j = 16 * nt + li; const float gj = gcs[j]; const f32x4 giv = *(const LAS f32x4*)(gcs + 16 * it + 4 * g);
#pragma unroll
                for (int i2 = 0; i2 < 4; ++i2) { const int i = 16 * it + 4 * g + i2; const float e = __expf(fminf(giv[i2] - gj, 0.f)); m1[nt][i2] = (i > j) ? -acc[i2] * e : 0.f; }
            }
        } else {
            const int it = w - 4, i = 16 * it + li; const float gi = gcs[i];
            v2u fr[4];
            bf16x8 fq[4], fk[4][4];
#pragma unroll
            for (int ks = 0; ks < 4; ++ks) fq[ks] = ldsb128(L + IMG_Q + (16 * it + li) * CP_STR + (32 * ks + 8 * g) * 2);
#pragma unroll
            for (int jt = 0; jt < 4; ++jt)
#pragma unroll
                for (int ks = 0; ks < 4; ++ks) fk[jt][ks] = ldsb128(L + IMG_K + (16 * jt + li) * CP_STR + (32 * ks + 8 * g) * 2);
            __builtin_amdgcn_sched_barrier(0);
#pragma unroll
            for (int jt = 0; jt < 4; ++jt) {
                f32x4 acc = {0.f, 0.f, 0.f, 0.f};
#pragma unroll
                for (int ks = 0; ks < 4; ++ks) acc = MFMA16(fk[jt][ks], fq[ks], acc);
                const f32x4 gjv = *(const LAS f32x4*)(gcs + 16 * jt + 4 * g);
#pragma unroll
                for (int i2 = 0; i2 < 4; ++i2) { const int j = 16 * jt + 4 * g + i2; const float e = __expf(fminf(gi - gjv[i2], 0.f)); acc[i2] = (j <= i) ? acc[i2] * e : 0.f; }
                fr[jt] = pk4(acc);
            }
            unsigned char* ab = ATp + (size_t)un * 8192 + ((it * 2) * 64 + lane) * 16;
            __builtin_nontemporal_store((v4u){fr[0].x, fr[0].y, fr[1].x, fr[1].y}, (v4u*)ab); __builtin_nontemporal_store((v4u){fr[2].x, fr[2].y, fr[3].x, fr[3].y}, (v4u*)(ab + 1024));
        }
        CP_BAR();
        LAS float* Md = (LAS float*)(L + CP_GATES + 1024);
        LAS unsigned char* Tt = L + 3 * NM_IMG;
        if (w < 4) {
#pragma unroll
            for (int nt = 0; nt < 4; ++nt) { const int o = (16 * nt + li) * NM_STR + (16 * w + 4 * g) * 2; *(LAS v2u*)(L + o) = pk4(m1[nt]); if (nt > w) *(LAS v2u*)(Tt + o) = (v2u){0u, 0u}; }
#pragma unroll
            for (int nt = 0; nt < 4; ++nt) if (nt == w) {
#pragma unroll
                for (int i2 = 0; i2 < 4; ++i2) Md[w * 256 + (4 * g + i2) * 16 + li] = m1[nt][i2]; }
        } else {
#pragma unroll
            for (int q = 0; q < 4; ++q) {
                const int f = (w - 4) * 4 + q, dkt = f >> 1, ks2 = f & 1;
                LAS unsigned char* p = L + IMG_KG + (32 * ks2 + 4 * g + (li >> 2)) * CP_STR + (16 * dkt + 4 * (li & 3)) * 2;
                const bf16x8 fr = tr_pair(p, 16 * CP_STR);
                *(bf16x8*)(KGp + (size_t)un * 16384 + ((dkt * 2 + ks2) * 64 + lane) * 16) = fr;
            }
        }
        CP_BAR();
        if (w == 0) {
            float xv[16];
#pragma unroll
            for (int i = 0; i < 16; ++i) {
                float a = (i == li) ? 1.0f : 0.0f;
#pragma unroll
                for (int k4 = 0; k4 < (i + 3) / 4; ++k4) {
                    const f32x4 mv = *(const LAS f32x4*)(Md + g * 256 + i * 16 + 4 * k4);
#pragma unroll
                    for (int e = 0; e < 4; ++e) if (4 * k4 + e < i) a += mv[e] * xv[4 * k4 + e];
                }
                xv[i] = a;
            }
            v4u lo, hi;
            lo.x = pk2(xv[0], xv[1]); lo.y = pk2(xv[2], xv[3]); lo.z = pk2(xv[4], xv[5]); lo.w = pk2(xv[6], xv[7]);
            hi.x = pk2(xv[8], xv[9]); hi.y = pk2(xv[10], xv[11]); hi.z = pk2(xv[12], xv[13]); hi.w = pk2(xv[14], xv[15]);
            LAS unsigned char* d = Tt + (16 * g + li) * NM_STR + (16 * g) * 2;
            *(LAS v4u*)d = lo; *(LAS v4u*)(d + 16) = hi;
        }
        CP_BAR();
        const bf16x8 zf = {0, 0, 0, 0, 0, 0, 0, 0};
        if (w < 2) {
            const int p = w;
            bf16x8 af = tr_pair(L + (32 * p + 8 * g + (li >> 2)) * NM_STR + (32 * p + 16 + 4 * (li & 3)) * 2, 4 * NM_STR);
            bf16x8 bfr = ldsb128(Tt + (32 * p + li) * NM_STR + (32 * p + 8 * g) * 2);
            if (g >= 2) { af = zf; bfr = zf; }
            f32x4 a = {0.f, 0.f, 0.f, 0.f}; a = MFMA16(af, bfr, a);
            *(LAS v2u*)(L + 1 * NM_IMG + (16 * p + li) * NM_STR + (4 * g) * 2) = pk4(a);
        }
        CP_BAR();
        if (w < 2) {
            const int p = w;
            bf16x8 af = tr_pair(Tt + (32 * p + 16 + 8 * g + (li >> 2)) * NM_STR + (32 * p + 16 + 4 * (li & 3)) * 2, 4 * NM_STR);
            bf16x8 bfr = ldsb128(L + 1 * NM_IMG + (16 * p + li) * NM_STR + (8 * g) * 2);
            if (g >= 2) { af = zf; bfr = zf; }
            f32x4 a = {0.f, 0.f, 0.f, 0.f}; a = MFMA16(af, bfr, a);
            *(LAS v2u*)(Tt + (32 * p + li) * NM_STR + (32 * p + 16 + 4 * g) * 2) = pk4(a);
        }
        CP_BAR();
        if (w < 4) {
            const int ti = w >> 1, tn = w & 1;
            const bf16x8 af = tr_pair(L + (8 * g + (li >> 2)) * NM_STR + (32 + 16 * ti + 4 * (li & 3)) * 2, 4 * NM_STR);
            const bf16x8 bfr = ldsb128(Tt + (16 * tn + li) * NM_STR + (8 * g) * 2);
            f32x4 a = {0.f, 0.f, 0.f, 0.f}; a = MFMA16(af, bfr, a);
            *(LAS v2u*)(L + 2 * NM_IMG + (16 * tn + li) * NM_STR + (16 * ti + 4 * g) * 2) = pk4(a);
        }
        CP_BAR();
        if (w < 4) {
            const int ti = w >> 1, tn = w & 1;
            const bf16x8 af = tr_pair(Tt + (32 + 8 * g + (li >> 2)) * NM_STR + (32 + 16 * ti + 4 * (li & 3)) * 2, 4 * NM_STR);
            const bf16x8 bfr = ldsb128(L + 2 * NM_IMG + (16 * tn + li) * NM_STR + (8 * g) * 2);
            f32x4 a = {0.f, 0.f, 0.f, 0.f}; a = MFMA16(af, bfr, a);
            *(LAS v2u*)(Tt + (16 * tn + li) * NM_STR + (32 + 16 * ti + 4 * g) * 2) = pk4(a);
        }
        CP_BAR();
#pragma unroll
        for (int mat = 0; mat < 3; ++mat)
#pragma unroll
            for (int j = 0; j < 4; ++j) { asm volatile("" :: "v"(I.x[mat][j][0])); asm volatile("" :: "v"(I.x[mat][j][1])); }
        asm volatile("" :: "v"(I.wv)); asm volatile("" :: "v"(I.bl)); asm volatile("" :: "v"(I.al)); asm volatile("" :: "v"(I.alog)); asm volatile("" :: "v"(I.dtb));
        CP_S0(unn);
        for (int rp_ = 0; rp_ < (PROBE_CP == 3 ? 2 : 1); ++rp_) {
        {
            bf16x8 tf[4][2];
#pragma unroll
            for (int it = 0; it < 4; ++it)
#pragma unroll
                for (int ks = 0; ks < 2; ++ks) tf[it][ks] = tr_pair(Tt + (32 * ks + 8 * g + (li >> 2)) * NM_STR + (16 * it + 4 * (li & 3)) * 2, 4 * NM_STR);
            bf16x8 vbf[2], kbf[2];
#pragma unroll
            for (int ks = 0; ks < 2; ++ks) {
                const int o = (32 * ks + 8 * g + (li >> 2)) * CP_STR + (16 * w + 4 * (li & 3)) * 2;
                vbf[ks] = tr_pair(L + IMG_VB + o, 4 * CP_STR); kbf[ks] = tr_pair(L + IMG_KBG + o, 4 * CP_STR);
            }
#pragma unroll
            for (int it = 0; it < 4; ++it) {
                f32x4 a = {0.f, 0.f, 0.f, 0.f}; a = MFMA16(tf[it][0], vbf[0], a); a = MFMA16(tf[it][1], vbf[1], a);
                __builtin_nontemporal_store(pk4(a), (v2u*)(UFp + (size_t)un * 16384 + ((w * 4 + it) * 64 + lane) * 8));
                f32x4 d = {0.f, 0.f, 0.f, 0.f}; d = MFMA16(kbf[0], tf[it][0], d); d = MFMA16(kbf[1], tf[it][1], d);
                *(v2u*)(WFp + (size_t)un * 16384 + ((it * 4 + (w >> 1)) * 64 + lane) * 16 + (w & 1) * 8) = pk4(-d);
            }
        }
        }
        CP_BAR();
    }
}

#undef CP_BAR
#undef CP_S0
constexpr int SC_SLOT = 35840;
#define SB_() __builtin_amdgcn_sched_barrier(0)
__device__ __forceinline__ void scan_compute(const LAS unsigned char* B, f32x4 (&S)[8], float dc, unsigned char* sbp, unsigned char* vbp, int lane) {
    const LAS unsigned char* Bl = B + lane * 16;
    bf16x8 h0[8], h1[8];
    f32x4 vn[4];
#pragma unroll
    for (int mt = 0; mt < 4; ++mt) { h0[2 * mt] = ldsb128(Bl + (mt * 4 + 0) * 1024); h0[2 * mt + 1] = ldsb128(Bl + (mt * 4 + 1) * 1024); }
#pragma unroll
    for (int mt = 0; mt < 4; ++mt) { const v2u uw = *(const LAS v2u*)(B + 32768 + (mt * 64 + lane) * 8); vn[mt] = (f32x4){bflo(uw.x), bfhi(uw.x), bflo(uw.y), bfhi(uw.y)}; }
#pragma unroll
    for (int mt = 0; mt < 4; ++mt) { h1[2 * mt] = ldsb128(Bl + (mt * 4 + 2) * 1024); h1[2 * mt + 1] = ldsb128(Bl + (mt * 4 + 3) * 1024); }
    bf16x8 Sb[4];
#pragma unroll
    for (int ks = 0; ks < 4; ++ks) { const v2u lo = pk4(S[2 * ks]), hi = pk4(S[2 * ks + 1]); Sb[ks] = __builtin_bit_cast(bf16x8, (v4u){lo.x, lo.y, hi.x, hi.y}); *(bf16x8*)(sbp + ks * 1024) = Sb[ks]; }
    SB_();
#pragma unroll
    for (int k2 = 0; k2 < 2; ++k2)
#pragma unroll
        for (int mt = 0; mt < 4; ++mt) vn[mt] = MFMA16(h0[2 * mt + k2], Sb[k2], vn[mt]);
    SB_();
#pragma unroll
    for (int d = 0; d < 4; ++d) { h0[2 * d] = ldsb128(Bl + 16384 + (d * 2) * 1024); h0[2 * d + 1] = ldsb128(Bl + 16384 + (d * 2 + 1) * 1024); }
    SB_();
#pragma unroll
    for (int k2 = 0; k2 < 2; ++k2)
#pragma unroll
        for (int mt = 0; mt < 4; ++mt) vn[mt] = MFMA16(h1[2 * mt + k2], Sb[2 + k2], vn[mt]);
    SB_();
#pragma unroll
    for (int d = 0; d < 4; ++d) { h1[2 * d] = ldsb128(Bl + 16384 + ((d + 4) * 2) * 1024); h1[2 * d + 1] = ldsb128(Bl + 16384 + ((d + 4) * 2 + 1) * 1024); }
    bf16x8 vb[2];
#pragma unroll
    for (int ks = 0; ks < 2; ++ks) { const v2u lo = pk4(vn[2 * ks]), hi = pk4(vn[2 * ks + 1]); vb[ks] = __builtin_bit_cast(bf16x8, (v4u){lo.x, lo.y, hi.x, hi.y}); *(bf16x8*)(vbp + ks * 1024) = vb[ks]; }
#pragma unroll
    for (int d = 0; d < 8; ++d) S[d] = S[d] * dc;
    SB_();
#pragma unroll
    for (int ks = 0; ks < 2; ++ks)
#pragma unroll
        for (int d = 0; d < 4; ++d) S[d] = MFMA16(h0[2 * d + ks], vb[ks], S[d]);
#pragma unroll
    for (int ks = 0; ks < 2; ++ks)
#pragma unroll
        for (int d = 0; d < 4; ++d) S[4 + d] = MFMA16(h1[2 * d + ks], vb[ks], S[4 + d]);
    SB_();
}
#undef SB_
#define SCAN_LOAD(R, CHK) do { const size_t un_ = (size_t)(bh * 128 + ((CHK) < NCH ? (CHK) : NCH - 1)); _Pragma("unroll") for (int i_ = 0; i_ < 5; ++i_) R[i_] = *(const v4u*)(F.ws + bo[i_] + un_ * 16384u); } while (0)
#define SCAN_STORE(R, SLOT) do { LAS unsigned char* Bn_ = L + (SLOT) * SC_SLOT + lt * 16; _Pragma("unroll") for (int i_ = 0; i_ < 5; ++i_) *(LAS v4u*)(Bn_ + i_ * 448 * 16) = R[i_]; } while (0)
#define SCAN_BAR() do { asm volatile("s_waitcnt lgkmcnt(0)" ::: "memory"); __builtin_amdgcn_s_barrier(); asm volatile("" ::: "memory"); } while (0)
__device__ __forceinline__ void ph_scan(Frame& F) {
    if (F.blk < 128) {
        const int x = F.blk & 7, qq = F.blk >> 3, bh = x + 8 * (qq >> 3), s = qq & 7;
        const int lane = F.lane, w = F.wave;
        LAS unsigned char* L = F.lds;
        const float* CDEC = WSP(const float, WS_CDEC);
        if (w == 0) {
            unsigned char* sbp = F.ws + WS_SBF + ((size_t)(bh * 128) * 8 + s) * 4096 + lane * 16;
            unsigned char* vbp = F.ws + WS_VBF + ((size_t)(bh * 128) * 8 + s) * 2048 + lane * 16;
            f32x4 S[8];
#pragma unroll
            for (int d = 0; d < 8; ++d) S[d] = (f32x4){0.f, 0.f, 0.f, 0.f};
            float dnext = CDEC[bh * 128];
            SCAN_BAR();
#pragma unroll 1
            for (int c = 0; c < NCH; c += 2) {
                { const float dc = dnext; dnext = CDEC[bh * 128 + c + 1]; scan_compute(L, S, dc, sbp + (size_t)c * 32768, vbp + (size_t)c * 16384, lane); }
                SCAN_BAR();
                { const float dc = dnext; dnext = CDEC[bh * 128 + (c + 2 < NCH ? c + 2 : NCH - 1)]; scan_compute(L + SC_SLOT, S, dc, sbp + (size_t)(c + 1) * 32768, vbp + (size_t)(c + 1) * 16384, lane); }
                SCAN_BAR();
            }
        } else {
            const int lt = (w - 1) * 64 + lane;
            unsigned bo[5];
#pragma unroll
            for (int i = 0; i < 5; ++i) {
                int j = lt + 448 * i; j = j < 2176 ? j : 2175;
                unsigned o = (unsigned)WS_WF + (unsigned)j * 16u;
                if (j >= 1024) o = (unsigned)WS_KGF + (unsigned)(j - 1024) * 16u;
                if (j >= 2048) o = (unsigned)WS_UF + (unsigned)s * 2048u + (unsigned)(j - 2048) * 16u;
                bo[i] = o;
            }
            v4u rA[5], rB[5], rC[5], rD[5];
            SCAN_LOAD(rA, 0); SCAN_STORE(rA, 0); SCAN_LOAD(rA, 1); SCAN_LOAD(rB, 2); SCAN_LOAD(rC, 3); SCAN_LOAD(rD, 4);
            SCAN_BAR();
#pragma unroll 1
            for (int c = 0; c < NCH; c += 4) {
                SCAN_STORE(rA, 1); SCAN_LOAD(rA, c + 5); SCAN_BAR();
                SCAN_STORE(rB, 0); SCAN_LOAD(rB, c + 6); SCAN_BAR();
                SCAN_STORE(rC, 1); SCAN_LOAD(rC, c + 7); SCAN_BAR();
                SCAN_STORE(rD, 0); SCAN_LOAD(rD, c + 8); SCAN_BAR();
            }
        }
    } else {
#if CONV_IN_SCAN
        ph_weights_moe_blk(F, F.blk - 128, 128);
#endif
    }
}
#undef SCAN_LOAD
#undef SCAN_STORE
#undef SCAN_BAR
#define OP_BAR() do { asm volatile("s_waitcnt lgkmcnt(0)" ::: "memory"); __builtin_amdgcn_s_barrier(); asm volatile("" ::: "memory"); } while (0)
struct OpSmall { bf16x8 sf[4], vf[2]; unsigned short gt[16]; };
__device__ __forceinline__ void op_issue(Frame& F, int un, int w, int lane, LAS unsigned char* tile, OpSmall& R) {
#pragma unroll
    for (int q = 0; q < 3; ++q) { const int f = w * 3 + q;
        const unsigned char* src = (f < 16 ? F.ws + WS_QGF + (size_t)un * 16384 + f * 1024 : F.ws + WS_ATF + (size_t)un * 8192 + (f - 16) * 1024) + lane * 16;
        __builtin_amdgcn_global_load_lds((const unsigned*)src, (LAS unsigned*)(tile + f * 1024), 16, 0, 2); }
    const unsigned char* sb = F.ws + WS_SBF + ((size_t)un * 8 + w) * 4096 + lane * 16;
    const unsigned char* vb = F.ws + WS_VBF + ((size_t)un * 8 + w) * 2048 + lane * 16;
#pragma unroll
    for (int i = 0; i < 4; ++i) R.sf[i] = __builtin_nontemporal_load((const bf16x8*)(sb + i * 1024));
#pragma unroll
    for (int i = 0; i < 2; ++i) R.vf[i] = __builtin_nontemporal_load((const bf16x8*)(vb + i * 1024));
    const int b = un >> 10, h = (un >> 7) & 7, c = un & 127, li = lane & 15, g = lane >> 4;
    const bf16* gp = WSP(const bf16, WS_GATE) + ((size_t)b * T + (size_t)c * CH + 4 * g) * D + 128 * h + 16 * w + li;
#pragma unroll
    for (int mt = 0; mt < 4; ++mt)
#pragma unroll
        for (int i = 0; i < 4; ++i) R.gt[mt * 4 + i] = gp[(size_t)(16 * mt + i) * D];
}
__device__ __forceinline__ void ph_ophase(Frame& F) {
    bf16* MIX = WSP(bf16, WS_MIX);
    LAS float* part = (LAS float*)F.lds;
    LAS float* rinv = part + 512;
    LAS unsigned char* tiles = F.lds + 4096;
    const int w = F.wave;
    constexpr int NU = NB * DH * NCH;
    OpSmall R;
    if (F.blk < NU) op_issue(F, F.blk, w, F.lane, tiles, R);
    int par = 0;
#pragma unroll 1
    for (int un = F.blk; un < NU; un += GRID, par ^= 1) {
        int tid = F.tid; asm volatile("" : "+v"(tid));
        const int lane = tid & 63, li = lane & 15, g = lane >> 4;
        const int b = un >> 10, h = (un >> 7) & 7, c = un & 127;
        OpSmall C = R;
        asm volatile("s_waitcnt vmcnt(0)" ::: "memory");
        OP_BAR();
        if (un + GRID < NU) op_issue(F, un + GRID, w, lane, tiles + (par ^ 1) * 24576, R);
        const LAS unsigned char* tl = tiles + par * 24576 + lane * 16;
        f32x4 oa[4];
#pragma unroll
        for (int mt = 0; mt < 4; ++mt) { oa[mt] = (f32x4){0.f, 0.f, 0.f, 0.f};
#pragma unroll
            for (int ks = 0; ks < 4; ++ks) oa[mt] = MFMA16(ldsb128(tl + (mt * 4 + ks) * 1024), C.sf[ks], oa[mt]);
#pragma unroll
            for (int ks = 0; ks < 2; ++ks) oa[mt] = MFMA16(ldsb128(tl + 16384 + (mt * 2 + ks) * 1024), C.vf[ks], oa[mt]); }
#pragma unroll
        for (int mt = 0; mt < 4; ++mt)
#pragma unroll
            for (int i = 0; i < 4; ++i) { const float q = row16_sum(oa[mt][i] * oa[mt][i]); if (li == 0) part[w * 64 + 16 * mt + 4 * g + i] = q; }
        OP_BAR();
        if (tid < 64) { float sacc = 0.f;
#pragma unroll
            for (int q = 0; q < 8; ++q) sacc += part[q * 64 + tid];
            rinv[tid] = 1.0f / sqrtf(sacc * (1.f / DHD) + EPS); }
        OP_BAR();
        const float ng = F.o_norm_g[16 * w + li];
        LAS unsigned char* ot = F.lds + 4096 + 2 * 24576;
#pragma unroll
        for (int mt = 0; mt < 4; ++mt) { const f32x4 rv = *(const LAS f32x4*)(rinv + 16 * mt + 4 * g);
#pragma unroll
            for (int i = 0; i < 4; ++i) { const float gv = bf2f(C.gt[mt * 4 + i]); *(LAS unsigned short*)(ot + (16 * mt + 4 * g + i) * 272 + (16 * w + li) * 2) = (unsigned short)f2bf(oa[mt][i] * rv[i] * ng * silu_f(gv)); } }
        OP_BAR();
        { bf16* mp = MIX + ((size_t)b * T + (size_t)c * CH) * D + 128 * h;
#pragma unroll
          for (int q = 0; q < 2; ++q) { const int p = tid + 512 * q, row = p >> 4, ch = p & 15; *(v4u*)(mp + (size_t)row * D + ch * 8) = *(const LAS v4u*)(ot + row * 272 + ch * 16); } }
    }
    asm volatile("s_waitcnt vmcnt(0)" ::: "memory"); __syncthreads();
}
#undef OP_BAR
constexpr int NPHASE = 20;
__global__ void __launch_bounds__(NTHR, 2) mega(Args args) {
    extern __shared__ __attribute__((aligned(16))) unsigned char lds_raw[];
    Frame F; frame_init(F, args, (LAS unsigned char*)lds_raw);
    volatile LAS unsigned* MISC = (volatile LAS unsigned*)(F.lds + MISC_OFF);
    for (int u = F.tid; u < (LDS_BYTES - MISC_OFF) / 4; u += NTHR) ((LAS unsigned*)(F.lds + MISC_OFF))[u] = 0u;
    __syncthreads();
    const int lo = args.ph_lo, hi = args.ph_hi;
    XcdBarrier bar; bar.bar = WSP(unsigned, WS_CTL) + CW_BAR + args.li * XCD_BAR_WORDS; bar.x = 0; bar.st = nullptr;
    if (hi - lo > 1) bar = xcd_barrier_post(WSP(unsigned, WS_CTL) + CW_BAR + args.li * XCD_BAR_WORDS, MISC + 8);
#define IN(k) (lo <= (k) && (k) < hi)
#define LAUNDER() asm volatile("" : "+v"(F.tid), "+v"(F.lane))
#define SEAM(k) do { if (IN(k) && IN((k) + 1)) xcd_barrier(bar, F.tid); } while (0)
    if (IN(0)) { LAUNDER(); ph_mod_rope(F); __syncthreads(); ph_weights_dense(F); SEAM(0); }
    if (IN(1)) { LAUNDER(); ph_norm_a(F); SEAM(1); }
    if (IN(2)) { LAUNDER();
        pg8::Gemm g{WSP(const bf16, WS_H), WSP(const bf16, WS_WB_L0IN), M, L0N, D}; pg8::StaticOrder S; S.init(M, L0N, GRID, F.blk);
        pg8::EpiL0In E{WSP(bf16, WS_PROJ0), WSP(const float, WS_ROPE)};
        pg8::gemm_phase<pg8::EpiL0In, pg8::StaticOrder, true, true>(F.lds, g, S, E, F.tid);
        SEAM(2);
    }
    if (IN(3)) { LAUNDER(); ph_attn_pool(F); SEAM(3); }
    if (IN(4)) { LAUNDER(); ph_attn_combine(F); SEAM(4); }
    if (IN(5)) { LAUNDER();
        pg8::Gemm g{WSP(const bf16, WS_MIX), WSP(const bf16, WS_WB_L0OUT), M, D, D}; pg8::StaticOrder S; S.init(M, D, GRID, F.blk);
        pg8::EpiNormB E{F.x, (bf16*)F.out, WSP(bf16, WS_H), F.mix_post_g, F.ffn_pre_g, WSP(const float, WS_MOD), WSP(unsigned, WS_XB), WSP(unsigned, WS_XB) + 65536, WSP(unsigned, WS_CTL)};
        pg8::gemm_phase<pg8::EpiNormB, pg8::StaticOrder, true, true>(F.lds, g, S, E, F.tid);
        SEAM(5);
    }
    if (IN(7)) { LAUNDER();
        pg8::Gemm g{WSP(const bf16, WS_H), WSP(const bf16, WS_WB_L0GU), M, 2 * FF, D}; pg8::StaticOrder S; S.init(M, 2 * FF, GRID, F.blk);
        pg8::EpiSwiglu E{WSP(bf16, WS_HID0), FF, 1 << 30};
        pg8::gemm_phase<pg8::EpiSwiglu, pg8::StaticOrder, true, true>(F.lds, g, S, E, F.tid);
        SEAM(7);
    }
    if (IN(8)) { LAUNDER();
        pg8::Gemm g{WSP(const bf16, WS_HID0), WSP(const bf16, WS_WB_L0DN), M, D, FF}; pg8::StaticOrder S; S.init(M, D, GRID, F.blk);
        pg8::EpiPlain E{WSP(bf16, WS_Y), D, nullptr, 0, 1 << 30, 1 << 30, 1.0f};
        pg8::gemm_phase<pg8::EpiPlain, pg8::StaticOrder, true, true>(F.lds, g, S, E, F.tid);
        SEAM(8);
    }
    if (IN(9)) { LAUNDER(); ph_norm_mid<1>(F); SEAM(9); }
    if (IN(10)) { LAUNDER();
        pg8::Gemm g{WSP(const bf16, WS_H), WSP(const bf16, WS_WB_L1IN), M, 4096, D}; pg8::StaticOrder S; S.init(M, 4096, GRID, F.blk);
        pg8::EpiPlain E{WSP(bf16, WS_QKV), 3072, WSP(bf16, WS_GATE), D, 12, 1 << 30, 1.0f};
        pg8::gemm_phase<pg8::EpiPlain, pg8::StaticOrder, true, true>(F.lds, g, S, E, F.tid);
        SEAM(10);
    }
    if (IN(11)) { LAUNDER(); ph_chunk_prep(F); SEAM(11); }
    if (IN(12)) { LAUNDER(); ph_scan(F); SEAM(12); }
    if (IN(13)) { LAUNDER(); ph_ophase(F); SEAM(13); }
    if (IN(14)) { LAUNDER();
        pg8::Gemm g{WSP(const bf16, WS_MIX), WSP(const bf16, WS_WB_L1OUT), M, D, D}; pg8::StaticOrder S; S.init(M, D, GRID, F.blk);
        pg8::EpiPlain E{WSP(bf16, WS_Y), D, nullptr, 0, 1 << 30, 1 << 30, 1.0f};
        pg8::gemm_phase<pg8::EpiPlain, pg8::StaticOrder, true, true>(F.lds, g, S, E, F.tid);
        SEAM(14);
    }
    if (IN(15)) { LAUNDER(); ph_norm_mid<2>(F); SEAM(15); }
    if (IN(16)) { LAUNDER(); ph_moe_gather(F);
        SEAM(16); }
    if (IN(17)) { LAUNDER();
        pg8::Gemm g{F.ws + WS_ASORT, F.ws + WS_WB_GU, MAXROWS, NE * 2 * FF, D}; pg8::MoeOrder S; S.init((const LAS int*)(F.lds + MISC_OFF + 128), 28, GRID, F.blk);
        pg8::EpiSwigluF8 E{F.ws + WS_HID, FF, 28, 0.03125f, 4.0f};
        pg8::gemm_phase<pg8::EpiSwigluF8, pg8::MoeOrder, true, true, true>(F.lds, g, S, E, F.tid);
        SEAM(17);
    }
    if (IN(18)) { LAUNDER();
        pg8::Gemm g{F.ws + WS_HID, F.ws + WS_WB_DN, MAXROWS, NE * D, FF}; pg8::MoeDnOrder S; S.init((const LAS int*)(F.lds + MISC_OFF + 128), F.blk);
        pg8::EpiMoeDn E{WSP(bf16, WS_YS), WSP(bf16, WS_YSP), 0.00390625f};
        pg8::gemm_phase<pg8::EpiMoeDn, pg8::MoeDnOrder, true, true, true>(F.lds, g, S, E, F.tid);
        SEAM(18);
    }
    if (IN(19)) { LAUNDER(); ph_final(F); }
#undef IN
#undef LAUNDER
#undef SEAM
}

extern "C" void kernel_launch(void* const* d_in, const int* in_sizes, int n_in, void* d_out, int out_size, void* d_ws, size_t ws_size, hipStream_t stream) {
    static int ok = 0;
    if (ok == 0) {
        if (n_in != 26 || in_sizes[0] != M * D || out_size != M * D || ws_size < WS_NEED) { fprintf(stderr, "kernel_launch: unexpected shapes (n_in %d, in0 %d, out %d, ws %zu)\n", n_in, n_in > 0 ? in_sizes[0] : -1, out_size, ws_size); ok = -1; return; }
        if (hipFuncSetAttribute((const void*)mega, hipFuncAttributeMaxDynamicSharedMemorySize, LDS_BYTES) != hipSuccess) { fprintf(stderr, "kernel_launch: hipFuncSetAttribute failed\n"); ok = -1; return; }
        int per_cu = 0; (void)hipOccupancyMaxActiveBlocksPerMultiprocessor(&per_cu, (const void*)mega, NTHR, LDS_BYTES); (void)hipGetLastError();
        if (per_cu < 1) fprintf(stderr, "kernel_launch: occupancy query says %d\n", per_cu);
        ok = 1;
    }
    if (ok < 0) return;
    (void)hipMemsetAsync((char*)d_ws + WS_CTL, 0, (size_t)(CW_BAR + XCD_BAR_WORDS) * 4, stream);
    Args a{}; for (int i = 0; i < 26; ++i) a.in[i] = d_in[i]; a.out = (float*)d_out; a.ws = (unsigned char*)d_ws;
    a.ph_lo = 0; a.ph_hi = NPHASE; a.li = 0;
    hipLaunchKernelGGL(mega, dim3(GRID), dim3(NTHR), LDS_BYTES, stream, a);
}
```
